# Optimizing an MI355X kernel written in HIP

```python
import math
import jax, jax.numpy as jnp
from jax import lax
import numpy as np

D_MODEL = 1024
BATCH = 16
SEQ = 256
DEPTH = 2
DEC_BATCH = 2
DEC_SEQ = 2048
PAST_LEN = 512

GRID_W = 64
HY_W = 256
HY_ORDER = 2
N_BANDS = 8
POS_EMB = 1 + 2 * N_BANDS
FILT_HID = 64
N_HEADS = 8
Q_LORA = 256
KV_LORA = 128
NOPE_DIM = 64
ROPE_DIM = 32
V_DIM = 64
ROPE_BASE = 10000.0
Q_BLOCK = 128
FN_GROUPS = 4
FN_GROUP_W = 64
FN_W = FN_GROUPS * FN_GROUP_W
N_BRANCH = 3
D_FF = 2816
EPS = 1e-6
IN_COLS = 3 * HY_W + Q_LORA + KV_LORA + ROPE_DIM + FN_W + N_BRANCH * D_MODEL

kernel_name = 'hybrid_hyena_mla_fnet_diffusion_step'


def rmsnorm(x, g):
    x32 = x.astype(jnp.float32)
    y = x32 * lax.rsqrt(jnp.mean(x32 * x32, axis=-1, keepdims=True) + EPS)
    return (y * g.astype(jnp.float32)).astype(x.dtype)


def swiglu(x, w_up, w_down):
    g, u = jnp.split(x @ w_up, 2, axis=-1)
    return (jax.nn.silu(g) * u) @ w_down


def short_conv(u, w, b):
    up = jnp.pad(u, ((0, 0), (1, 1), (0, 0)))
    return up[:, :-2] * w[0] + up[:, 1:-1] * w[1] + up[:, 2:] * w[2] + b


def hyena_filters(L, w1, b1, w2, b2, w3):
    f32 = jnp.float32
    t_idx = jnp.arange(L, dtype=f32)
    t_norm = t_idx / (L - 1)
    w = 2.0 * math.pi * t_idx / L
    bands = jnp.linspace(1e-4, N_BANDS - 1, N_BANDS, dtype=f32)
    ang = w[:, None] * bands[None, :]
    feats = jnp.concatenate([t_norm[:, None], jnp.cos(ang), -jnp.sin(ang)], axis=-1)
    h = jnp.sin(feats @ w1.astype(f32) + b1.astype(f32))
    h = jnp.sin(h @ w2.astype(f32) + b2.astype(f32))
    h = (h @ w3.astype(f32)).reshape(L, 2, HY_ORDER, HY_W)
    deltas = jnp.linspace(math.log(1e-2) / 1.5, math.log(1e-2) / 0.3, HY_W, dtype=f32)
    decay = jnp.exp(-t_norm[:, None] * jnp.abs(deltas)[None, :])
    h = h * decay[:, None, None, :]
    h_fwd, h_bwd = h[:, 0], h[:, 1]
    filt = jnp.concatenate([h_fwd, jnp.zeros((1, HY_ORDER, HY_W), f32), h_bwd[1:][::-1]], axis=0)
    filt = filt / (jnp.sum(jnp.abs(filt), axis=0, keepdims=True) + EPS)
    return jnp.fft.rfft(filt, axis=0)


def fftconv(u, filt_f, skip):
    L = u.shape[1]
    u32 = u.astype(jnp.float32)
    U = jnp.fft.rfft(u32, n=2 * L, axis=1)
    y = jnp.fft.irfft(U * filt_f[None], n=2 * L, axis=1)[:, :L]
    return (y + u32 * skip.astype(jnp.float32)).astype(u.dtype)


def hyena_mixer(u, conv_w, conv_b, w1, b1, w2, b2, w3, skip):
    L = u.shape[1]
    u = short_conv(u, conv_w, conv_b)
    x1, x2, v = jnp.split(u, 3, axis=-1)
    filt_f = hyena_filters(L, w1, b1, w2, b2, w3)
    z = x1 * fftconv(v, filt_f[:, 0], skip[0])
    z = x2 * fftconv(z, filt_f[:, 1], skip[1])
    return z


def axial_angles(rows_n):
    f32 = jnp.float32
    rows = jnp.repeat(jnp.arange(rows_n, dtype=f32), GRID_W)
    cols = jnp.tile(jnp.arange(GRID_W, dtype=f32), rows_n)
    n_freq = ROPE_DIM // 4
    inv = ROPE_BASE ** (-jnp.arange(n_freq, dtype=f32) / n_freq)
    return rows[:, None] * inv[None, :], cols[:, None] * inv[None, :]


def rotate_block(x, ang):
    c = jnp.cos(ang)[:, None, :]
    s = jnp.sin(ang)[:, None, :]
    x1, x2 = jnp.split(x, 2, axis=-1)
    return jnp.concatenate([x1 * c - x2 * s, x2 * c + x1 * s], axis=-1)


def axial_rope(x, ang_r, ang_c):
    xr, xc = jnp.split(x, 2, axis=-1)
    return jnp.concatenate([rotate_block(xr, ang_r), rotate_block(xc, ang_c)], axis=-1).astype(x.dtype)


def blocked_attention(q, k, v):
    B, Lq, H, dq = q.shape
    nb = Lq // Q_BLOCK
    scale = 1.0 / math.sqrt(dq)
    qb = q.reshape(B, nb, Q_BLOCK, H, dq).transpose(1, 0, 2, 3, 4)

    def one_block(qi):
        s = jnp.einsum('bqhd,bkhd->bhqk', qi, k).astype(jnp.float32) * scale
        p = jax.nn.softmax(s, axis=-1).astype(v.dtype)
        return jnp.einsum('bhqk,bkhd->bqhd', p, v)

    o = lax.map(one_block, qb)
    return o.transpose(1, 0, 2, 3, 4).reshape(B, Lq, H * v.shape[-1])


def token_mix(n, l, P, rope_ang, ctx_ckv, ctx_krope):
    B, L, _ = n.shape
    proj = n @ P['w_in'][l]
    i0 = 3 * HY_W
    i1 = i0 + Q_LORA
    i2 = i1 + KV_LORA
    i3 = i2 + ROPE_DIM
    i4 = i3 + FN_W
    hy, q_a, kv_a, k_r, fn, gates = jnp.split(proj, [i0, i1, i2, i3, i4], axis=-1)

    y_a = hyena_mixer(hy, P['hy_conv_w'][l], P['hy_conv_b'][l], P['hy_filt_w1'][l], P['hy_filt_b1'][l],
                      P['hy_filt_w2'][l], P['hy_filt_b2'][l], P['hy_filt_w3'][l], P['hy_skip'][l]) @ P['w_hy_out'][l]

    q = (rmsnorm(q_a, P['q_norm_g'][l]) @ P['w_qb'][l]).reshape(B, L, N_HEADS, NOPE_DIM + ROPE_DIM)
    q_nope, q_rope = jnp.split(q, [NOPE_DIM], axis=-1)
    ckv = rmsnorm(kv_a, P['kv_norm_g'][l])
    k_rope = k_r[:, :, None, :]
    if rope_ang is not None:
        q_rope = axial_rope(q_rope, rope_ang[0], rope_ang[1])
        k_rope = axial_rope(k_rope, rope_ang[0], rope_ang[1])
    kv = (ckv @ P['w_kvb'][l]).reshape(B, L, N_HEADS, NOPE_DIM + V_DIM)
    k_nope, v = jnp.split(kv, [NOPE_DIM], axis=-1)
    if ctx_ckv is not None:
        Lc = ctx_ckv.shape[1]
        kv_c = (ctx_ckv @ P['w_kvb'][l]).reshape(B, Lc, N_HEADS, NOPE_DIM + V_DIM)
        k_nope = jnp.concatenate([k_nope, kv_c[..., :NOPE_DIM]], axis=1)
        v = jnp.concatenate([v, kv_c[..., NOPE_DIM:]], axis=1)
        k_rope = jnp.concatenate([k_rope, ctx_krope[:, :, None, :]], axis=1)
    k = jnp.concatenate([k_nope, jnp.broadcast_to(k_rope, k_nope.shape[:-1] + (ROPE_DIM,))], axis=-1)
    q = jnp.concatenate([q_nope, q_rope], axis=-1)
    y_b = blocked_attention(q, k, v) @ P['w_mla_o'][l]

    f = fn.reshape(B, L, FN_GROUPS, FN_GROUP_W).astype(jnp.float32)
    f = jnp.fft.fft2(f, axes=(1, 3), norm='ortho').real.reshape(B, L, FN_W).astype(n.dtype)
    y_c = f @ P['w_fnet'][l]

    g_a, g_b, g_c = jnp.split(jax.nn.sigmoid(gates), N_BRANCH, axis=-1)
    y = (g_a * y_a + g_b * y_b + g_c * y_c) @ P['w_out'][l]
    return y, ckv, k_r


def trunk_layer(h, ada, l, P, rope_ang, ctx_ckv, ctx_krope):
    s0, sc0, g0, s1, sc1, g1, s2, sc2, g2 = [m[:, None, :] for m in jnp.split(ada, 9, axis=-1)]
    n = rmsnorm(h, P['norm_g'][l, 0]) * (1 + sc0) + s0
    h = h + 0.5 * g0 * swiglu(n, P['w_ffn_up'][l, 0], P['w_ffn_down'][l, 0])
    n = rmsnorm(h, P['norm_g'][l, 1]) * (1 + sc1) + s1
    y, ckv, k_r = token_mix(n, l, P, rope_ang, ctx_ckv, ctx_krope)
    h = h + g1 * y
    n = rmsnorm(h, P['norm_g'][l, 2]) * (1 + sc2) + s2
    h = h + 0.5 * g2 * swiglu(n, P['w_ffn_up'][l, 1], P['w_ffn_down'][l, 1])
    return h, ckv, k_r


def setup_inputs(seed: int = 0) -> dict:
    key = jax.random.key(seed)
    ks = jax.random.split(key, 32)
    f32 = jnp.float32

    def nrm(k, shape, scale=1.0):
        return jax.random.normal(k, shape, f32) * scale

    D = D_MODEL
    return {
        'x_prompt': nrm(ks[0], (BATCH, SEQ, D)),
        'x_sample': nrm(ks[1], (DEC_BATCH, DEC_SEQ, D)),
        'cache_ckv': nrm(ks[2], (DEC_BATCH, DEPTH, PAST_LEN, KV_LORA)),
        'cache_krope': nrm(ks[3], (DEC_BATCH, DEPTH, PAST_LEN, ROPE_DIM)),
        'c': nrm(ks[4], (DEC_BATCH, D)),
        'c_ctx': nrm(ks[5], (D,)),
        'w_ada': nrm(ks[6], (DEPTH, D, 9 * D), 0.5 * D ** -0.5),
        'b_ada': nrm(ks[7], (DEPTH, 9 * D), 0.01),
        'norm_g': 1.0 + nrm(ks[8], (DEPTH, 3, D), 0.05),
        'w_ffn_up': nrm(ks[9], (DEPTH, 2, D, 2 * D_FF), D ** -0.5),
        'w_ffn_down': nrm(ks[10], (DEPTH, 2, D_FF, D), D_FF ** -0.5),
        'w_in': nrm(ks[11], (DEPTH, D, IN_COLS), D ** -0.5),
        'hy_conv_w': nrm(ks[12], (DEPTH, 3, 3 * HY_W), 3 ** -0.5),
        'hy_conv_b': nrm(ks[13], (DEPTH, 3 * HY_W), 0.01),
        'hy_filt_w1': nrm(ks[14], (DEPTH, POS_EMB, FILT_HID), POS_EMB ** -0.5),
        'hy_filt_b1': nrm(ks[15], (DEPTH, FILT_HID), 0.1),
        'hy_filt_w2': nrm(ks[16], (DEPTH, FILT_HID, FILT_HID), FILT_HID ** -0.5),
        'hy_filt_b2': nrm(ks[17], (DEPTH, FILT_HID), 0.1),
        'hy_filt_w3': nrm(ks[18], (DEPTH, FILT_HID, 2 * HY_ORDER * HY_W), FILT_HID ** -0.5),
        'hy_skip': nrm(ks[19], (DEPTH, HY_ORDER, HY_W), 0.5),
        'w_hy_out': nrm(ks[20], (DEPTH, HY_W, D), HY_W ** -0.5),
        'q_norm_g': 1.0 + nrm(ks[21], (DEPTH, Q_LORA), 0.05),
        'w_qb': nrm(ks[22], (DEPTH, Q_LORA, N_HEADS * (NOPE_DIM + ROPE_DIM)), Q_LORA ** -0.5),
        'kv_norm_g': 1.0 + nrm(ks[23], (DEPTH, KV_LORA), 0.05),
        'w_kvb': nrm(ks[24], (DEPTH, KV_LORA, N_HEADS * (NOPE_DIM + V_DIM)), KV_LORA ** -0.5),
        'w_mla_o': nrm(ks[25], (DEPTH, N_HEADS * V_DIM, D), (N_HEADS * V_DIM) ** -0.5),
        'w_fnet': nrm(ks[26], (DEPTH, FN_W, D), FN_W ** -0.5),
        'w_out': nrm(ks[27], (DEPTH, D, D), D ** -0.5),
        'final_g': 1.0 + nrm(ks[28], (D,), 0.05),
    }


def reference(x_prompt, x_sample, cache_ckv, cache_krope, c, c_ctx, w_ada, b_ada, norm_g, w_ffn_up, w_ffn_down,
              w_in, hy_conv_w, hy_conv_b, hy_filt_w1, hy_filt_b1, hy_filt_w2, hy_filt_b2, hy_filt_w3, hy_skip,
              w_hy_out, q_norm_g, w_qb, kv_norm_g, w_kvb, w_mla_o, w_fnet, w_out, final_g):
    P = {
        'norm_g': norm_g, 'w_ffn_up': w_ffn_up, 'w_ffn_down': w_ffn_down, 'w_in': w_in,
        'hy_conv_w': hy_conv_w, 'hy_conv_b': hy_conv_b, 'hy_filt_w1': hy_filt_w1, 'hy_filt_b1': hy_filt_b1,
        'hy_filt_w2': hy_filt_w2, 'hy_filt_b2': hy_filt_b2, 'hy_filt_w3': hy_filt_w3, 'hy_skip': hy_skip,
        'w_hy_out': w_hy_out, 'q_norm_g': q_norm_g, 'w_qb': w_qb, 'kv_norm_g': kv_norm_g, 'w_kvb': w_kvb,
        'w_mla_o': w_mla_o, 'w_fnet': w_fnet, 'w_out': w_out,
    }
    rows_n = x_sample.shape[1] // GRID_W
    rope_ang = axial_angles(rows_n)
    silu_ctx = jax.nn.silu(c_ctx)[None, :]
    silu_c = jax.nn.silu(c)
    hp = x_prompt
    hs = x_sample
    ckv_list = []
    kr_list = []
    for l in range(DEPTH):
        ada_ctx = silu_ctx @ w_ada[l] + b_ada[l]
        hp, ckv, kr = trunk_layer(hp, ada_ctx, l, P, None, None, None)
        ckv_list.append(ckv)
        kr_list.append(kr)
        ada_lat = silu_c @ w_ada[l] + b_ada[l]
        hs, _, _ = trunk_layer(hs, ada_lat, l, P, rope_ang, cache_ckv[:, l], cache_krope[:, l])
    y_prompt = rmsnorm(hp, final_g)
    y_sample = rmsnorm(hs, final_g)
    new_ckv = jnp.stack(ckv_list, axis=1)
    new_krope = jnp.stack(kr_list, axis=1)
    return (y_prompt, y_sample, new_ckv, new_krope)
```

```cpp
#include <hip/hip_runtime.h>
#include <cstdio>
#include <cstdint>
namespace pg8 {
#define PG8_LAS __attribute__((address_space(3)))
typedef unsigned short bf16_t;
typedef short bf16x8 __attribute__((ext_vector_type(8)));
typedef float f32x4 __attribute__((ext_vector_type(4)));
typedef unsigned u32x4 __attribute__((ext_vector_type(4)));
constexpr int BM = 256, BK = 64, HALF = 128, HTB = HALF * BK * 2  , STAGE_BYTES = 8 * HTB, NXCD = 8, WGM = 8;

__host__ __device__ __forceinline__ int lds_byte(int r, int c) { const int st = (r >> 4) * 2 + (c >> 5), rr = r & 15, cc = c & 31, ob = rr * 64 + cc * 2; return st * 1024 + (ob ^ (((ob >> 9) & 1) << 5)); }
__host__ __device__ __forceinline__ void stage_rc(int b, int& R, int& C) { const int st = b / 1024, sb = b % 1024, swz = sb ^ (((sb >> 9) & 1) << 5); R = (st >> 1) * 16 + swz / 64; C = (st & 1) * 32 + (swz % 64) / 2; }
__host__ __device__ __forceinline__ int perm32(int rho) { const int n = rho >> 4, i = rho & 15; return 8 * (i >> 2) + 4 * n + (i & 3); }

struct Unit { int pm, pn; };
struct Gemm { const bf16_t* A; const bf16_t* Bt; int M, N, K, lda, ldb; };

struct StaticOrder {
    int nM, nN, nwg, G, c;
    __host__ __device__ void init(int M, int N, int G_, int c_) { nM = M / BM; nN = N / BM; nwg = nM * nN; G = G_; c = c_; }
    __host__ __device__ bool next(int i, Unit& u) const {
        const long L = (long)i * G + c; if (L >= nwg) return false;
        int wgid = (int)L; { const int q = nwg / NXCD, r = nwg % NXCD, xcd = wgid % NXCD, off = wgid / NXCD; wgid = (xcd < r ? xcd * (q + 1) : r * (q + 1) + (xcd - r) * q) + off; }
        const int nig = WGM * nN, gid = wgid / nig, fm = gid * WGM, gsz = (nM - fm) < WGM ? (nM - fm) : WGM;
        u.pm = fm + ((wgid % nig) % gsz); u.pn = (wgid % nig) / gsz; return true;
    }
    __device__ __forceinline__ void a_ready(const Unit&) const {}
    __device__ __forceinline__ void done(const Unit&) const {}
};


__device__ __forceinline__ f32x4 zero4_() { float a, b, c, d; asm volatile("v_mov_b32 %0, 0\n\tv_mov_b32 %1, 0\n\tv_mov_b32 %2, 0\n\tv_mov_b32 %3, 0" : "=v"(a), "=v"(b), "=v"(c), "=v"(d)); return (f32x4){a, b, c, d}; }
template <class Epi, class Sched, bool ALIGN_EPI = false, bool SP2 = false>
__device__ __forceinline__ void gemm_phase(PG8_LAS unsigned char* lds, const Gemm g, const Sched& S, const Epi& E) {
    int tid_ = threadIdx.x; asm volatile("" : "+v"(tid_));
    const int tid = tid_, wid = __builtin_amdgcn_readfirstlane(tid >> 6), lane = tid & 63, wr = wid >> 2, wc = wid & 3, fr = lane & 15, fq = lane >> 4;
    const int K = g.K, nt = K / BK;
    unsigned voffA[2], voffB[2];
#pragma unroll
    for (int i = 0; i < 2; ++i) { int R, C; stage_rc(tid * 16 + i * 8192, R, C); const int Rb = Epi::PERM ? ((R & ~31) + perm32(R & 31)) : R;
        voffA[i] = (unsigned)(R * g.lda + C) * 2u; voffB[i] = (unsigned)(Rb * g.ldb + C) * 2u; }
    const size_t kstep = (size_t)(BK * 2);
    const size_t hstepA = (size_t)HALF * g.lda * 2, hstepB = (size_t)HALF * g.ldb * 2;
    const size_t tstepA = 2 * hstepA, tstepB = 2 * hstepB;
    const unsigned ldsw = (unsigned)wid * 1024u;
    const int aoff = lds_byte(wr * 64 + fr, fq * 8), boff = lds_byte(wc * 32 + fr, fq * 8);
#define PG8_SA(b, h) (((b) * 2 + (h)) * HTB)
#define PG8_SB(b, h) ((4 + (b) * 2 + (h)) * HTB)
#define PG8_STAGE(bufoff, gbase, voff) do { _Pragma("unroll") for (int _i = 0; _i < 2; ++_i) \
        __builtin_amdgcn_global_load_lds((const unsigned*)((const char*)(gbase) + (voff)[_i]), (PG8_LAS unsigned*)(lds + (bufoff) + ldsw + _i * 8192), 16, 0, 0); } while (0)
#define PG8_LDA(dst, b, h) do { _Pragma("unroll") for (int m = 0; m < 4; ++m) _Pragma("unroll") for (int k = 0; k < 2; ++k) dst[m][k] = *(const PG8_LAS bf16x8*)(lds + PG8_SA(b, h) + aoff + m * 2048 + k * 1024); } while (0)
#define PG8_LDB(dst, b, h) do { _Pragma("unroll") for (int n = 0; n < 2; ++n) _Pragma("unroll") for (int k = 0; k < 2; ++k) dst[n][k] = *(const PG8_LAS bf16x8*)(lds + PG8_SB(b, h) + boff + n * 2048 + k * 1024); } while (0)
#define PG8_MMA(ai, bj, At, Bt) do { __builtin_amdgcn_s_setprio(1); _Pragma("unroll") for (int m = 0; m < 4; ++m) _Pragma("unroll") for (int n = 0; n < 2; ++n) _Pragma("unroll") for (int k = 0; k < 2; ++k) \
        acc[ai][bj][m][n] = __builtin_amdgcn_mfma_f32_16x16x32_bf16(Bt[n][k], At[m][k], acc[ai][bj][m][n], 0, 0, 0); __builtin_amdgcn_s_setprio(0); } while (0)
#define PG8_WAIT_V(n) asm volatile("s_waitcnt vmcnt(" #n ")" ::: "memory")
#define PG8_WAIT_L(n) asm volatile("s_waitcnt lgkmcnt(" #n ")" ::: "memory")
#define PG8_BAR __builtin_amdgcn_s_barrier()
#define PG8_SCHED __builtin_amdgcn_sched_barrier(0)
    Unit cur, nxt; int ui = 0;
    if (!S.next(0, cur)) return;
    f32x4 acc[2][2][4][2];
#pragma unroll
    for (int a = 0; a < 2; ++a)
#pragma unroll
        for (int b = 0; b < 2; ++b)
#pragma unroll
            for (int m = 0; m < 4; ++m)
#pragma unroll
                for (int n = 0; n < 2; ++n) acc[a][b][m][n] = zero4_();
    bf16x8 At[4][2], B0[2][2], B1[2][2];
    const char* cA = (const char*)g.A + (size_t)cur.pm * tstepA; const char* cB = (const char*)g.Bt + (size_t)cur.pn * tstepB;
    S.a_ready(cur);
    if constexpr (SP2) {
        PG8_STAGE(PG8_SB(0, 0), cB, voffB); PG8_STAGE(PG8_SB(0, 1), cB + hstepB, voffB); PG8_STAGE(PG8_SA(0, 0), cA, voffA); PG8_STAGE(PG8_SA(0, 1), cA + hstepA, voffA);
        if (wr == 1) PG8_BAR;
        PG8_WAIT_V(2); PG8_BAR;
        PG8_STAGE(PG8_SB(1, 0), cB + kstep, voffB); PG8_STAGE(PG8_SA(1, 0), cA + kstep, voffA); PG8_STAGE(PG8_SB(1, 1), cB + hstepB + kstep, voffB);
        PG8_WAIT_V(6); PG8_BAR;
    } else {
        PG8_STAGE(PG8_SB(0, 0), cB, voffB); PG8_STAGE(PG8_SA(0, 0), cA, voffA); PG8_STAGE(PG8_SB(0, 1), cB + hstepB, voffB); PG8_STAGE(PG8_SA(0, 1), cA + hstepA, voffA);
        if (wr == 1) PG8_BAR;
        PG8_WAIT_V(4); PG8_BAR;
        PG8_STAGE(PG8_SB(1, 0), cB + kstep, voffB); PG8_STAGE(PG8_SA(1, 0), cA + kstep, voffA); PG8_STAGE(PG8_SB(1, 1), cB + hstepB + kstep, voffB);
        PG8_WAIT_V(6); PG8_BAR;
    }
#pragma unroll 1
    for (;;) {
        const bool has_next = S.next(ui + 1, nxt);
        const char* nA = has_next ? (const char*)g.A + (size_t)nxt.pm * tstepA : cA; const char* nB = has_next ? (const char*)g.Bt + (size_t)nxt.pn * tstepB : cB;
#pragma unroll 1
        for (int t = 0; t < nt; t += 2) {
            const bool last = (t == nt - 2);
            const char* a1 = cA + (size_t)(t + 1) * kstep;
            const char* a2 = last ? nA : cA + (size_t)(t + 2) * kstep; const char* b2 = last ? nB : cB + (size_t)(t + 2) * kstep;
            const char* a3 = a2 + kstep; const char* b3 = b2 + kstep;
            if (last && has_next) S.a_ready(nxt);
            if constexpr (SP2) {
            PG8_LDB(B0, 0, 0); PG8_LDB(B1, 0, 1); PG8_SCHED; PG8_LDA(At, 0, 0); PG8_STAGE(PG8_SA(1, 1), a1 + hstepA, voffA);
            PG8_WAIT_V(8); PG8_WAIT_L(0); PG8_BAR; PG8_MMA(0, 0, At, B0); PG8_MMA(0, 1, At, B1); PG8_BAR; PG8_SCHED;
            PG8_LDA(At, 0, 1); PG8_STAGE(PG8_SB(0, 0), b2, voffB); PG8_STAGE(PG8_SB(0, 1), b2 + hstepB, voffB); PG8_STAGE(PG8_SA(0, 0), a2, voffA);
            PG8_WAIT_V(8); PG8_WAIT_L(0); PG8_BAR; PG8_MMA(1, 0, At, B0); PG8_MMA(1, 1, At, B1); PG8_BAR; PG8_SCHED;
            PG8_LDB(B0, 1, 0); PG8_LDB(B1, 1, 1); PG8_SCHED; PG8_LDA(At, 1, 0); PG8_STAGE(PG8_SA(0, 1), a2 + hstepA, voffA);
            PG8_WAIT_V(8); PG8_WAIT_L(0); PG8_BAR; PG8_MMA(0, 0, At, B0); PG8_MMA(0, 1, At, B1); PG8_BAR; PG8_SCHED;
            PG8_LDA(At, 1, 1); PG8_STAGE(PG8_SB(1, 0), b3, voffB); PG8_STAGE(PG8_SB(1, 1), b3 + hstepB, voffB); PG8_STAGE(PG8_SA(1, 0), a3, voffA);
            PG8_WAIT_V(8); PG8_WAIT_L(0); PG8_BAR; PG8_MMA(1, 0, At, B0); PG8_MMA(1, 1, At, B1); PG8_BAR; PG8_SCHED;
            } else {
            PG8_LDB(B0, 0, 0); PG8_SCHED; PG8_LDA(At, 0, 0); PG8_STAGE(PG8_SA(1, 1), a1 + hstepA, voffA);
            PG8_WAIT_L(8); PG8_BAR; PG8_WAIT_L(0); PG8_MMA(0, 0, At, B0); PG8_BAR; PG8_SCHED;
            PG8_LDB(B1, 0, 1); PG8_STAGE(PG8_SB(0, 0), b2, voffB);
            PG8_BAR; PG8_WAIT_L(0); PG8_MMA(0, 1, At, B1); PG8_BAR;
            PG8_LDA(At, 0, 1); PG8_STAGE(PG8_SA(0, 0), a2, voffA);
            PG8_BAR; PG8_WAIT_L(0); PG8_MMA(1, 0, At, B0); PG8_BAR; PG8_SCHED;
            PG8_STAGE(PG8_SB(0, 1), b2 + hstepB, voffB);
            PG8_WAIT_V(6); PG8_BAR; PG8_MMA(1, 1, At, B1); PG8_BAR;
            PG8_LDB(B0, 1, 0); PG8_SCHED; PG8_LDA(At, 1, 0); PG8_STAGE(PG8_SA(0, 1), a2 + hstepA, voffA);
            PG8_WAIT_L(8); PG8_BAR; PG8_WAIT_L(0); PG8_MMA(0, 0, At, B0); PG8_BAR; PG8_SCHED;
            PG8_LDB(B1, 1, 1); PG8_STAGE(PG8_SB(1, 0), b3, voffB);
            PG8_BAR; PG8_WAIT_L(0); PG8_MMA(0, 1, At, B1); PG8_BAR;
            PG8_LDA(At, 1, 1); PG8_STAGE(PG8_SA(1, 0), a3, voffA);
            PG8_BAR; PG8_WAIT_L(0); PG8_MMA(1, 0, At, B0); PG8_BAR; PG8_SCHED;
            PG8_STAGE(PG8_SB(1, 1), b3 + hstepB, voffB);
            PG8_WAIT_V(6); PG8_BAR; PG8_MMA(1, 1, At, B1); PG8_BAR;
            }
        }
        if constexpr (ALIGN_EPI) { if (wr == 0) PG8_BAR; }
        if constexpr (!Epi::AFTER_DRAIN) { E(acc, cur, wr, wc, fr, fq); S.done(cur); }
        if (!has_next) break;
#pragma unroll
        for (int a = 0; a < 2; ++a)
#pragma unroll
            for (int b = 0; b < 2; ++b)
#pragma unroll
                for (int m = 0; m < 4; ++m)
#pragma unroll
                    for (int n = 0; n < 2; ++n) acc[a][b][m][n] = zero4_();
        cur = nxt; cA = nA; cB = nB; ++ui;
        if constexpr (ALIGN_EPI) { if (wr == 1) PG8_BAR; }
    }
    PG8_WAIT_V(0);
    if constexpr (!ALIGN_EPI) { if (wr == 0) PG8_BAR; }
    PG8_BAR;
    if constexpr (Epi::AFTER_DRAIN) { E.fused(acc, cur, wr, wc, fr, fq, lds, wid, lane); S.done(cur); }
#undef PG8_SA
#undef PG8_SB
#undef PG8_STAGE
#undef PG8_LDA
#undef PG8_LDB
#undef PG8_MMA
#undef PG8_WAIT_V
#undef PG8_WAIT_L
#undef PG8_BAR
#undef PG8_SCHED
}
}

#define GAS __attribute__((address_space(1)))
#define LAS __attribute__((address_space(3)))
typedef unsigned short bf16_t;
typedef float f32x4 __attribute__((ext_vector_type(4)));
typedef float f32x8 __attribute__((ext_vector_type(8)));
typedef float f32x16 __attribute__((ext_vector_type(16)));
typedef short bf16x8 __attribute__((ext_vector_type(8)));
typedef short s16x4 __attribute__((ext_vector_type(4)));
typedef unsigned u32x4 __attribute__((ext_vector_type(4)));
typedef unsigned u32x2 __attribute__((ext_vector_type(2)));

constexpr int DM = 1024, MTOK = 8192, NCTX = 4096, LCTX = 256, LLAT = 2048;
constexpr int DFF = 2816, NUP = 5632, INC = 4512;
constexpr int N1 = 3584;
constexpr int N2 = 1280;
constexpr int KVROWS = 9216;
constexpr int NADA = 9216;
constexpr float EPSV = 1e-6f;
constexpr int NWAVES = 8, NTHR = 512;

constexpr size_t al256(size_t x) { return (x + 255) & ~(size_t)255; }
constexpr size_t WS_CTL = 0, CTL_BYTES = 1u << 20;
constexpr size_t WS_ADAP = WS_CTL + CTL_BYTES;
constexpr size_t WS_ADA  = WS_ADAP + al256((size_t)16 * 2 * 3 * NADA * 4);
constexpr size_t WS_SSQ  = WS_ADA + al256((size_t)2 * 3 * NADA * 4);
constexpr size_t WS_SSKV = WS_SSQ + al256((size_t)MTOK * 4 * 4);
constexpr size_t WS_ROPE = WS_SSKV + al256((size_t)MTOK * 4 * 4);
constexpr size_t WS_H2   = WS_ROPE + al256(64 * 8 * 2 * 4);
constexpr size_t WS_FILT = WS_H2 + al256((size_t)2 * 2304 * 64 * 4);
constexpr size_t FILT_LAYER = (size_t)512 * 4096 + (size_t)512 * 512;
constexpr size_t WS_CKVRAW = WS_FILT + al256(2 * FILT_LAYER * 4);
constexpr size_t WS_KRRAW = WS_CKVRAW + al256((size_t)NCTX * 128 * 4);
constexpr size_t WS_CKVB = WS_KRRAW + al256((size_t)MTOK * 32 * 4);
constexpr size_t WS_WUP  = WS_CKVB + al256((size_t)2 * 1024 * 256 * 2);
constexpr size_t WS_WDN  = WS_WUP + al256((size_t)4 * NUP * DM * 2);
constexpr size_t WS_W1T  = WS_WDN + al256((size_t)4 * DM * DFF * 2);
constexpr size_t WS_W2T  = WS_W1T + al256((size_t)2 * N1 * DM * 2);
constexpr size_t WS_WQB  = WS_W2T + al256((size_t)2 * N2 * DM * 2);
constexpr size_t WS_WKVB = WS_WQB + al256((size_t)2 * 768 * 256 * 2);
constexpr size_t WS_WKVR = WS_WKVB + al256((size_t)2 * 1024 * 256 * 2);
constexpr size_t WS_WHY  = WS_WKVR + al256((size_t)2 * 1024 * 256 * 2);
constexpr size_t WS_WMLA = WS_WHY + al256((size_t)2 * 1024 * 256 * 2);
constexpr size_t WS_WFN  = WS_WMLA + al256((size_t)2 * 1024 * 512 * 2);
constexpr size_t WS_WOUT = WS_WFN + al256((size_t)2 * 1024 * 256 * 2);
constexpr size_t WS_DFTL = WS_WOUT + al256((size_t)2 * 1024 * 1024 * 2);
constexpr size_t WS_DFTC = WS_DFTL + al256((size_t)2048 * 4096 * 2);
constexpr size_t WS_H    = WS_DFTC + al256((size_t)256 * 512 * 2);
constexpr size_t WS_N    = WS_H + al256((size_t)MTOK * DM * 4);
constexpr size_t WS_KV   = WS_N + al256((size_t)MTOK * DM * 2);
constexpr size_t WS_KR   = WS_KV + al256((size_t)KVROWS * 1024 * 2);
constexpr size_t WS_R1   = WS_KR + al256((size_t)KVROWS * 32 * 2);
constexpr size_t WS_ACT  = WS_R1;
constexpr size_t WS_P1   = WS_R1;
constexpr size_t WS_HYT  = WS_P1 + al256((size_t)MTOK * N1 * 2);
constexpr size_t WS_XCTL = WS_HYT + al256((size_t)768 * MTOK * 2);
constexpr size_t WS_XCTC = WS_XCTL + al256((size_t)512 * 4096 * 2);
constexpr size_t WS_Q    = WS_XCTC + al256((size_t)4096 * 512 * 2);
constexpr size_t WS_O    = WS_Q + al256((size_t)MTOK * 768 * 2);
constexpr size_t WS_Z    = WS_O + al256((size_t)MTOK * 512 * 2);
constexpr size_t WS_FN   = WS_Z + al256((size_t)MTOK * 256 * 2);
constexpr size_t WS_Y    = WS_FN + al256((size_t)MTOK * 256 * 2);
constexpr size_t WS_END  = WS_Y + al256((size_t)MTOK * DM * 4);
static_assert(WS_ACT + (size_t)MTOK * DFF * 2 <= WS_END, "ws map");

constexpr int CW_BAR = 4096;

constexpr int RING_BYTES = 131072;
constexpr int MISC_OFF = RING_BYTES + 320;
constexpr int LDS_BYTES = 147456;

__device__ __forceinline__ unsigned f2bf(float f) { unsigned u = __builtin_bit_cast(unsigned, f); return (u + 0x7fffu + ((u >> 16) & 1u)) >> 16; }
__device__ __forceinline__ unsigned pk2(float lo, float hi) { return f2bf(lo) | (f2bf(hi) << 16); }
__device__ __forceinline__ float bf2f(unsigned short b) { return __builtin_bit_cast(float, (unsigned)b << 16); }
__device__ __forceinline__ float bflo(unsigned w) { return __builtin_bit_cast(float, w << 16); }
__device__ __forceinline__ float bfhi(unsigned w) { return __builtin_bit_cast(float, w & 0xffff0000u); }
__device__ __forceinline__ unsigned cvtpk(float lo, float hi) { unsigned r; asm volatile("v_cvt_pk_bf16_f32 %0, %1, %2" : "=v"(r) : "v"(lo), "v"(hi)); return r; }
__device__ __forceinline__ u32x4 pack8(f32x4 a, f32x4 b) { u32x4 w; w.x = cvtpk(a[0], a[1]); w.y = cvtpk(a[2], a[3]); w.z = cvtpk(b[0], b[1]); w.w = cvtpk(b[2], b[3]); return w; }
__device__ __forceinline__ float wave_sum(float v) {
#pragma unroll
    for (int o = 1; o < 64; o <<= 1) v += __shfl_xor(v, o);
    return v;
}
__device__ __forceinline__ float sigmoidf_(float x) { return 1.0f / (1.0f + __expf(-x)); }
__device__ __forceinline__ float siluf_(float x) { return x / (1.0f + __expf(-x)); }
__device__ __forceinline__ int grp_of_pm(int pm) { return pm < 16 ? 0 : (pm < 24 ? 1 : 2); }
__device__ __forceinline__ int kvrow_of(int r) { return r < NCTX ? r : NCTX + ((r - NCTX) >> 11) * 2560 + ((r - NCTX) & 2047); }

#define XB_TMO      128
#define XB_XCNT(j)  (256  + 64 * (j))
#define XB_XSUB(j)  (1280 + 64 * (j))
#define XB_XGEN(j)  (2304 + 64 * (j))
#define XB_TOP      3328
#define XB_TOPGEN   3392
#define XCD_BAR_WORDS 3456
#define XB_SPIN_CAP (1u << 20)
__device__ __forceinline__ unsigned xb_ld(unsigned* p)              { return __hip_atomic_load(p, __ATOMIC_RELAXED, __HIP_MEMORY_SCOPE_AGENT); }
__device__ __forceinline__ unsigned xb_add(unsigned* p, unsigned v) { return __hip_atomic_fetch_add(p, v, __ATOMIC_RELAXED, __HIP_MEMORY_SCOPE_AGENT); }
__device__ __forceinline__ unsigned xb_xcc_id() { return (unsigned)__builtin_amdgcn_s_getreg((3 << 11) | 20) & 0xFu; }
#define XB_SPIN(cond, bar) do { unsigned _sp = 0; while (cond) { __builtin_amdgcn_s_sleep(1); \
    if ((++_sp & 255u) == 0u) { if (xb_ld(&(bar)[XB_TMO])) break; if (_sp > XB_SPIN_CAP) { atomicAdd(&(bar)[XB_TMO], 1u); break; } } } } while (0)
struct XcdBarrier { unsigned* bar; unsigned x; volatile LAS unsigned* st; };
__device__ __forceinline__ XcdBarrier xcd_barrier_post(unsigned* bar, volatile LAS unsigned* st) {
    XcdBarrier b; b.bar = bar; b.x = xb_xcc_id(); b.st = st;
    if (threadIdx.x == 0) (void)xb_add(&bar[XB_XCNT(b.x)], 1u);
    return b;
}
__device__ __forceinline__ void xcd_barrier_complete(unsigned* bar, unsigned x, unsigned& nloc, unsigned& nx) {
    const unsigned G = gridDim.x * gridDim.y * gridDim.z;
    unsigned sum, cnt, mine, sp = 0u;
    for (;;) {
        sum = 0u; cnt = 0u; mine = 0u;
#pragma unroll 1
        for (unsigned j = 0; j < 16; ++j) { const unsigned c = xb_ld(&bar[XB_XCNT(j)]); sum += c; cnt += (c > 0u) ? 1u : 0u; mine = (j == x) ? c : mine; }
        if (sum == G) break;
        __builtin_amdgcn_s_sleep(1);
        if ((++sp & 255u) == 0u) { if (xb_ld(&bar[XB_TMO])) break; if (sp > XB_SPIN_CAP) { atomicAdd(&bar[XB_TMO], 1u); break; } }
    }
    nloc = mine > 0u ? mine : 1u; nx = cnt > 0u ? cnt : 1u;
}
__device__ __forceinline__ void xcd_barrier(const XcdBarrier& b) {
    asm volatile("s_waitcnt vmcnt(0)" ::: "memory");
    __syncthreads();
    if (threadIdx.x == 0) {
        size_t z_ = 0; asm volatile("" : "+s"(z_));
        unsigned* bar = b.bar + z_;
        __builtin_amdgcn_s_waitcnt(0);
        unsigned nloc = b.st[0], nx = b.st[1];
        if (nloc == 0u) { xcd_barrier_complete(bar, b.x, nloc, nx); b.st[0] = nloc; b.st[1] = nx; }
        const unsigned old = xb_add(&bar[XB_XSUB(b.x)], 1u);
        const unsigned gen = old / nloc;
        if (old + 1u == (gen + 1u) * nloc) {
            __builtin_amdgcn_fence(__ATOMIC_RELEASE, "agent");
            asm volatile("s_waitcnt vmcnt(0)" ::: "memory");
            const unsigned og = xb_add(&bar[XB_TOP], 1u);
            const unsigned tg = og / nx;
            if (og + 1u == (tg + 1u) * nx) xb_add(&bar[XB_TOPGEN], 1u);
            else XB_SPIN(xb_ld(&bar[XB_TOPGEN]) == tg, bar);
            __builtin_amdgcn_fence(__ATOMIC_ACQUIRE, "agent");
            xb_add(&bar[XB_XGEN(b.x)], 1u);
            asm volatile("s_waitcnt vmcnt(0)" ::: "memory");
        } else {
            XB_SPIN(xb_ld(&bar[XB_XGEN(b.x)]) == gen, bar);
            __builtin_amdgcn_fence(__ATOMIC_ACQUIRE, "agent");
            asm volatile("s_waitcnt vmcnt(0)" ::: "memory");
        }
    }
    __syncthreads();
}

using pg8::Unit;
typedef const f32x4 (&AccT)[2][2][4][2];

struct EpiSwiglu {
    static constexpr bool PERM = false, AFTER_DRAIN = false;
    bf16_t* ACT;
    __device__ __forceinline__ void operator()(AccT acc, const Unit& u, int wr, int wc, int fr, int fq) const {
        int z_ = 0; asm volatile("" : "+s"(z_));
        const int row0 = u.pm * 256 + wr * 64 + fr + z_, f0 = u.pn * 128 + wc * 16 + 4 * fq;
#pragma unroll
        for (int ai = 0; ai < 2; ++ai)
#pragma unroll
            for (int m = 0; m < 4; ++m) { bf16_t* rp = ACT + (size_t)(row0 + ai * 128 + m * 16) * DFF + f0;
#pragma unroll
                for (int bj = 0; bj < 2; ++bj) { const f32x4 g = acc[ai][bj][m][0], x = acc[ai][bj][m][1];
                    u32x2 w; w.x = cvtpk(siluf_(g[0]) * x[0], siluf_(g[1]) * x[1]); w.y = cvtpk(siluf_(g[2]) * x[2], siluf_(g[3]) * x[3]);
                    *(u32x2*)(rp + 64 * bj) = w; } }
    }
};
struct EpiResid {
    static constexpr bool PERM = true, AFTER_DRAIN = false;
    float* H; const float* gate; float gs;
    __device__ __forceinline__ void operator()(AccT acc, const Unit& u, int wr, int wc, int fr, int fq) const {
        int z_ = 0; asm volatile("" : "+s"(z_));
        const int row0 = u.pm * 256 + wr * 64 + fr + z_, col0 = u.pn * 256 + wc * 32 + 8 * fq;
        const float* gp = gate + grp_of_pm(u.pm) * NADA + col0;
        f32x4 gv[2][2];
#pragma unroll
        for (int bj = 0; bj < 2; ++bj) { gv[bj][0] = *(const f32x4*)(gp + bj * 128) * gs; gv[bj][1] = *(const f32x4*)(gp + bj * 128 + 4) * gs; }
#pragma unroll
        for (int ai = 0; ai < 2; ++ai)
#pragma unroll
            for (int m = 0; m < 4; ++m) { float* rp = H + (size_t)(row0 + ai * 128 + m * 16) * DM + col0;
#pragma unroll
                for (int bj = 0; bj < 2; ++bj) {
                    f32x4 h0 = *(const f32x4*)(rp + bj * 128), h1 = *(const f32x4*)(rp + bj * 128 + 4);
                    h0 += gv[bj][0] * acc[ai][bj][m][0]; h1 += gv[bj][1] * acc[ai][bj][m][1];
                    *(f32x4*)(rp + bj * 128) = h0; *(f32x4*)(rp + bj * 128 + 4) = h1; }
                if (m & 1) asm volatile("" ::: "memory"); }
    }
};
struct EpiProj1 {
    static constexpr bool PERM = true, AFTER_DRAIN = false;
    bf16_t* P1; float* SSQ; float* SSKV; float* CKVRAW; float* KRRAW;
    __device__ __forceinline__ void operator()(AccT acc, const Unit& u, int wr, int wc, int fr, int fq) const {
        int z_ = 0; asm volatile("" : "+s"(z_));
        fq += z_; wc += z_;
        const int row0 = u.pm * 256 + wr * 64 + fr + z_, col0 = u.pn * 256 + wc * 32 + 8 * fq;
        if (u.pn >= 2) {
#pragma unroll
            for (int ai = 0; ai < 2; ++ai)
#pragma unroll
                for (int m = 0; m < 4; ++m) { bf16_t* rp = P1 + (size_t)(row0 + ai * 128 + m * 16) * N1 + col0;
#pragma unroll
                    for (int bj = 0; bj < 2; ++bj) { f32x4 a = acc[ai][bj][m][0], b = acc[ai][bj][m][1];
#pragma unroll
                        for (int j = 0; j < 4; ++j) { a[j] = sigmoidf_(a[j]); b[j] = sigmoidf_(b[j]); }
                        *(u32x4*)(rp + bj * 128) = pack8(a, b); } }
        } else {
            const bool isq = (u.pn == 0);
#pragma unroll
            for (int ai = 0; ai < 2; ++ai)
#pragma unroll
                for (int m = 0; m < 4; ++m) { const int row = row0 + ai * 128 + m * 16; bf16_t* rp = P1 + (size_t)row * N1 + col0;
                    const f32x4 a0 = acc[ai][0][m][0], b0 = acc[ai][0][m][1], a1 = acc[ai][1][m][0], b1 = acc[ai][1][m][1];
                    *(u32x4*)(rp) = pack8(a0, b0); *(u32x4*)(rp + 128) = pack8(a1, b1);
                    float s = (a0[0] * a0[0] + a0[1] * a0[1]) + (a0[2] * a0[2] + a0[3] * a0[3]) + (b0[0] * b0[0] + b0[1] * b0[1]) + (b0[2] * b0[2] + b0[3] * b0[3]);
                    if (isq) s += (a1[0] * a1[0] + a1[1] * a1[1]) + (a1[2] * a1[2] + a1[3] * a1[3]) + (b1[0] * b1[0] + b1[1] * b1[1]) + (b1[2] * b1[2] + b1[3] * b1[3]);
                    s += __shfl_xor(s, 16); s += __shfl_xor(s, 32);
                    if (fq == 0) (isq ? SSQ : SSKV)[row * 4 + wc] = s;
                    if (!isq) {
                        if (row < NCTX) { float* cp = CKVRAW + (size_t)row * 128 + wc * 32 + 8 * fq; *(f32x4*)cp = a0; *(f32x4*)(cp + 4) = b0; }
                        if (wc == 0) { float* kp = KRRAW + (size_t)row * 32 + 8 * fq; *(f32x4*)kp = a1; *(f32x4*)(kp + 4) = b1; }
                    }
                    asm volatile("" ::: "memory"); }
        }
    }
};
struct EpiQ {
    static constexpr bool PERM = true, AFTER_DRAIN = false;
    bf16_t* Q; const float* SSQ; const float* rope;
    __device__ __forceinline__ void operator()(AccT acc, const Unit& u, int wr, int wc, int fr, int fq) const {
        int z_ = 0; asm volatile("" : "+s"(z_));
        const int row0 = u.pm * 256 + wr * 64 + fr + z_, col0 = u.pn * 256 + wc * 32 + 8 * fq;
#pragma unroll
        for (int ai = 0; ai < 2; ++ai)
#pragma unroll
            for (int m = 0; m < 4; ++m) { const int row = row0 + ai * 128 + m * 16;
                const f32x4 ss = *(const f32x4*)(SSQ + row * 4); const float rstd = __builtin_amdgcn_rsqf(((ss[0] + ss[1]) + (ss[2] + ss[3])) * (1.0f / 256.0f) + EPSV);
#pragma unroll
                for (int bj = 0; bj < 2; ++bj) { const int c = col0 + bj * 128, within = c % 96;
                    f32x4 a = acc[ai][bj][m][0] * rstd, b = acc[ai][bj][m][1] * rstd;
                    if (within >= 64 && row >= NCTX) { const int pp = within - 64, part = pp >> 4, ib = (pp & 15) >> 1; const int t = (row - NCTX) & 2047, pos = part == 0 ? (t >> 6) : (t & 63);
                        const float* rt = rope + (pos * 8 + ib) * 2; const f32x4 r0 = *(const f32x4*)rt, r1 = *(const f32x4*)(rt + 4);
                        f32x4 a2, b2; a2[0] = a[0] * r0[0] - a[1] * r0[1]; a2[1] = a[1] * r0[0] + a[0] * r0[1]; a2[2] = a[2] * r0[2] - a[3] * r0[3]; a2[3] = a[3] * r0[2] + a[2] * r0[3];
                        b2[0] = b[0] * r1[0] - b[1] * r1[1]; b2[1] = b[1] * r1[0] + b[0] * r1[1]; b2[2] = b[2] * r1[2] - b[3] * r1[3]; b2[3] = b[3] * r1[2] + b[2] * r1[3]; a = a2; b = b2; }
                    *(u32x4*)(Q + (size_t)row * 768 + c) = pack8(a, b); }
                asm volatile("" ::: "memory"); }
    }
};
template <bool CACHED> struct EpiKV {
    static constexpr bool PERM = true, AFTER_DRAIN = false;
    bf16_t* KV; const float* SS;
    __device__ __forceinline__ void operator()(AccT acc, const Unit& u, int wr, int wc, int fr, int fq) const {
        int z_ = 0; asm volatile("" : "+s"(z_));
        const int row0 = u.pm * 256 + wr * 64 + fr + z_, col0 = u.pn * 256 + wc * 32 + 8 * fq;
#pragma unroll
        for (int ai = 0; ai < 2; ++ai)
#pragma unroll
            for (int m = 0; m < 4; ++m) { const int row = row0 + ai * 128 + m * 16; float rstd = 1.0f; int drow;
                if (CACHED) drow = NCTX + (row >> 9) * 2560 + 2048 + (row & 511);
                else { drow = kvrow_of(row); const f32x4 ss = *(const f32x4*)(SS + row * 4); rstd = __builtin_amdgcn_rsqf(((ss[0] + ss[1]) + (ss[2] + ss[3])) * (1.0f / 128.0f) + EPSV); }
#pragma unroll
                for (int bj = 0; bj < 2; ++bj) *(u32x4*)(KV + (size_t)drow * 1024 + col0 + bj * 128) = pack8(acc[ai][bj][m][0] * rstd, acc[ai][bj][m][1] * rstd);
                asm volatile("" ::: "memory"); }
    }
};
struct EpiT {
    static constexpr bool PERM = true, AFTER_DRAIN = false;
    bf16_t* HYT; bf16_t* XCTL; bf16_t* XCTC;
    __device__ __forceinline__ void operator()(AccT acc, const Unit& u, int wr, int wc, int fr, int fq) const {
        int z_ = 0; asm volatile("" : "+s"(z_));
        const int row0 = u.pm * 256 + wr * 64 + fr + z_, tok0 = u.pn * 256 + wc * 32 + 8 * fq;
#pragma unroll
        for (int ai = 0; ai < 2; ++ai)
#pragma unroll
            for (int m = 0; m < 4; ++m) { const int n = row0 + ai * 128 + m * 16;
#pragma unroll
                for (int bj = 0; bj < 2; ++bj) { const int tok = tok0 + bj * 128; bf16_t* dp;
                    if (u.pm < 3) dp = HYT + (size_t)n * MTOK + tok;
                    else { const int isS = u.pm - 3, col = n - 768 - 256 * isS;
                        if (tok < NCTX) dp = XCTC + ((size_t)((tok >> 8) * 256 + col)) * 512 + isS * 256 + (tok & 255);
                        else dp = XCTL + ((size_t)(((tok - NCTX) >> 11) * 256 + col)) * 4096 + isS * 2048 + ((tok - NCTX) & 2047); }
                    *(u32x4*)dp = pack8(acc[ai][bj][m][0], acc[ai][bj][m][1]); } }
    }
};
struct EpiFn {
    static constexpr bool PERM = true, AFTER_DRAIN = false;
    bf16_t* FN; int lat; float scale;
    __device__ __forceinline__ void operator()(AccT acc, const Unit& u, int wr, int wc, int fr, int fq) const {
        int z_ = 0; asm volatile("" : "+s"(z_));
        const int rb = lat ? (NCTX + u.pn * 2048 + u.pm * 256) : (u.pn * 256);
        const int row0 = rb + wr * 64 + fr + z_, col0 = wc * 32 + 8 * fq;
#pragma unroll
        for (int ai = 0; ai < 2; ++ai)
#pragma unroll
            for (int m = 0; m < 4; ++m) { bf16_t* rp = FN + (size_t)(row0 + ai * 128 + m * 16) * 256 + col0;
#pragma unroll
                for (int bj = 0; bj < 2; ++bj) *(u32x4*)(rp + bj * 128) = pack8(acc[ai][bj][m][0] * scale, acc[ai][bj][m][1] * scale); }
    }
};
template <int MODE> struct EpiGate {
    static constexpr bool PERM = true, AFTER_DRAIN = false;
    float* Y; bf16_t* YB; const bf16_t* G;
    __device__ __forceinline__ void operator()(AccT acc, const Unit& u, int wr, int wc, int fr, int fq) const {
        int z_ = 0; asm volatile("" : "+s"(z_));
        const int row0 = u.pm * 256 + wr * 64 + fr + z_, col0 = u.pn * 256 + wc * 32 + 8 * fq;
#pragma unroll
        for (int ai = 0; ai < 2; ++ai)
#pragma unroll
            for (int m = 0; m < 4; ++m) { const int row = row0 + ai * 128 + m * 16;
#pragma unroll
                for (int bj = 0; bj < 2; ++bj) { const int c = col0 + bj * 128;
                    const u32x4 gw = *(const u32x4*)(G + (size_t)row * N1 + c);
                    f32x4 g0, g1; g0[0] = bflo(gw.x); g0[1] = bfhi(gw.x); g0[2] = bflo(gw.y); g0[3] = bfhi(gw.y); g1[0] = bflo(gw.z); g1[1] = bfhi(gw.z); g1[2] = bflo(gw.w); g1[3] = bfhi(gw.w);
                    f32x4 a = g0 * acc[ai][bj][m][0], b = g1 * acc[ai][bj][m][1];
                    float* yp = Y + (size_t)row * DM + c;
                    if (MODE >= 1) { a += *(const f32x4*)yp; b += *(const f32x4*)(yp + 4); }
                    if (MODE <= 1) { *(f32x4*)yp = a; *(f32x4*)(yp + 4) = b; }
                    else *(u32x4*)(YB + (size_t)row * DM + c) = pack8(a, b); }
                asm volatile("" ::: "memory"); }
    }
};

namespace att {
constexpr int KVBLK = 64;
constexpr float SCALE = 0.10206207261596575f;
constexpr float THR = 8.f;
constexpr int SHM_V = KVBLK * 128 * 2, SHM_K = KVBLK * 128 * 2, SHM_ATTN = 2 * SHM_V + 2 * SHM_K + NWAVES * 64 * 4;
#define KSWZ(row, colB) ((row) * 256 + ((colB) ^ (((row) & 7) << 4)))
#define SBAR() __builtin_amdgcn_sched_barrier(0)
__device__ __forceinline__ int crow(int r, int hi) { return (r & 3) + 8 * (r >> 2) + 4 * hi; }
__device__ __forceinline__ void partialSM(f32x16& p0, f32x16& p1, float& m_reg, float& mn, float& alpha) {
  constexpr float C = SCALE * 1.4426950408889634f;
  float pmax = p0[0];
#pragma unroll
  for (int r = 1; r < 16; ++r) pmax = fmaxf(pmax, p0[r]);
#pragma unroll
  for (int r = 0; r < 16; ++r) pmax = fmaxf(pmax, p1[r]);
  { auto rr = __builtin_amdgcn_permlane32_swap(__float_as_uint(pmax), __float_as_uint(pmax), false, false);
    pmax = fmaxf(__uint_as_float(rr[0]), __uint_as_float(rr[1])); }
  if (__builtin_expect(__all(pmax - m_reg <= THR / SCALE), 1)) { mn = m_reg; alpha = 1.f; }
  else { mn = fmaxf(m_reg, pmax); alpha = __builtin_amdgcn_exp2f((m_reg - mn) * C); m_reg = mn; }
  float mnC = -mn * C;
#pragma unroll
  for (int r = 0; r < 16; ++r) p0[r] = fmaf(p0[r], C, mnC);
#pragma unroll
  for (int r = 0; r < 16; ++r) p1[r] = fmaf(p1[r], C, mnC);
#pragma unroll
  for (int r = 0; r < 16; ++r) p0[r] = __builtin_amdgcn_exp2f(p0[r]);
}
__device__ __forceinline__ void finishSM(f32x16& p0, f32x16& p1, float alpha, float& l_reg, bf16x8& pa0, bf16x8& pa1, bf16x8& pa2, bf16x8& pa3) {
#pragma unroll
  for (int r = 0; r < 16; ++r) p1[r] = __builtin_amdgcn_exp2f(p1[r]);
  float ps = 0;
#pragma unroll
  for (int r = 0; r < 16; ++r) ps += p0[r];
#pragma unroll
  for (int r = 0; r < 16; ++r) ps += p1[r];
  { auto rr = __builtin_amdgcn_permlane32_swap(__float_as_uint(ps), __float_as_uint(ps), false, false);
    ps = __uint_as_float(rr[0]) + __uint_as_float(rr[1]); }
  l_reg = l_reg * alpha + ps;
#define PK4(P, BASE, OUT) do { unsigned a0 = cvtpk(P[BASE + 0], P[BASE + 1]), a1 = cvtpk(P[BASE + 2], P[BASE + 3]);   \
    unsigned b0 = cvtpk(P[BASE + 4], P[BASE + 5]), b1 = cvtpk(P[BASE + 6], P[BASE + 7]);                              \
    auto r0 = __builtin_amdgcn_permlane32_swap(a0, b0, false, false); auto r1 = __builtin_amdgcn_permlane32_swap(a1, b1, false, false); \
    u32x4 w = {r0[0], r1[0], r0[1], r1[1]}; OUT = *reinterpret_cast<bf16x8*>(&w); } while (0)
  PK4(p0, 0, pa0); PK4(p0, 8, pa1); PK4(p1, 0, pa2); PK4(p1, 8, pa3);
#undef PK4
}
__device__ __forceinline__ void qkt(f32x16& p0, f32x16& p1, const char* Ks, const bf16x8* qr, int r32, int hi) {
  p0 = f32x16{}; p1 = f32x16{};
#pragma unroll
  for (int d0 = 0; d0 < 6; ++d0) { int cb = (d0 * 16 + hi * 8) * 2;
    bf16x8 b0 = *reinterpret_cast<const bf16x8*>(Ks + KSWZ(r32, cb));
    bf16x8 b1 = *reinterpret_cast<const bf16x8*>(Ks + KSWZ(32 + r32, cb));
    p0 = __builtin_amdgcn_mfma_f32_32x32x16_bf16(b0, qr[d0], p0, 0, 0, 0);
    p1 = __builtin_amdgcn_mfma_f32_32x32x16_bf16(b1, qr[d0], p1, 0, 0, 0); }
}
__device__ __forceinline__ int v_st(int k, int c) { const int kk = (k & ~0xC) | ((k & 4) << 1) | ((k & 8) >> 1); return ((kk >> 3) * 4 + (c >> 5)) * 512 + ((kk & 7) * 32 + (c & 31)) * 2; }
__device__ __forceinline__ int v_rd_base(int lane) { return ((lane & 3) << 3) | (((lane >> 2) & 3) << 6) | (((lane >> 4) & 1) << 5) | (((lane >> 5) & 1) << 8); }
constexpr int v_rd_off(int d0, int ks, int half) { return d0 * 512 + ks * 4096 + half * 2048; }
template <int OFF> __device__ __forceinline__ s16x4 tr_read(int vb) {
  s16x4 r; asm volatile("ds_read_b64_tr_b16 %0, %1 offset:%2" : "=&v"(r) : "v"(vb), "i"(OFF) : "memory"); return r;
}
template <int D0> __device__ __forceinline__ void pv_one(f32x16& od, int vb, bf16x8 pa0, bf16x8 pa1, bf16x8 pa2, bf16x8 pa3) {
  const s16x4 l0 = tr_read<v_rd_off(D0, 0, 0)>(vb), h0 = tr_read<v_rd_off(D0, 0, 1)>(vb), l1 = tr_read<v_rd_off(D0, 1, 0)>(vb), h1 = tr_read<v_rd_off(D0, 1, 1)>(vb);
  const s16x4 l2 = tr_read<v_rd_off(D0, 2, 0)>(vb), h2 = tr_read<v_rd_off(D0, 2, 1)>(vb), l3 = tr_read<v_rd_off(D0, 3, 0)>(vb), h3 = tr_read<v_rd_off(D0, 3, 1)>(vb);
  asm volatile("s_waitcnt lgkmcnt(0)" ::: "memory"); SBAR();
#define PK(L, H) (bf16x8){L[0], L[1], L[2], L[3], H[0], H[1], H[2], H[3]}
  od = __builtin_amdgcn_mfma_f32_32x32x16_bf16(pa0, PK(l0, h0), od, 0, 0, 0);
  od = __builtin_amdgcn_mfma_f32_32x32x16_bf16(pa1, PK(l1, h1), od, 0, 0, 0);
  od = __builtin_amdgcn_mfma_f32_32x32x16_bf16(pa2, PK(l2, h2), od, 0, 0, 0);
  od = __builtin_amdgcn_mfma_f32_32x32x16_bf16(pa3, PK(l3, h3), od, 0, 0, 0);
#undef PK
}
__device__ __forceinline__ void pv_d0(f32x16* o, int vb, bf16x8 pa0, bf16x8 pa1, bf16x8 pa2, bf16x8 pa3) {
  pv_one<0>(o[0], vb, pa0, pa1, pa2, pa3); pv_one<1>(o[1], vb, pa0, pa1, pa2, pa3);
}
__device__ __forceinline__ void attn_unit(const bf16_t* __restrict__ Qb, const bf16_t* __restrict__ KVh, const bf16_t* __restrict__ KRr, bf16_t* __restrict__ Ob, int seq, char* lds) {
  int tid_ = threadIdx.x; asm volatile("" : "+v"(tid_));
  const int tid = tid_, wid = tid >> 6, lane = tid & 63, r32 = lane & 31, hi = lane >> 5;
  char* V_lds = lds; char* K_lds = lds + 2 * SHM_V;
  float* ws = (float*)(lds + 2 * SHM_V + 2 * SHM_K) + wid * 64; float* li_l = ws; float* al_l = ws + 32;
  float m_reg = -1e30f, l_reg = 0; f32x16 o[2] = {}; bf16x8 qr[6];
  const bf16_t* Qw = Qb + (long)(wid * 32 + r32) * 768 + hi * 8;
#pragma unroll
  for (int d0 = 0; d0 < 6; ++d0) qr[d0] = *reinterpret_cast<const bf16x8*>(Qw + d0 * 16);
  const int sr = tid >> 4, sc = (tid & 15) * 8, vst0 = v_st(sr, sc & 63), vst1 = v_st(32 + sr, sc & 63);
  const bool kn = sc < 64, krp = (sc >= 64 && sc < 96);
  const int vb0 = (int)(uintptr_t)V_lds + v_rd_base(lane);
  struct { bf16x8 vs0, vs1, ks0, ks1; } sr_[2];
#define SLOAD(i, k0) do { if (kn) { sr_[i].vs0 = *reinterpret_cast<const bf16x8*>(&KVh[(long)((k0) + sr) * 1024 + 64 + sc]); sr_[i].vs1 = *reinterpret_cast<const bf16x8*>(&KVh[(long)((k0) + 32 + sr) * 1024 + 64 + sc]); \
      sr_[i].ks0 = *reinterpret_cast<const bf16x8*>(&KVh[(long)((k0) + sr) * 1024 + sc]); sr_[i].ks1 = *reinterpret_cast<const bf16x8*>(&KVh[(long)((k0) + 32 + sr) * 1024 + sc]); } \
    else if (krp) { sr_[i].ks0 = *reinterpret_cast<const bf16x8*>(&KRr[(long)((k0) + sr) * 32 + sc - 64]); sr_[i].ks1 = *reinterpret_cast<const bf16x8*>(&KRr[(long)((k0) + 32 + sr) * 32 + sc - 64]); } } while (0)
#define SWRITE(b, i) do { if (kn) { *(bf16x8*)(V_lds + (b) * SHM_V + vst0) = sr_[i].vs0; *(bf16x8*)(V_lds + (b) * SHM_V + vst1) = sr_[i].vs1; } \
    if (kn || krp) { int kc = sc * 2; *(bf16x8*)(K_lds + (b) * SHM_K + KSWZ(sr, kc)) = sr_[i].ks0; *(bf16x8*)(K_lds + (b) * SHM_K + KSWZ(32 + sr, kc)) = sr_[i].ks1; } } while (0)
#define RESC(a) do { if (__any((a) < 1.f)) { if (hi == 0) al_l[r32] = (a); asm volatile("s_waitcnt lgkmcnt(0)" ::: "memory"); \
    _Pragma("unroll") for (int d = 0; d < 2; ++d) _Pragma("unroll") for (int r = 0; r < 16; ++r) o[d][r] *= al_l[crow(r, hi)]; } } while (0)
  f32x16 pA0, pA1, pB0, pB1; float mnA, mnB, alA, alB; bf16x8 pa0, pa1, pa2, pa3; const int NT = seq / KVBLK;
  SLOAD(0, 0); SWRITE(0, 0); __syncthreads();
  qkt(pA0, pA1, K_lds, qr, r32, hi); partialSM(pA0, pA1, m_reg, mnA, alA);
  SLOAD(1, KVBLK); if (2 < NT) SLOAD(0, 2 * KVBLK);
  SWRITE(1, 1); __syncthreads();
  for (int j = 1; j + 1 < NT; j += 2) {
    SBAR(); qkt(pB0, pB1, K_lds + SHM_K, qr, r32, hi);
    finishSM(pA0, pA1, alA, l_reg, pa0, pa1, pa2, pa3); SBAR();
    SLOAD(1, (j + 2) * KVBLK); SBAR();
    pv_d0(o, vb0, pa0, pa1, pa2, pa3); partialSM(pB0, pB1, m_reg, mnB, alB);
    __syncthreads(); SWRITE(0, 0);
    RESC(alB); __syncthreads();
    SBAR(); qkt(pA0, pA1, K_lds, qr, r32, hi);
    finishSM(pB0, pB1, alB, l_reg, pa0, pa1, pa2, pa3); SBAR();
    if (j + 3 < NT) SLOAD(0, (j + 3) * KVBLK); SBAR();
    pv_d0(o, vb0 + SHM_V, pa0, pa1, pa2, pa3); partialSM(pA0, pA1, m_reg, mnA, alA);
    __syncthreads(); SWRITE(1, 1);
    RESC(alA); __syncthreads();
  }
  SBAR(); qkt(pB0, pB1, K_lds + SHM_K, qr, r32, hi);
  finishSM(pA0, pA1, alA, l_reg, pa0, pa1, pa2, pa3); SBAR();
  pv_d0(o, vb0, pa0, pa1, pa2, pa3); partialSM(pB0, pB1, m_reg, mnB, alB);
  __syncthreads(); RESC(alB);
  finishSM(pB0, pB1, alB, l_reg, pa0, pa1, pa2, pa3); SBAR();
  pv_d0(o, vb0 + SHM_V, pa0, pa1, pa2, pa3);
  if (hi == 0) li_l[r32] = l_reg; asm volatile("s_waitcnt lgkmcnt(0)" ::: "memory");
  float rli[16];
#pragma unroll
  for (int r = 0; r < 16; ++r) rli[r] = __builtin_amdgcn_rcpf(li_l[crow(r, hi)]);
  bf16_t* Ow = Ob + (long)(wid * 32) * 512;
#pragma unroll
  for (int r = 0; r < 16; ++r) { int orow = crow(r, hi);
#pragma unroll
    for (int d0 = 0; d0 < 2; ++d0) Ow[(long)orow * 512 + d0 * 32 + r32] = (bf16_t)f2bf(o[d0][r] * rli[r]); }
  __syncthreads();
#undef SLOAD
#undef SWRITE
#undef RESC
}
#undef KSWZ
#undef SBAR
}

struct Args { const float* in[29]; float* out; unsigned char* ws; int ph_lo, ph_hi, use_bar, pad; };
enum { I_XP = 0, I_XS, I_CCKV, I_CKR, I_C, I_CCTX, I_WADA, I_BADA, I_NORMG, I_WUP, I_WDN, I_WIN, I_HCW, I_HCB, I_FW1, I_FB1, I_FW2, I_FB2, I_FW3, I_SKIP,
       I_WHY, I_QNG, I_WQB, I_KVNG, I_WKVB, I_WMLA, I_WFN, I_WOUT, I_FING };

struct Frame {
    LAS unsigned char* lds; char* ldsg;
    int G, bid;
    unsigned char* ws;
};
#define WSP(T, off) ((T*)(F.ws + (off)))
#define TLW() int tid_ = threadIdx.x; asm volatile("" : "+v"(tid_)); const int tid = tid_, lane = tid & 63, wave = __builtin_amdgcn_readfirstlane(tid >> 6); (void)lane; (void)wave
__device__ __forceinline__ const float* argin(int i) { size_t off = (size_t)i * 8; asm volatile("" : "+s"(off)); const __attribute__((address_space(4))) char* k = (const __attribute__((address_space(4))) char*)__builtin_amdgcn_kernarg_segment_ptr(); return (const float*)(*(const GAS float* const __attribute__((address_space(4)))*)(k + off)); }
#define AIN(i) argin(i)

enum { CK_ID = 0, CK_UP, CK_IN, CK_QB };
__device__ __forceinline__ bf16_t* conv_dst(int kind, bf16_t* d0, bf16_t* d1, int ldd, int n) {
    if (kind == CK_ID) return d0 + (size_t)n * ldd;
    if (kind == CK_UP) { const int isU = n >= DFF, f = n - DFF * isU; const int R = (f >> 7) * 256 + ((f >> 6) & 1) * 128 + ((f >> 4) & 3) * 32 + 16 * isU + (f & 15); return d0 + (size_t)R * ldd; }
    if (kind == CK_IN) {
        if (n < 768) return d1 + (size_t)n * ldd;
        if (n < 1024) return d0 + (size_t)(n - 768) * ldd;
        if (n < 1152) return d0 + (size_t)(256 + n - 1024) * ldd;
        if (n < 1184) { const int p = n - 1152, part = p >> 4, w = p & 15, half = w >> 3, i = w & 7; return d0 + (size_t)(384 + part * 16 + 2 * i + half) * ldd; }
        if (n < 1440) return nullptr;
        return d0 + (size_t)(512 + n - 1440) * ldd;
    }
    { const int h = n / 96, w96 = n - h * 96; int d = w96;
      if (w96 >= 64) { const int p = w96 - 64, part = p >> 4, w = p & 15, half = w >> 3, i = w & 7; d = 64 + part * 16 + 2 * i + half; }
      return d0 + (size_t)(h * 96 + d) * ldd; }
}
__device__ __forceinline__ void conv_item(const float* W, int ldw, int k0, int n0, int kind, bf16_t* d0, bf16_t* d1, int ldd, const float* kscale, bf16_t* dextra, LAS float* scr, int lane) {
#pragma unroll 8
    for (int i = 0; i < 32; ++i) { const int kk = 2 * i + (lane >> 5); scr[kk * 33 + (lane & 31)] = W[(size_t)(k0 + kk) * ldw + n0 + (lane & 31)]; }
    asm volatile("s_waitcnt lgkmcnt(0)" ::: "memory");
    const int c = lane & 7;
    float ks[8];
#pragma unroll
    for (int e = 0; e < 8; ++e) ks[e] = kscale ? kscale[k0 + 8 * c + e] : 1.0f;
#pragma unroll
    for (int j = 0; j < 4; ++j) { const int n = (lane >> 3) + 8 * j; const LAS float* s = scr + (8 * c) * 33 + n;
        bf16_t* dp = conv_dst(kind, d0, d1, ldd, n0 + n);
        if (dp) { u32x4 o; o.x = pk2(s[0 * 33] * ks[0], s[1 * 33] * ks[1]); o.y = pk2(s[2 * 33] * ks[2], s[3 * 33] * ks[3]); o.z = pk2(s[4 * 33] * ks[4], s[5 * 33] * ks[5]); o.w = pk2(s[6 * 33] * ks[6], s[7 * 33] * ks[7]);
            *(u32x4*)(dp + k0 + 8 * c) = o;
            if (dextra) { u32x4 r; r.x = pk2(s[0 * 33], s[1 * 33]); r.y = pk2(s[2 * 33], s[3 * 33]); r.z = pk2(s[4 * 33], s[5 * 33]); r.w = pk2(s[6 * 33], s[7 * 33]); *(u32x4*)(dextra + (size_t)(n0 + n) * ldd + k0 + 8 * c) = r; } } }
    asm volatile("s_waitcnt lgkmcnt(0)" ::: "memory");
}

__device__ __forceinline__ void p0_phase(Frame& F, const Args& A) {
    TLW();
    LAS float* scr = (LAS float*)(F.lds + wave * 16384);
    const int gw = F.bid * NWAVES + wave, NGW = F.G * NWAVES;
    const int gt = F.bid * NTHR + tid, NGT = F.G * NTHR;
    {
        constexpr int I_UP = 16 * 176, I_DN = 44 * 32, I_IN = 16 * 141, I_QB = 4 * 24, I_KVB = 2 * 32, I_HY = 4 * 32, I_MLA = 8 * 32, I_FN = 4 * 32, I_OUT = 16 * 32;
        constexpr int PER_L = 2 * I_UP + 2 * I_DN + I_IN + I_QB + I_KVB + I_HY + I_MLA + I_FN + I_OUT;
        for (int it = gw; it < 2 * PER_L; it += NGW) {
            const int l = it / PER_L; int r = it - l * PER_L;
            if (r < 2 * I_UP) { const int f = r / I_UP; r -= f * I_UP; const int nb = 176, kb = r / nb, n_ = r % nb;
                conv_item(AIN(I_WUP) + (size_t)(l * 2 + f) * DM * NUP, NUP, kb * 64, n_ * 32, CK_UP, WSP(bf16_t, WS_WUP) + (size_t)(l * 2 + f) * NUP * DM, nullptr, DM, nullptr, nullptr, scr, lane); continue; }
            r -= 2 * I_UP;
            if (r < 2 * I_DN) { const int f = r / I_DN; r -= f * I_DN; const int nb = 32, kb = r / nb, n_ = r % nb;
                conv_item(AIN(I_WDN) + (size_t)(l * 2 + f) * DFF * DM, DM, kb * 64, n_ * 32, CK_ID, WSP(bf16_t, WS_WDN) + (size_t)(l * 2 + f) * DM * DFF, nullptr, DFF, nullptr, nullptr, scr, lane); continue; }
            r -= 2 * I_DN;
            if (r < I_IN) { const int nb = 141, kb = r / nb, n_ = r % nb;
                conv_item(AIN(I_WIN) + (size_t)l * DM * INC, INC, kb * 64, n_ * 32, CK_IN, WSP(bf16_t, WS_W1T) + (size_t)l * N1 * DM, WSP(bf16_t, WS_W2T) + (size_t)l * N2 * DM, DM, nullptr, nullptr, scr, lane); continue; }
            r -= I_IN;
            if (r < I_QB) { const int nb = 24, kb = r / nb, n_ = r % nb;
                conv_item(AIN(I_WQB) + (size_t)l * 256 * 768, 768, kb * 64, n_ * 32, CK_QB, WSP(bf16_t, WS_WQB) + (size_t)l * 768 * 256, nullptr, 256, AIN(I_QNG) + l * 256, nullptr, scr, lane); continue; }
            r -= I_QB;
            if (r < I_KVB) { const int nb = 32, kb = r / nb, n_ = r % nb;
                conv_item(AIN(I_WKVB) + (size_t)l * 128 * 1024, 1024, kb * 64, n_ * 32, CK_ID, WSP(bf16_t, WS_WKVB) + (size_t)l * 1024 * 256, nullptr, 256, AIN(I_KVNG) + l * 128, WSP(bf16_t, WS_WKVR) + (size_t)l * 1024 * 256, scr, lane); continue; }
            r -= I_KVB;
            if (r < I_HY) { const int nb = 32, kb = r / nb, n_ = r % nb;
                conv_item(AIN(I_WHY) + (size_t)l * 256 * 1024, 1024, kb * 64, n_ * 32, CK_ID, WSP(bf16_t, WS_WHY) + (size_t)l * 1024 * 256, nullptr, 256, nullptr, nullptr, scr, lane); continue; }
            r -= I_HY;
            if (r < I_MLA) { const int nb = 32, kb = r / nb, n_ = r % nb;
                conv_item(AIN(I_WMLA) + (size_t)l * 512 * 1024, 1024, kb * 64, n_ * 32, CK_ID, WSP(bf16_t, WS_WMLA) + (size_t)l * 1024 * 512, nullptr, 512, nullptr, nullptr, scr, lane); continue; }
            r -= I_MLA;
            if (r < I_FN) { const int nb = 32, kb = r / nb, n_ = r % nb;
                conv_item(AIN(I_WFN) + (size_t)l * 256 * 1024, 1024, kb * 64, n_ * 32, CK_ID, WSP(bf16_t, WS_WFN) + (size_t)l * 1024 * 256, nullptr, 256, nullptr, nullptr, scr, lane); continue; }
            r -= I_FN;
            { const int nb = 32, kb = r / nb, n_ = r % nb;
                conv_item(AIN(I_WOUT) + (size_t)l * 1024 * 1024, 1024, kb * 64, n_ * 32, CK_ID, WSP(bf16_t, WS_WOUT) + (size_t)l * 1024 * 1024, nullptr, 1024, nullptr, nullptr, scr, lane); }
        }
    }
    __syncthreads();
    LAS float* scv = (LAS float*)(F.lds);
    LAS float* ctab = (LAS float*)(F.lds + 16384);
    for (int i = tid; i < 3 * DM; i += NTHR) { const int g = i >> 10, k = i & 1023; const float c = (g == 0) ? AIN(I_CCTX)[k] : AIN(I_C)[(g - 1) * DM + k]; scv[i] = siluf_(c); }
    for (int i = tid; i < 2048; i += NTHR) ctab[i] = cospif((float)i * (1.0f / 1024.0f));
    __syncthreads();
    for (int it = gw; it < 2 * 4 * 16 * 4; it += NGW) {
        const int mq = it & 3, kc = (it >> 2) & 15, g = (it >> 6) & 3, l = it >> 8; const int k = kc * 64 + lane;
        const float* src = AIN(I_WIN) + (size_t)l * DM * INC + (size_t)k * INC + 1184 + g * 64;
        float x[64];
#pragma unroll
        for (int j = 0; j < 16; ++j) { const f32x4 v = *(const f32x4*)(src + 4 * j); x[4 * j] = v[0]; x[4 * j + 1] = v[1]; x[4 * j + 2] = v[2]; x[4 * j + 3] = v[3]; }
        bf16_t* dst = WSP(bf16_t, WS_W2T) + (size_t)l * N2 * DM;
        for (int mm = 0; mm < 16; ++mm) { const int m = mq * 16 + mm; float sc_ = 0.f, ss_ = 0.f;
#pragma unroll
            for (int j = 0; j < 64; ++j) { const int ph = (j * m) & 63; sc_ += x[j] * ctab[ph * 32]; ss_ += x[j] * ctab[((ph + 48) & 63) * 32]; }
            dst[(size_t)(768 + g * 64 + m) * DM + k] = (bf16_t)f2bf(sc_); dst[(size_t)(1024 + g * 64 + m) * DM + k] = (bf16_t)f2bf(ss_); }
    }
    for (int it = gw; it < 2 * 16 * 36; it += NGW) {
        const int cc = it % 36, kc = (it / 36) & 15, l = it / (36 * 16);
        const float* wp = AIN(I_WADA) + (size_t)l * DM * NADA + (size_t)(kc * 64) * NADA + cc * 256 + lane * 4;
        f32x4 a0 = {0, 0, 0, 0}, a1 = a0, a2 = a0;
#pragma unroll 8
        for (int k = 0; k < 64; ++k) { const f32x4 w = *(const f32x4*)(wp + (size_t)k * NADA); const int kk = kc * 64 + k; a0 += w * scv[kk]; a1 += w * scv[1024 + kk]; a2 += w * scv[2048 + kk]; }
        float* op = WSP(float, WS_ADAP) + ((size_t)(kc * 2 + l) * 3) * NADA + cc * 256 + lane * 4;
        *(f32x4*)op = a0; *(f32x4*)(op + NADA) = a1; *(f32x4*)(op + 2 * NADA) = a2;
    }
    for (int it = gw; it < 2 * 288; it += NGW) {
        const int l = it / 288, r0 = (it % 288) * 8;
        const float* W1 = AIN(I_FW1) + l * 17 * 64; const float* W2 = AIN(I_FW2) + l * 64 * 64;
        float w1c[17], w2c[64];
#pragma unroll
        for (int i = 0; i < 17; ++i) w1c[i] = W1[i * 64 + lane];
#pragma unroll
        for (int k = 0; k < 64; ++k) w2c[k] = W2[k * 64 + lane];
        const float b1 = AIN(I_FB1)[l * 64 + lane], b2 = AIN(I_FB2)[l * 64 + lane];
        for (int rr = 0; rr < 8; ++rr) { const int row = r0 + rr; const int L = row < 256 ? 256 : 2048, t = row < 256 ? row : row - 256;
            float feat = 0.f;
            { const float tn = (float)t / (float)(L - 1), w = 6.283185307179586f * (float)t / (float)L;
              const int bi = (lane >= 9) ? lane - 9 : lane - 1; const float band = 1e-4f + (float)bi * ((7.0f - 1e-4f) / 7.0f); const float ang = w * band;
              feat = (lane == 0) ? tn : ((lane <= 8) ? cosf(ang) : -sinf(ang)); }
            float h1 = b1;
#pragma unroll
            for (int i = 0; i < 17; ++i) h1 += __builtin_bit_cast(float, __builtin_amdgcn_readlane(__builtin_bit_cast(int, feat), i)) * w1c[i];
            h1 = sinf(h1);
            float h2 = b2;
#pragma unroll
            for (int k = 0; k < 64; ++k) h2 += __builtin_bit_cast(float, __builtin_amdgcn_readlane(__builtin_bit_cast(int, h1), k)) * w2c[k];
            h2 = sinf(h2);
            WSP(float, WS_H2)[((size_t)l * 2304 + row) * 64 + lane] = h2; }
    }
    if (F.bid == 0) { const int pos = tid >> 3, i = tid & 7; const float inv = exp2f(-(float)i * (13.287712379549449f / 8.0f)); float s, c; sincosf((float)pos * inv, &s, &c);
        WSP(float, WS_ROPE)[(pos * 8 + i) * 2] = c; WSP(float, WS_ROPE)[(pos * 8 + i) * 2 + 1] = s; }
    for (int it = gt; it < 2048 * 512 + 256 * 64; it += NGT) {
        const bool isl = it < 2048 * 512; const int L = isl ? 2048 : 256, j = isl ? it : it - 2048 * 512, per = 2 * L / 8, k = j / per, t8 = (j % per) * 8, sh = isl ? 0 : 3;
        float v[8];
#pragma unroll
        for (int e = 0; e < 8; ++e) { const int tt = t8 + e, isS = tt >= L, t = tt - isS * L; const int ph = (k * t) & (L - 1);
            v[e] = isS ? -ctab[(((ph - L / 4) & (L - 1)) << sh)] : ctab[ph << sh]; }
        u32x4 o; o.x = pk2(v[0], v[1]); o.y = pk2(v[2], v[3]); o.z = pk2(v[4], v[5]); o.w = pk2(v[6], v[7]);
        *(u32x4*)((isl ? WSP(bf16_t, WS_DFTL) : WSP(bf16_t, WS_DFTC)) + (size_t)k * 2 * L + t8) = o;
    }
    for (int it = gt; it < 2 * 1024 * 32; it += NGT) { const int c8 = (it & 31) * 8, row = (it >> 5) & 1023, l = it >> 15; const int b = row >> 9, j = row & 511;
        u32x4 o = {0, 0, 0, 0};
        if (c8 < 128) { const float* sp = AIN(I_CCKV) + ((size_t)((b * 2 + l) * 512 + j)) * 128 + c8; const f32x4 x = *(const f32x4*)sp, y = *(const f32x4*)(sp + 4);
            o.x = pk2(x[0], x[1]); o.y = pk2(x[2], x[3]); o.z = pk2(y[0], y[1]); o.w = pk2(y[2], y[3]); }
        *(u32x4*)(WSP(bf16_t, WS_CKVB) + ((size_t)l * 1024 + row) * 256 + c8) = o; }
    for (int it = gt; it < 2 * 96 * 128; it += NGT) { const int c8 = (it & 127) * 8, r = (it >> 7) % 96, l = it / (96 * 128);
        *(u32x4*)(WSP(bf16_t, WS_W1T) + ((size_t)l * N1 + 416 + r) * DM + c8) = (u32x4){0, 0, 0, 0}; }
    for (int it = gt; it < 2 * 2 * 1024 * 16; it += NGT) { const int c8 = 128 + (it & 15) * 8, r = (it >> 4) & 1023, l = (it >> 14) & 1, wsel = it >> 15;
        *(u32x4*)((wsel ? WSP(bf16_t, WS_WKVR) : WSP(bf16_t, WS_WKVB)) + ((size_t)l * 1024 + r) * 256 + c8) = (u32x4){0, 0, 0, 0}; }
    __syncthreads();
}

__device__ __forceinline__ void norm_phase(Frame& F, const Args& A, int l, int which, bool first, bool from_partials) {
    TLW();
    LAS float* gm = (LAS float*)(F.lds);
    LAS float* sv = (LAS float*)(F.lds + 12288);
    for (int i = tid; i < 3 * DM; i += NTHR) { const int g = i >> 10, c = i & 1023; float s, sc;
        if (from_partials) { s = AIN(I_BADA)[l * NADA + (3 * which) * DM + c]; sc = AIN(I_BADA)[l * NADA + (3 * which + 1) * DM + c];
            for (int kc = 0; kc < 16; ++kc) { const float* pp = WSP(float, WS_ADAP) + ((size_t)(kc * 2 + l) * 3 + g) * NADA; s += pp[(3 * which) * DM + c]; sc += pp[(3 * which + 1) * DM + c]; } }
        else { const float* ad = WSP(float, WS_ADA) + ((size_t)l * 3 + g) * NADA; s = ad[(3 * which) * DM + c]; sc = ad[(3 * which + 1) * DM + c]; }
        gm[i] = AIN(I_NORMG)[(l * 3 + which) * DM + c] * (1.0f + sc); sv[i] = s; }
    __syncthreads();
    const int gw = F.bid * NWAVES + wave, NGW = F.G * NWAVES;
    for (int r = gw; r < MTOK; r += NGW) {
        const float* src = first ? (r < NCTX ? AIN(I_XP) + (size_t)r * DM : AIN(I_XS) + (size_t)(r - NCTX) * DM) : WSP(float, WS_H) + (size_t)r * DM;
        const int g = r < NCTX ? 0 : 1 + ((r - NCTX) >> 11);
        f32x4 v[4]; float s = 0.f;
#pragma unroll
        for (int j = 0; j < 4; ++j) { v[j] = *(const f32x4*)(src + 4 * lane + 256 * j); s += (v[j][0] * v[j][0] + v[j][1] * v[j][1]) + (v[j][2] * v[j][2] + v[j][3] * v[j][3]); }
        const float rstd = 1.0f / sqrtf(wave_sum(s) * (1.0f / DM) + EPSV);
        bf16_t* np = WSP(bf16_t, WS_N) + (size_t)r * DM;
#pragma unroll
        for (int j = 0; j < 4; ++j) { const int c = 4 * lane + 256 * j; const f32x4 gg = *(const LAS f32x4*)(gm + g * DM + c), ss = *(const LAS f32x4*)(sv + g * DM + c);
            const f32x4 y = v[j] * rstd * gg + ss; u32x2 w; w.x = cvtpk(y[0], y[1]); w.y = cvtpk(y[2], y[3]); *(u32x2*)(np + c) = w;
            if (first) *(f32x4*)(WSP(float, WS_H) + (size_t)r * DM + c) = v[j]; }
    }
    __syncthreads();
}
__device__ __forceinline__ void final_norm_phase(Frame& F, const Args& A) {
    TLW();
    const int gw = F.bid * NWAVES + wave, NGW = F.G * NWAVES;
    for (int r = gw; r < MTOK; r += NGW) {
        const float* src = WSP(float, WS_H) + (size_t)r * DM;
        f32x4 v[4]; float s = 0.f;
#pragma unroll
        for (int j = 0; j < 4; ++j) { v[j] = *(const f32x4*)(src + 4 * lane + 256 * j); s += (v[j][0] * v[j][0] + v[j][1] * v[j][1]) + (v[j][2] * v[j][2] + v[j][3] * v[j][3]); }
        const float rstd = 1.0f / sqrtf(wave_sum(s) * (1.0f / DM) + EPSV);
#pragma unroll
        for (int j = 0; j < 4; ++j) { const int c = 4 * lane + 256 * j; const f32x4 gg = *(const f32x4*)(AIN(I_FING) + c); *(f32x4*)(A.out + (size_t)r * DM + c) = v[j] * rstd * gg; }
    }
}

__device__ __forceinline__ void p0b_phase(Frame& F, const Args& A) {
    TLW();
    const int gt = F.bid * NTHR + tid, NGT = F.G * NTHR, gw = F.bid * NWAVES + wave, NGW = F.G * NWAVES;
    for (int it = gt; it < 2 * 3 * NADA; it += NGT) { const int c = it % NADA, g = (it / NADA) % 3, l = it / (3 * NADA); float s = AIN(I_BADA)[l * NADA + c];
        for (int kc = 0; kc < 16; ++kc) s += WSP(float, WS_ADAP)[((size_t)(kc * 2 + l) * 3 + g) * NADA + c];
        WSP(float, WS_ADA)[((size_t)l * 3 + g) * NADA + c] = s; }
    for (int it = gw; it < 2 * 36 * 16; it += NGW) {
        const int cc = it & 15, rc = (it >> 4) % 36, l = it / (36 * 16); const int row = rc * 64 + lane, L = rc < 4 ? 256 : 2048, t = rc < 4 ? row : row - 256;
        const float* hp = WSP(float, WS_H2) + ((size_t)l * 2304 + row) * 64;
        float h[64];
#pragma unroll
        for (int j = 0; j < 16; ++j) { const f32x4 v = *(const f32x4*)(hp + 4 * j); h[4 * j] = v[0]; h[4 * j + 1] = v[1]; h[4 * j + 2] = v[2]; h[4 * j + 3] = v[3]; }
        const float tn = (float)t / (float)(L - 1);
        float* fb = WSP(float, WS_FILT) + (size_t)l * FILT_LAYER + (rc < 4 ? (size_t)512 * 4096 : 0);
        const float* W3 = AIN(I_FW3) + (size_t)l * 64 * 1024;
        for (int ci = 0; ci < 64; ++ci) { const int col = cc * 64 + ci;
            float s = 0.f;
#pragma unroll
            for (int k = 0; k < 64; ++k) s += h[k] * W3[k * 1024 + col];
            const int ch = col & 255, oc = col & 511, dir = col >> 9;
            const float delta = -3.0701134573253944f + (float)ch * ((-15.350567286626972f + 3.0701134573253944f) / 255.0f);
            s *= expf(-tn * fabsf(delta));
            float* fr = fb + (size_t)oc * (2 * L);
            if (dir == 0) fr[L + t] = s; else if (t > 0) fr[L - t] = s;
            if (dir == 1 && t == 0) fr[0] = 0.f; }
    }
}

__device__ __forceinline__ void hyena_unit(Frame& F, const Args& A, int l, int unit) {
    TLW();
    const bool lat = unit < 512; const int uu = lat ? unit : unit - 512; const int sb = uu >> 8, c = uu & 255;
    const int L = lat ? 2048 : 256, tok0 = lat ? NCTX + sb * 2048 : sb * 2048;
    LAS float* Uv = (LAS float*)(F.lds);
    LAS float* Ux1 = Uv + 2048; LAS float* Ux2 = Ux1 + 2048; LAS float* Uz = Ux2 + 2048;
    LAS float* G0 = Uz + 2048;
    LAS float* G1 = G0 + 4104;
    LAS float* red = G1 + 4104;
    const bf16_t* hyt = WSP(bf16_t, WS_HYT);
    for (int i = tid; i < 3 * 2048; i += NTHR) { const int which = i >> 11, p = i & 2047, t = p & (L - 1); const int ch = (which == 0 ? 512 : (which == 1 ? 0 : 256)) + c;
        const bf16_t* hp = hyt + (size_t)ch * MTOK + tok0 + p; const float* cw = AIN(I_HCW) + (size_t)l * 3 * 768 + ch;
        const float xm = t > 0 ? bf2f(hp[-1]) : 0.f, x0 = bf2f(hp[0]), xp = t < L - 1 ? bf2f(hp[1]) : 0.f;
        const float val = xm * cw[0] + x0 * cw[768] + xp * cw[1536] + AIN(I_HCB)[l * 768 + ch];
        (which == 0 ? Uv : (which == 1 ? Ux1 : Ux2))[p] = val; }
    const float* fb = WSP(float, WS_FILT) + (size_t)l * FILT_LAYER + (lat ? 0 : (size_t)512 * 4096);
    float asum0 = 0.f, asum1 = 0.f;
    for (int i = tid; i < 2 * L + 4; i += NTHR) { const int j = i - 3; float f0 = 0.f, f1 = 0.f;
        if (j >= 0 && j < 2 * L) { f0 = fb[(size_t)c * (2 * L) + j]; f1 = fb[(size_t)(256 + c) * (2 * L) + j]; }
        G0[i] = f0; G1[i] = f1; asum0 += fabsf(f0); asum1 += fabsf(f1); }
    asum0 = wave_sum(asum0); asum1 = wave_sum(asum1);
    if (lane == 0) { red[wave] = asum0; red[8 + wave] = asum1; }
    __syncthreads();
    float n0 = 0.f, n1 = 0.f;
#pragma unroll
    for (int w = 0; w < 8; ++w) { n0 += red[w]; n1 += red[8 + w]; }
    const float inv0 = 1.0f / (n0 + EPSV), inv1 = 1.0f / (n1 + EPSV);
    const float sk0 = AIN(I_SKIP)[(l * 2 + 0) * 256 + c], sk1 = AIN(I_SKIP)[(l * 2 + 1) * 256 + c];
    const int o4 = 4 * tid, seg = o4 / L, t0 = o4 - seg * L, ub = seg * L;
#pragma unroll 1
    for (int ord = 0; ord < 2; ++ord) {
        const LAS float* U = ord == 0 ? Uv : Uz; const LAS float* G = ord == 0 ? G0 : G1;
        float acc[4] = {0.f, 0.f, 0.f, 0.f};
        for (int s0 = 0; s0 < L; s0 += 4) {
            const f32x4 u4 = *(const LAS f32x4*)(U + ub + s0);
            const int i0 = t0 - s0 + L;
            const f32x4 ga = *(const LAS f32x4*)(G + i0), gb = *(const LAS f32x4*)(G + i0 + 4);
            const float g[8] = {ga[0], ga[1], ga[2], ga[3], gb[0], gb[1], gb[2], gb[3]};
#pragma unroll
            for (int a = 0; a < 4; ++a)
#pragma unroll
                for (int b = 0; b < 4; ++b) acc[a] += g[a - b + 3] * u4[b];
        }
        if (ord == 0) {
#pragma unroll
            for (int a = 0; a < 4; ++a) Uz[o4 + a] = Ux1[o4 + a] * (acc[a] * inv0 + sk0 * Uv[o4 + a]);
            __syncthreads();
        } else {
#pragma unroll
            for (int a = 0; a < 4; ++a) { const float z = Ux2[o4 + a] * (acc[a] * inv1 + sk1 * Uz[o4 + a]); WSP(bf16_t, WS_Z)[(size_t)(tok0 + o4 + a) * 256 + c] = (bf16_t)f2bf(z); }
        }
    }
    __syncthreads();
}

constexpr int ST_PER_LAYER = 21, N_STEPS = 3 + 2 * ST_PER_LAYER;
#ifndef MK_ONE_LAUNCH
#define MK_ONE_LAUNCH 0
#endif
#ifndef PHSEL
#define PHSEL -1
#endif
#define PSEL(k) (PHSEL < 0 || PHSEL == (k))
__host__ __device__ constexpr bool bar_after(int st) {
    if (st < 3) return st != 1;
    const int s = (st - 3) % ST_PER_LAYER;
    return !(s == 3 || s == 5 || s == 6 || s == 7 || s == 9 || s == 10 || s == 11 || s == 13 || s == 14);
}

template <class Epi> __device__ __forceinline__ void run_gemm(Frame& F, const bf16_t* Ap, int lda, const bf16_t* Bp, int ldb, int M, int N, int K, int cshift, const Epi& E) {
    pg8::Gemm g{Ap, Bp, M, N, K, lda, ldb}; pg8::StaticOrder S; S.init(M, N, F.G, (F.bid + F.G - cshift) % F.G);
    pg8::gemm_phase<Epi, pg8::StaticOrder, true, true>(F.lds, g, S, E);
}

__global__ void __launch_bounds__(NTHR, 2) mk_fwd(Args args) {
    extern __shared__ __attribute__((aligned(16))) unsigned char lds[];
    Frame F;
    F.lds = (LAS unsigned char*)lds; F.ldsg = (char*)lds;
    F.G = gridDim.x; F.bid = blockIdx.x;
    volatile LAS unsigned* MISC = (volatile LAS unsigned*)(F.lds + MISC_OFF);
    for (int u = threadIdx.x; u < (LDS_BYTES - RING_BYTES) / 4; u += NTHR) ((LAS unsigned*)(F.lds + RING_BYTES))[u] = 0u;
    __syncthreads();
    const int lo = args.ph_lo, hi = args.ph_hi;
    XcdBarrier bar; bar.bar = (unsigned*)(args.ws + WS_CTL) + CW_BAR; bar.x = 0; bar.st = nullptr;
    if (args.use_bar) bar = xcd_barrier_post((unsigned*)(args.ws + WS_CTL) + CW_BAR, MISC + 8);
    const Args& A = args;

#pragma unroll 1
    for (int st = lo; st < hi; ++st) {
        { size_t z_ = 0; asm volatile("" : "+s"(z_)); F.ws = args.ws + z_; }
        if (st == 0) { if (PSEL(100)) p0_phase(F, A); }
        else if (st == 1) { if (PSEL(101)) p0b_phase(F, A); }
        else if (st == 2) { if (PSEL(102)) norm_phase(F, A, 0, 0, true, true); }
        else {
            const int l = (st - 3) / ST_PER_LAYER, s = (st - 3) % ST_PER_LAYER;
            const float* ada = WSP(float, WS_ADA) + (size_t)l * 3 * NADA;
            if ((s == 0 || s == 18) && PSEL(0)) {
                const int f = s == 0 ? 0 : 1;
                EpiSwiglu E{WSP(bf16_t, WS_ACT)};
                run_gemm(F, WSP(bf16_t, WS_N), DM, WSP(bf16_t, WS_WUP) + (size_t)(l * 2 + f) * NUP * DM, DM, MTOK, NUP, DM, 0, E);
            } else if ((s == 1 || s == 19) && PSEL(1)) {
                const int f = s == 1 ? 0 : 1;
                EpiResid E{WSP(float, WS_H), ada + (f == 0 ? 2 : 8) * DM, 0.5f};
                run_gemm(F, WSP(bf16_t, WS_ACT), DFF, WSP(bf16_t, WS_WDN) + (size_t)(l * 2 + f) * DM * DFF, DFF, MTOK, DM, DFF, 0, E);
            } else if (s == 2 && PSEL(2)) norm_phase(F, A, l, 1, false, false);
            else if (s == 3 && PSEL(3)) {
                EpiProj1 E1{WSP(bf16_t, WS_P1), WSP(float, WS_SSQ), WSP(float, WS_SSKV), WSP(float, WS_CKVRAW), WSP(float, WS_KRRAW)};
                run_gemm(F, WSP(bf16_t, WS_N), DM, WSP(bf16_t, WS_W1T) + (size_t)l * N1 * DM, DM, MTOK, N1, DM, 0, E1);
            } else if (s == 4 && PSEL(4)) {
                EpiT E2{WSP(bf16_t, WS_HYT), WSP(bf16_t, WS_XCTL), WSP(bf16_t, WS_XCTC)};
                run_gemm(F, WSP(bf16_t, WS_W2T) + (size_t)l * N2 * DM, DM, WSP(bf16_t, WS_N), DM, N2, MTOK, DM, 192, E2);
            } else if (s == 5 && PSEL(5)) {
                EpiQ EQ{WSP(bf16_t, WS_Q), WSP(float, WS_SSQ), WSP(float, WS_ROPE)};
                run_gemm(F, WSP(bf16_t, WS_P1), N1, WSP(bf16_t, WS_WQB) + (size_t)l * 768 * 256, 256, MTOK, 768, 256, 0, EQ);
            } else if (s == 6 && PSEL(6)) {
                EpiKV<false> EK{WSP(bf16_t, WS_KV), WSP(float, WS_SSKV)};
                run_gemm(F, WSP(bf16_t, WS_P1) + 256, N1, WSP(bf16_t, WS_WKVB) + (size_t)l * 1024 * 256, 256, MTOK, 1024, 256, 96, EK);
            } else if (s == 7 && PSEL(7)) {
                EpiKV<true> EC{WSP(bf16_t, WS_KV), nullptr};
                run_gemm(F, WSP(bf16_t, WS_CKVB) + (size_t)l * 1024 * 256, 256, WSP(bf16_t, WS_WKVR) + (size_t)l * 1024 * 256, 256, 1024, 1024, 256, 224, EC);
            } else if (s == 8 && PSEL(8)) {
                TLW(); const int gt = F.bid * NTHR + tid, NGT = F.G * NTHR;
                for (int it = gt; it < NCTX * 32; it += NGT) { const int r = it >> 5, c4 = (it & 31) * 4;
                    const f32x4 ss = *(const f32x4*)(WSP(float, WS_SSKV) + r * 4); const float rstd = 1.0f / sqrtf(((ss[0] + ss[1]) + (ss[2] + ss[3])) * (1.0f / 128.0f) + EPSV);
                    const f32x4 x = *(const f32x4*)(WSP(float, WS_CKVRAW) + (size_t)r * 128 + c4), g = *(const f32x4*)(AIN(I_KVNG) + l * 128 + c4);
                    *(f32x4*)(A.out + (size_t)MTOK * DM + ((size_t)((r >> 8) * 2 + l) * 256 + (r & 255)) * 128 + c4) = x * rstd * g; }
                for (int it = gt; it < MTOK * 4; it += NGT) { const int row = it >> 2, q = it & 3, part = q >> 1, ib = 4 * (q & 1);
                    const float* kp = WSP(float, WS_KRRAW) + (size_t)row * 32 + 8 * q; const f32x4 va = *(const f32x4*)kp, vb = *(const f32x4*)(kp + 4);
                    float v[8] = {va[0], va[1], va[2], va[3], vb[0], vb[1], vb[2], vb[3]};
                    if (row < NCTX) { float* op = A.out + (size_t)MTOK * DM + (size_t)16 * 2 * 256 * 128 + (size_t)((row >> 8) * 2 * 256 + l * 256 + (row & 255)) * 32 + part * 16 + ib;
#pragma unroll
                        for (int e = 0; e < 8; ++e) op[(e & 1) * 8 + (e >> 1)] = v[e];
                    } else { const int t = (row - NCTX) & 2047, pos = part == 0 ? (t >> 6) : (t & 63); const float* rt = WSP(float, WS_ROPE) + (pos * 8 + ib) * 2;
#pragma unroll
                        for (int e = 0; e < 8; e += 2) { const float cs = rt[e], sn = rt[e + 1], x1 = v[e], x2 = v[e + 1]; v[e] = x1 * cs - x2 * sn; v[e + 1] = x2 * cs + x1 * sn; } }
                    u32x4 w; w.x = cvtpk(v[0], v[1]); w.y = cvtpk(v[2], v[3]); w.z = cvtpk(v[4], v[5]); w.w = cvtpk(v[6], v[7]);
                    *(u32x4*)(WSP(bf16_t, WS_KR) + (size_t)kvrow_of(row) * 32 + 8 * q) = w; }
                for (int it = gt; it < 2 * 512 * 32; it += NGT) { const int pp = it & 31, j = (it >> 5) & 511, b = it >> 14; const int part = pp >> 4, w = pp & 15, i = w >> 1, half = w & 1, p = part * 16 + half * 8 + i;
                    WSP(bf16_t, WS_KR)[(size_t)(NCTX + b * 2560 + 2048 + j) * 32 + pp] = (bf16_t)f2bf(AIN(I_CKR)[((size_t)(b * 2 + l) * 512 + j) * 32 + p]); }
            } else if (s == 9 && PSEL(9)) {
                EpiFn EL{WSP(bf16_t, WS_FN), 1, 0.00276213586400995f};
                run_gemm(F, WSP(bf16_t, WS_DFTL), 4096, WSP(bf16_t, WS_XCTL), 4096, 2048, 512, 4096, 128, EL);
            } else if (s == 10 && PSEL(10)) {
                EpiFn EC{WSP(bf16_t, WS_FN), 0, 0.0078125f};
                run_gemm(F, WSP(bf16_t, WS_DFTC), 512, WSP(bf16_t, WS_XCTC), 512, 256, 4096, 512, 144, EC);
            } else if (s == 11 && PSEL(11)) {
                for (int u = F.bid; u < 256; u += F.G) {
                    const bf16_t *Qb, *KVh, *KRr; bf16_t* Ob; int seq;
                    if (u < 128) { const int b = u >> 6, h = (u >> 3) & 7, qb = u & 7; const int r0 = NCTX + b * 2048 + qb * 256, k0 = NCTX + b * 2560;
                        Qb = WSP(bf16_t, WS_Q) + (size_t)r0 * 768 + h * 96; KVh = WSP(bf16_t, WS_KV) + (size_t)k0 * 1024 + h * 128; KRr = WSP(bf16_t, WS_KR) + (size_t)k0 * 32; Ob = WSP(bf16_t, WS_O) + (size_t)r0 * 512 + h * 64; seq = 2560; }
                    else { const int v = u - 128, b = v >> 3, h = v & 7; const int r0 = b * 256;
                        Qb = WSP(bf16_t, WS_Q) + (size_t)r0 * 768 + h * 96; KVh = WSP(bf16_t, WS_KV) + (size_t)r0 * 1024 + h * 128; KRr = WSP(bf16_t, WS_KR) + (size_t)r0 * 32; Ob = WSP(bf16_t, WS_O) + (size_t)r0 * 512 + h * 64; seq = 256; }
                    att::attn_unit(Qb, KVh, KRr, Ob, seq, F.ldsg);
                }
            } else if (s == 12 && PSEL(12)) {
                for (int u = F.bid; u < 1024; u += F.G) hyena_unit(F, A, l, u);
            } else if (s == 13 && PSEL(13)) {
                EpiGate<0> E0{WSP(float, WS_Y), WSP(bf16_t, WS_N), WSP(bf16_t, WS_P1) + 512};
                run_gemm(F, WSP(bf16_t, WS_Z), 256, WSP(bf16_t, WS_WHY) + (size_t)l * 1024 * 256, 256, MTOK, DM, 256, 0, E0);
            } else if (s == 14 && PSEL(14)) {
                EpiGate<1> E1{WSP(float, WS_Y), WSP(bf16_t, WS_N), WSP(bf16_t, WS_P1) + 512 + 1024};
                run_gemm(F, WSP(bf16_t, WS_O), 512, WSP(bf16_t, WS_WMLA) + (size_t)l * 1024 * 512, 512, MTOK, DM, 512, 0, E1);
            } else if (s == 15 && PSEL(15)) {
                EpiGate<2> E2{WSP(float, WS_Y), WSP(bf16_t, WS_N), WSP(bf16_t, WS_P1) + 512 + 2048};
                run_gemm(F, WSP(bf16_t, WS_FN), 256, WSP(bf16_t, WS_WFN) + (size_t)l * 1024 * 256, 256, MTOK, DM, 256, 0, E2);
            } else if (s == 16 && PSEL(16)) {
                EpiResid E{WSP(float, WS_H), ada + 5 * DM, 1.0f};
                run_gemm(F, WSP(bf16_t, WS_N), DM, WSP(bf16_t, WS_WOUT) + (size_t)l * DM * DM, DM, MTOK, DM, DM, 0, E);
            } else if (s == 17 && PSEL(17)) norm_phase(F, A, l, 2, false, false);
            else if (s == 20 && PSEL(20)) { if (l == 0) norm_phase(F, A, 1, 0, false, false); else final_norm_phase(F, A); }
        }
        if (st + 1 < hi) { if (bar_after(st)) xcd_barrier(bar); else { asm volatile("s_waitcnt vmcnt(0)" ::: "memory"); __syncthreads(); } }
    }
}

extern "C" void kernel_launch(void* const* d_in, const int* in_sizes, int n_in, void* d_out, int out_size, void* d_ws, size_t ws_size, hipStream_t stream) {
    static int grid = 0;
    if (grid == 0) {
        if (n_in != 29 || ws_size < WS_END) { fprintf(stderr, "kernel_launch: n_in %d ws %zu (need %zu)\n", n_in, ws_size, (size_t)WS_END); grid = -1; return; }
        int dev = 0, cus = 0;
        if (hipGetDevice(&dev) != hipSuccess || hipDeviceGetAttribute(&cus, hipDeviceAttributeMultiprocessorCount, dev) != hipSuccess) { grid = -1; return; }
        if (hipFuncSetAttribute((const void*)mk_fwd, hipFuncAttributeMaxDynamicSharedMemorySize, LDS_BYTES) != hipSuccess) { fprintf(stderr, "kernel_launch: hipFuncSetAttribute failed\n"); grid = -1; return; }
        grid = cus;
    }
    if (grid < 0) return;
    (void)hipMemsetAsync((char*)d_ws + WS_CTL, 0, CTL_BYTES, stream);
    Args a{};
    for (int i = 0; i < 29; ++i) a.in[i] = (const float*)d_in[i];
    a.out = (float*)d_out; a.ws = (unsigned char*)d_ws;
#if MK_ONE_LAUNCH
    a.ph_lo = 0; a.ph_hi = N_STEPS; a.use_bar = 1;
    hipLaunchKernelGGL(mk_fwd, dim3(grid), dim3(NTHR), LDS_BYTES, stream, a);
#else
    a.use_bar = 0;
    for (int s0 = 0; s0 < N_STEPS;) { int s1 = s0; while (!bar_after(s1)) ++s1; a.ph_lo = s0; a.ph_hi = s1 + 1; hipLaunchKernelGGL(mk_fwd, dim3(grid), dim3(NTHR), LDS_BYTES, stream, a); s0 = s1 + 1; }
#endif
}
```

```cpp
#include <hip/hip_runtime.h>
#include <cstdio>
#include <cstdint>
namespace pg8 {
#define PG8_LAS __attribute__((address_space(3)))
typedef unsigned short bf16_t;
typedef short bf16x8 __attribute__((ext_vector_type(8)));
typedef float f32x4 __attribute__((ext_vector_type(4)));
typedef unsigned u32x4 __attribute__((ext_vector_type(4)));
constexpr int BM = 256, BK = 64, HALF = 128, HTB = HALF * BK * 2  , STAGE_BYTES = 8 * HTB, NXCD = 8, WGM = 8;

__host__ __device__ __forceinline__ int lds_byte(int r, int c) { const int st = (r >> 4) * 2 + (c >> 5), rr = r & 15, cc = c & 31, ob = rr * 64 + cc * 2; return st * 1024 + (ob ^ (((ob >> 9) & 1) << 5)); }
__host__ __device__ __forceinline__ void stage_rc(int b, int& R, int& C) { const int st = b / 1024, sb = b % 1024, swz = sb ^ (((sb >> 9) & 1) << 5); R = (st >> 1) * 16 + swz / 64; C = (st & 1) * 32 + (swz % 64) / 2; }
__host__ __device__ __forceinline__ int perm32(int rho) { const int n = rho >> 4, i = rho & 15; return 8 * (i >> 2) + 4 * n + (i & 3); }

struct Unit { int pm, pn; };
struct Gemm { const bf16_t* A; const bf16_t* Bt; int M, N, K, lda, ldb; };

struct StaticOrder {
    int nM, nN, nwg, G, c;
    __host__ __device__ void init(int M, int N, int G_, int c_) { nM = M / BM; nN = N / BM; nwg = nM * nN; G = G_; c = c_; }
    __host__ __device__ bool next(int i, Unit& u) const {
        const long L = (long)i * G + c; if (L >= nwg) return false;
        int wgid = (int)L; { const int q = nwg / NXCD, r = nwg % NXCD, xcd = wgid % NXCD, off = wgid / NXCD; wgid = (xcd < r ? xcd * (q + 1) : r * (q + 1) + (xcd - r) * q) + off; }
        const int nig = WGM * nN, gid = wgid / nig, fm = gid * WGM, gsz = (nM - fm) < WGM ? (nM - fm) : WGM;
        u.pm = fm + ((wgid % nig) % gsz); u.pn = (wgid % nig) / gsz; return true;
    }
    __device__ __forceinline__ void a_ready(const Unit&) const {}
    __device__ __forceinline__ void done(const Unit&) const {}
};


__device__ __forceinline__ f32x4 zero4_() { float a, b, c, d; asm volatile("v_mov_b32 %0, 0\n\tv_mov_b32 %1, 0\n\tv_mov_b32 %2, 0\n\tv_mov_b32 %3, 0" : "=v"(a), "=v"(b), "=v"(c), "=v"(d)); return (f32x4){a, b, c, d}; }
template <class Epi, class Sched, bool ALIGN_EPI = false, bool SP2 = false>
__device__ __forceinline__ void gemm_phase(PG8_LAS unsigned char* lds, const Gemm g, const Sched& S, const Epi& E) {
    int tid_ = threadIdx.x; asm volatile("" : "+v"(tid_));
    const int tid = tid_, wid = __builtin_amdgcn_readfirstlane(tid >> 6), lane = tid & 63, wr = wid >> 2, wc = wid & 3, fr = lane & 15, fq = lane >> 4;
    const int K = g.K, nt = K / BK;
    unsigned voffA[2], voffB[2];
#pragma unroll
    for (int i = 0; i < 2; ++i) { int R, C; stage_rc(tid * 16 + i * 8192, R, C); const int Rb = Epi::PERM ? ((R & ~31) + perm32(R & 31)) : R;
        voffA[i] = (unsigned)(R * g.lda + C) * 2u; voffB[i] = (unsigned)(Rb * g.ldb + C) * 2u; }
    const size_t kstep = (size_t)(BK * 2);
    const size_t hstepA = (size_t)HALF * g.lda * 2, hstepB = (size_t)HALF * g.ldb * 2;
    const size_t tstepA = 2 * hstepA, tstepB = 2 * hstepB;
    const unsigned ldsw = (unsigned)wid * 1024u;
    const int aoff = lds_byte(wr * 64 + fr, fq * 8), boff = lds_byte(wc * 32 + fr, fq * 8);
#define PG8_SA(b, h) (((b) * 2 + (h)) * HTB)
#define PG8_SB(b, h) ((4 + (b) * 2 + (h)) * HTB)
#define PG8_STAGE(bufoff, gbase, voff) do { _Pragma("unroll") for (int _i = 0; _i < 2; ++_i) \
        __builtin_amdgcn_global_load_lds((const unsigned*)((const char*)(gbase) + (voff)[_i]), (PG8_LAS unsigned*)(lds + (bufoff) + ldsw + _i * 8192), 16, 0, 0); } while (0)
#define PG8_LDA(dst, b, h) do { _Pragma("unroll") for (int m = 0; m < 4; ++m) _Pragma("unroll") for (int k = 0; k < 2; ++k) dst[m][k] = *(const PG8_LAS bf16x8*)(lds + PG8_SA(b, h) + aoff + m * 2048 + k * 1024); } while (0)
#define PG8_LDB(dst, b, h) do { _Pragma("unroll") for (int n = 0; n < 2; ++n) _Pragma("unroll") for (int k = 0; k < 2; ++k) dst[n][k] = *(const PG8_LAS bf16x8*)(lds + PG8_SB(b, h) + boff + n * 2048 + k * 1024); } while (0)
#define PG8_MMA(ai, bj, At, Bt) do { __builtin_amdgcn_s_setprio(1); _Pragma("unroll") for (int m = 0; m < 4; ++m) _Pragma("unroll") for (int n = 0; n < 2; ++n) _Pragma("unroll") for (int k = 0; k < 2; ++k) \
        acc[ai][bj][m][n] = __builtin_amdgcn_mfma_f32_16x16x32_bf16(Bt[n][k], At[m][k], acc[ai][bj][m][n], 0, 0, 0); __builtin_amdgcn_s_setprio(0); } while (0)
#define PG8_WAIT_V(n) asm volatile("s_waitcnt vmcnt(" #n ")" ::: "memory")
#define PG8_WAIT_L(n) asm volatile("s_waitcnt lgkmcnt(" #n ")" ::: "memory")
#define PG8_BAR __builtin_amdgcn_s_barrier()
#define PG8_SCHED __builtin_amdgcn_sched_barrier(0)
    Unit cur, nxt; int ui = 0;
    if (!S.next(0, cur)) return;
    f32x4 acc[2][2][4][2];
#pragma unroll
    for (int a = 0; a < 2; ++a)
#pragma unroll
        for (int b = 0; b < 2; ++b)
#pragma unroll
            for (int m = 0; m < 4; ++m)
#pragma unroll
                for (int n = 0; n < 2; ++n) acc[a][b][m][n] = zero4_();
    bf16x8 At[4][2], B0[2][2], B1[2][2];
    const char* cA = (const char*)g.A + (size_t)cur.pm * tstepA; const char* cB = (const char*)g.Bt + (size_t)cur.pn * tstepB;
    S.a_ready(cur);
    if constexpr (SP2) {
        PG8_STAGE(PG8_SB(0, 0), cB, voffB); PG8_STAGE(PG8_SB(0, 1), cB + hstepB, voffB); PG8_STAGE(PG8_SA(0, 0), cA, voffA); PG8_STAGE(PG8_SA(0, 1), cA + hstepA, voffA);
        if (wr == 1) PG8_BAR;
        PG8_WAIT_V(2); PG8_BAR;
        PG8_STAGE(PG8_SB(1, 0), cB + kstep, voffB); PG8_STAGE(PG8_SA(1, 0), cA + kstep, voffA); PG8_STAGE(PG8_SB(1, 1), cB + hstepB + kstep, voffB);
        PG8_WAIT_V(6); PG8_BAR;
    } else {
        PG8_STAGE(PG8_SB(0, 0), cB, voffB); PG8_STAGE(PG8_SA(0, 0), cA, voffA); PG8_STAGE(PG8_SB(0, 1), cB + hstepB, voffB); PG8_STAGE(PG8_SA(0, 1), cA + hstepA, voffA);
        if (wr == 1) PG8_BAR;
        PG8_WAIT_V(4); PG8_BAR;
        PG8_STAGE(PG8_SB(1, 0), cB + kstep, voffB); PG8_STAGE(PG8_SA(1, 0), cA + kstep, voffA); PG8_STAGE(PG8_SB(1, 1), cB + hstepB + kstep, voffB);
        PG8_WAIT_V(6); PG8_BAR;
    }
#pragma unroll 1
    for (;;) {
        const bool has_next = S.next(ui + 1, nxt);
        const char* nA = has_next ? (const char*)g.A + (size_t)nxt.pm * tstepA : cA; const char* nB = has_next ? (const char*)g.Bt + (size_t)nxt.pn * tstepB : cB;
#pragma unroll 1
        for (int t = 0; t < nt; t += 2) {
            const bool last = (t == nt - 2);
            const char* a1 = cA + (size_t)(t + 1) * kstep;
            const char* a2 = last ? nA : cA + (size_t)(t + 2) * kstep; const char* b2 = last ? nB : cB + (size_t)(t + 2) * kstep;
            const char* a3 = a2 + kstep; const char* b3 = b2 + kstep;
            if (last && has_next) S.a_ready(nxt);
            if constexpr (SP2) {
            PG8_LDB(B0, 0, 0); PG8_LDB(B1, 0, 1); PG8_SCHED; PG8_LDA(At, 0, 0); PG8_STAGE(PG8_SA(1, 1), a1 + hstepA, voffA);
            PG8_WAIT_V(8); PG8_WAIT_L(0); PG8_BAR; PG8_MMA(0, 0, At, B0); PG8_MMA(0, 1, At, B1); PG8_BAR; PG8_SCHED;
            PG8_LDA(At, 0, 1); PG8_STAGE(PG8_SB(0, 0), b2, voffB); PG8_STAGE(PG8_SB(0, 1), b2 + hstepB, voffB); PG8_STAGE(PG8_SA(0, 0), a2, voffA);
            PG8_WAIT_V(8); PG8_WAIT_L(0); PG8_BAR; PG8_MMA(1, 0, At, B0); PG8_MMA(1, 1, At, B1); PG8_BAR; PG8_SCHED;
            PG8_LDB(B0, 1, 0); PG8_LDB(B1, 1, 1); PG8_SCHED; PG8_LDA(At, 1, 0); PG8_STAGE(PG8_SA(0, 1), a2 + hstepA, voffA);
            PG8_WAIT_V(8); PG8_WAIT_L(0); PG8_BAR; PG8_MMA(0, 0, At, B0); PG8_MMA(0, 1, At, B1); PG8_BAR; PG8_SCHED;
            PG8_LDA(At, 1, 1); PG8_STAGE(PG8_SB(1, 0), b3, voffB); PG8_STAGE(PG8_SB(1, 1), b3 + hstepB, voffB); PG8_STAGE(PG8_SA(1, 0), a3, voffA);
            PG8_WAIT_V(8); PG8_WAIT_L(0); PG8_BAR; PG8_MMA(1, 0, At, B0); PG8_MMA(1, 1, At, B1); PG8_BAR; PG8_SCHED;
            } else {
            PG8_LDB(B0, 0, 0); PG8_SCHED; PG8_LDA(At, 0, 0); PG8_STAGE(PG8_SA(1, 1), a1 + hstepA, voffA);
            PG8_WAIT_L(8); PG8_BAR; PG8_WAIT_L(0); PG8_MMA(0, 0, At, B0); PG8_BAR; PG8_SCHED;
            PG8_LDB(B1, 0, 1); PG8_STAGE(PG8_SB(0, 0), b2, voffB);
            PG8_BAR; PG8_WAIT_L(0); PG8_MMA(0, 1, At, B1); PG8_BAR;
            PG8_LDA(At, 0, 1); PG8_STAGE(PG8_SA(0, 0), a2, voffA);
            PG8_BAR; PG8_WAIT_L(0); PG8_MMA(1, 0, At, B0); PG8_BAR; PG8_SCHED;
            PG8_STAGE(PG8_SB(0, 1), b2 + hstepB, voffB);
            PG8_WAIT_V(6); PG8_BAR; PG8_MMA(1, 1, At, B1); PG8_BAR;
            PG8_LDB(B0, 1, 0); PG8_SCHED; PG8_LDA(At, 1, 0); PG8_STAGE(PG8_SA(0, 1), a2 + hstepA, voffA);
            PG8_WAIT_L(8); PG8_BAR; PG8_WAIT_L(0); PG8_MMA(0, 0, At, B0); PG8_BAR; PG8_SCHED;
            PG8_LDB(B1, 1, 1); PG8_STAGE(PG8_SB(1, 0), b3, voffB);
            PG8_BAR; PG8_WAIT_L(0); PG8_MMA(0, 1, At, B1); PG8_BAR;
            PG8_LDA(At, 1, 1); PG8_STAGE(PG8_SA(1, 0), a3, voffA);
            PG8_BAR; PG8_WAIT_L(0); PG8_MMA(1, 0, At, B0); PG8_BAR; PG8_SCHED;
            PG8_STAGE(PG8_SB(1, 1), b3 + hstepB, voffB);
            PG8_WAIT_V(6); PG8_BAR; PG8_MMA(1, 1, At, B1); PG8_BAR;
            }
        }
        if constexpr (ALIGN_EPI) { if (wr == 0) PG8_BAR; }
        if constexpr (!Epi::AFTER_DRAIN) { E(acc, cur, wr, wc, fr, fq); S.done(cur); }
        if (!has_next) break;
#pragma unroll
        for (int a = 0; a < 2; ++a)
#pragma unroll
            for (int b = 0; b < 2; ++b)
#pragma unroll
                for (int m = 0; m < 4; ++m)
#pragma unroll
                    for (int n = 0; n < 2; ++n) acc[a][b][m][n] = zero4_();
        cur = nxt; cA = nA; cB = nB; ++ui;
        if constexpr (ALIGN_EPI) { if (wr == 1) PG8_BAR; }
    }
    PG8_WAIT_V(0);
    if constexpr (!ALIGN_EPI) { if (wr == 0) PG8_BAR; }
    PG8_BAR;
    if constexpr (Epi::AFTER_DRAIN) { E.fused(acc, cur, wr, wc, fr, fq, lds, wid, lane); S.done(cur); }
#undef PG8_SA
#undef PG8_SB
#undef PG8_STAGE
#undef PG8_LDA
#undef PG8_LDB
#undef PG8_MMA
#undef PG8_WAIT_V
#undef PG8_WAIT_L
#undef PG8_BAR
#undef PG8_SCHED
}
}

#define GAS __attribute__((address_space(1)))
#define LAS __attribute__((address_space(3)))
typedef unsigned short bf16_t;
typedef float f32x4 __attribute__((ext_vector_type(4)));
typedef float f32x8 __attribute__((ext_vector_type(8)));
typedef float f32x16 __attribute__((ext_vector_type(16)));
typedef short bf16x8 __attribute__((ext_vector_type(8)));
typedef short s16x4 __attribute__((ext_vector_type(4)));
typedef unsigned u32x4 __attribute__((ext_vector_type(4)));
typedef unsigned u32x2 __attribute__((ext_vector_type(2)));

constexpr int DM = 1024, MTOK = 8192, NCTX = 4096, LCTX = 256, LLAT = 2048;
constexpr int DFF = 2816, NUP = 5632, INC = 4512;
constexpr int N1 = 3584;
constexpr int N2 = 1280;
constexpr int KVROWS = 9216;
constexpr int NADA = 9216;
constexpr float EPSV = 1e-6f;
constexpr int NWAVES = 8, NTHR = 512;

constexpr size_t al256(size_t x) { return (x + 255) & ~(size_t)255; }
constexpr size_t WS_CTL = 0, CTL_BYTES = 1u << 20;
constexpr size_t WS_ADAP = WS_CTL + CTL_BYTES;
constexpr size_t WS_ADA  = WS_ADAP + al256((size_t)16 * 2 * 3 * NADA * 4);
constexpr size_t WS_SSQ  = WS_ADA + al256((size_t)2 * 3 * NADA * 4);
constexpr size_t WS_SSKV = WS_SSQ + al256((size_t)MTOK * 4 * 4);
constexpr size_t WS_ROPE = WS_SSKV + al256((size_t)MTOK * 4 * 4);
constexpr size_t WS_H2   = WS_ROPE + al256(64 * 8 * 2 * 4);
constexpr size_t WS_FILT = WS_H2 + al256((size_t)2 * 2304 * 64 * 4);
constexpr size_t FILT_LAYER = (size_t)512 * 4096 + (size_t)512 * 512;
constexpr size_t WS_CKVRAW = WS_FILT + al256(2 * FILT_LAYER * 4);
constexpr size_t WS_KRRAW = WS_CKVRAW + al256((size_t)NCTX * 128 * 4);
constexpr size_t WS_CKVB = WS_KRRAW + al256((size_t)MTOK * 32 * 4);
constexpr size_t WS_WUP  = WS_CKVB + al256((size_t)2 * 1024 * 256 * 2);
constexpr size_t WS_WDN  = WS_WUP + al256((size_t)4 * NUP * DM * 2);
constexpr size_t WS_W1T  = WS_WDN + al256((size_t)4 * DM * DFF * 2);
constexpr size_t WS_W2T  = WS_W1T + al256((size_t)2 * N1 * DM * 2);
constexpr size_t WS_WQB  = WS_W2T + al256((size_t)2 * N2 * DM * 2);
constexpr size_t WS_WKVB = WS_WQB + al256((size_t)2 * 768 * 256 * 2);
constexpr size_t WS_WKVR = WS_WKVB + al256((size_t)2 * 1024 * 256 * 2);
constexpr size_t WS_WHY  = WS_WKVR + al256((size_t)2 * 1024 * 256 * 2);
constexpr size_t WS_WMLA = WS_WHY + al256((size_t)2 * 1024 * 256 * 2);
constexpr size_t WS_WFN  = WS_WMLA + al256((size_t)2 * 1024 * 512 * 2);
constexpr size_t WS_WOUT = WS_WFN + al256((size_t)2 * 1024 * 256 * 2);
constexpr size_t WS_DFTL = WS_WOUT + al256((size_t)2 * 1024 * 1024 * 2);
constexpr size_t WS_DFTC = WS_DFTL + al256((size_t)2048 * 4096 * 2);
constexpr size_t WS_H    = WS_DFTC + al256((size_t)256 * 512 * 2);
constexpr size_t WS_N    = WS_H + al256((size_t)MTOK * DM * 4);
constexpr size_t WS_KV   = WS_N + al256((size_t)MTOK * DM * 2);
constexpr size_t WS_KR   = WS_KV + al256((size_t)KVROWS * 1024 * 2);
constexpr size_t WS_R1   = WS_KR + al256((size_t)KVROWS * 32 * 2);
constexpr size_t WS_ACT  = WS_R1;
constexpr size_t WS_P1   = WS_R1;
constexpr size_t WS_HYT  = WS_P1 + al256((size_t)MTOK * N1 * 2);
constexpr size_t WS_XCTL = WS_HYT + al256((size_t)768 * MTOK * 2);
constexpr size_t WS_XCTC = WS_XCTL + al256((size_t)512 * 4096 * 2);
constexpr size_t WS_Q    = WS_XCTC + al256((size_t)4096 * 512 * 2);
constexpr size_t WS_O    = WS_Q + al256((size_t)MTOK * 768 * 2);
constexpr size_t WS_Z    = WS_O + al256((size_t)MTOK * 512 * 2);
constexpr size_t WS_FN   = WS_Z + al256((size_t)MTOK * 256 * 2);
constexpr size_t WS_Y    = WS_FN + al256((size_t)MTOK * 256 * 2);
constexpr size_t WS_END  = WS_Y + al256((size_t)MTOK * DM * 4);
static_assert(WS_ACT + (size_t)MTOK * DFF * 2 <= WS_END, "ws map");

constexpr int CW_BAR = 4096;

constexpr int RING_BYTES = 131072;
constexpr int MISC_OFF = 147456 - 256;
constexpr int LDS_BYTES = 147456;

__device__ __forceinline__ unsigned f2bf(float f) { unsigned u = __builtin_bit_cast(unsigned, f); return (u + 0x7fffu + ((u >> 16) & 1u)) >> 16; }
__device__ __forceinline__ unsigned pk2(float lo, float hi) { return f2bf(lo) | (f2bf(hi) << 16); }
__device__ __forceinline__ float bf2f(unsigned short b) { return __builtin_bit_cast(float, (unsigned)b << 16); }
__device__ __forceinline__ float bflo(unsigned w) { return __builtin_bit_cast(float, w << 16); }
__device__ __forceinline__ float bfhi(unsigned w) { return __builtin_bit_cast(float, w & 0xffff0000u); }
__device__ __forceinline__ unsigned cvtpk(float lo, float hi) { unsigned r; asm volatile("v_cvt_pk_bf16_f32 %0, %1, %2" : "=v"(r) : "v"(lo), "v"(hi)); return r; }
__device__ __forceinline__ u32x4 pack8(f32x4 a, f32x4 b) { u32x4 w; w.x = cvtpk(a[0], a[1]); w.y = cvtpk(a[2], a[3]); w.z = cvtpk(b[0], b[1]); w.w = cvtpk(b[2], b[3]); return w; }
__device__ __forceinline__ float wave_sum(float v) {
#pragma unroll
    for (int o = 1; o < 64; o <<= 1) v += __shfl_xor(v, o);
    return v;
}
__device__ __forceinline__ float sigmoidf_(float x) { return 1.0f / (1.0f + __expf(-x)); }
__device__ __forceinline__ float siluf_(float x) { return x / (1.0f + __expf(-x)); }
__device__ __forceinline__ int grp_of_pm(int pm) { return pm < 16 ? 0 : (pm < 24 ? 1 : 2); }
__device__ __forceinline__ int kvrow_of(int r) { return r < NCTX ? r : NCTX + ((r - NCTX) >> 11) * 2560 + ((r - NCTX) & 2047); }

#define XB_TMO      128
#define XB_XCNT(j)  (256  + 64 * (j))
#define XB_XSUB(j)  (1280 + 64 * (j))
#define XB_XGEN(j)  (2304 + 64 * (j))
#define XB_TOP      3328
#define XB_TOPGEN   3392
#define XCD_BAR_WORDS 3456
#define XB_SPIN_CAP (1u << 20)
__device__ __forceinline__ unsigned xb_ld(unsigned* p)              { return __hip_atomic_load(p, __ATOMIC_RELAXED, __HIP_MEMORY_SCOPE_AGENT); }
__device__ __forceinline__ unsigned xb_add(unsigned* p, unsigned v) { return __hip_atomic_fetch_add(p, v, __ATOMIC_RELAXED, __HIP_MEMORY_SCOPE_AGENT); }
__device__ __forceinline__ unsigned xb_xcc_id() { return (unsigned)__builtin_amdgcn_s_getreg((3 << 11) | 20) & 0xFu; }
#define XB_SPIN(cond, bar) do { unsigned _sp = 0; while (cond) { __builtin_amdgcn_s_sleep(1); \
    if ((++_sp & 255u) == 0u) { if (xb_ld(&(bar)[XB_TMO])) break; if (_sp > XB_SPIN_CAP) { atomicAdd(&(bar)[XB_TMO], 1u); break; } } } } while (0)
struct XcdBarrier { unsigned* bar; unsigned x; volatile LAS unsigned* st; };
__device__ __forceinline__ XcdBarrier xcd_barrier_post(unsigned* bar, volatile LAS unsigned* st) {
    XcdBarrier b; b.bar = bar; b.x = xb_xcc_id(); b.st = st;
    if (threadIdx.x == 0) (void)xb_add(&bar[XB_XCNT(b.x)], 1u);
    return b;
}
__device__ __forceinline__ void xcd_barrier_complete(unsigned* bar, unsigned x, unsigned& nloc, unsigned& nx) {
    const unsigned G = gridDim.x * gridDim.y * gridDim.z;
    unsigned sum, cnt, mine, sp = 0u;
    for (;;) {
        sum = 0u; cnt = 0u; mine = 0u;
#pragma unroll 1
        for (unsigned j = 0; j < 16; ++j) { const unsigned c = xb_ld(&bar[XB_XCNT(j)]); sum += c; cnt += (c > 0u) ? 1u : 0u; mine = (j == x) ? c : mine; }
        if (sum == G) break;
        __builtin_amdgcn_s_sleep(1);
        if ((++sp & 255u) == 0u) { if (xb_ld(&bar[XB_TMO])) break; if (sp > XB_SPIN_CAP) { atomicAdd(&bar[XB_TMO], 1u); break; } }
    }
    nloc = mine > 0u ? mine : 1u; nx = cnt > 0u ? cnt : 1u;
}
__device__ __forceinline__ void xcd_barrier(const XcdBarrier& b) {
    asm volatile("s_waitcnt vmcnt(0)" ::: "memory");
    __syncthreads();
    if (threadIdx.x == 0) {
        size_t z_ = 0; asm volatile("" : "+s"(z_));
        unsigned* bar = b.bar + z_;
        __builtin_amdgcn_s_waitcnt(0);
        unsigned nloc = b.st[0], nx = b.st[1];
        if (nloc == 0u) { xcd_barrier_complete(bar, b.x, nloc, nx); b.st[0] = nloc; b.st[1] = nx; }
        const unsigned old = xb_add(&bar[XB_XSUB(b.x)], 1u);
        const unsigned gen = old / nloc;
        if (old + 1u == (gen + 1u) * nloc) {
            __builtin_amdgcn_fence(__ATOMIC_RELEASE, "agent");
            asm volatile("s_waitcnt vmcnt(0)" ::: "memory");
            const unsigned og = xb_add(&bar[XB_TOP], 1u);
            const unsigned tg = og / nx;
            if (og + 1u == (tg + 1u) * nx) xb_add(&bar[XB_TOPGEN], 1u);
            else XB_SPIN(xb_ld(&bar[XB_TOPGEN]) == tg, bar);
            __builtin_amdgcn_fence(__ATOMIC_ACQUIRE, "agent");
            xb_add(&bar[XB_XGEN(b.x)], 1u);
            asm volatile("s_waitcnt vmcnt(0)" ::: "memory");
        } else {
            XB_SPIN(xb_ld(&bar[XB_XGEN(b.x)]) == gen, bar);
            __builtin_amdgcn_fence(__ATOMIC_ACQUIRE, "agent");
            asm volatile("s_waitcnt vmcnt(0)" ::: "memory");
        }
    }
    __syncthreads();
}

using pg8::Unit;
typedef const f32x4 (&AccT)[2][2][4][2];

struct EpiSwiglu {
    static constexpr bool PERM = false, AFTER_DRAIN = false;
    bf16_t* ACT;
    __device__ __forceinline__ void operator()(AccT acc, const Unit& u, int wr, int wc, int fr, int fq) const {
        int z_ = 0; asm volatile("" : "+s"(z_));
        const int row0 = u.pm * 256 + wr * 64 + fr + z_, f0 = u.pn * 128 + wc * 16 + 4 * fq;
#pragma unroll
        for (int ai = 0; ai < 2; ++ai)
#pragma unroll
            for (int m = 0; m < 4; ++m) { bf16_t* rp = ACT + (size_t)(row0 + ai * 128 + m * 16) * DFF + f0;
#pragma unroll
                for (int bj = 0; bj < 2; ++bj) { const f32x4 g = acc[ai][bj][m][0], x = acc[ai][bj][m][1];
                    u32x2 w; w.x = cvtpk(siluf_(g[0]) * x[0], siluf_(g[1]) * x[1]); w.y = cvtpk(siluf_(g[2]) * x[2], siluf_(g[3]) * x[3]);
                    *(u32x2*)(rp + 64 * bj) = w; } }
    }
};
struct EpiResid {
    static constexpr bool PERM = true, AFTER_DRAIN = false;
    float* H; const float* gate; float gs;
    __device__ __forceinline__ void operator()(AccT acc, const Unit& u, int wr, int wc, int fr, int fq) const {
        int z_ = 0; asm volatile("" : "+s"(z_));
        const int row0 = u.pm * 256 + wr * 64 + fr + z_, col0 = u.pn * 256 + wc * 32 + 8 * fq;
        const float* gp = gate + grp_of_pm(u.pm) * NADA + col0;
        f32x4 gv[2][2];
#pragma unroll
        for (int bj = 0; bj < 2; ++bj) { gv[bj][0] = *(const f32x4*)(gp + bj * 128) * gs; gv[bj][1] = *(const f32x4*)(gp + bj * 128 + 4) * gs; }
#pragma unroll
        for (int ai = 0; ai < 2; ++ai)
#pragma unroll
            for (int m = 0; m < 4; ++m) { float* rp = H + (size_t)(row0 + ai * 128 + m * 16) * DM + col0;
#pragma unroll
                for (int bj = 0; bj < 2; ++bj) {
                    f32x4 h0 = *(const f32x4*)(rp + bj * 128), h1 = *(const f32x4*)(rp + bj * 128 + 4);
                    h0 += gv[bj][0] * acc[ai][bj][m][0]; h1 += gv[bj][1] * acc[ai][bj][m][1];
                    *(f32x4*)(rp + bj * 128) = h0; *(f32x4*)(rp + bj * 128 + 4) = h1; }
                if (m & 1) asm volatile("" ::: "memory"); }
    }
};
struct EpiProj1 {
    static constexpr bool PERM = true, AFTER_DRAIN = false;
    bf16_t* P1; float* SSQ; float* SSKV; float* CKVRAW; float* KRRAW;
    __device__ __forceinline__ void operator()(AccT acc, const Unit& u, int wr, int wc, int fr, int fq) const {
        int z_ = 0; asm volatile("" : "+s"(z_));
        fq += z_; wc += z_;
        const int row0 = u.pm * 256 + wr * 64 + fr + z_, col0 = u.pn * 256 + wc * 32 + 8 * fq;
        if (u.pn >= 2) {
#pragma unroll
            for (int ai = 0; ai < 2; ++ai)
#pragma unroll
                for (int m = 0; m < 4; ++m) { bf16_t* rp = P1 + (size_t)(row0 + ai * 128 + m * 16) * N1 + col0;
#pragma unroll
                    for (int bj = 0; bj < 2; ++bj) { f32x4 a = acc[ai][bj][m][0], b = acc[ai][bj][m][1];
#pragma unroll
                        for (int j = 0; j < 4; ++j) { a[j] = sigmoidf_(a[j]); b[j] = sigmoidf_(b[j]); }
                        *(u32x4*)(rp + bj * 128) = pack8(a, b); } }
        } else {
            const bool isq = (u.pn == 0);
#pragma unroll
            for (int ai = 0; ai < 2; ++ai)
#pragma unroll
                for (int m = 0; m < 4; ++m) { const int row = row0 + ai * 128 + m * 16; bf16_t* rp = P1 + (size_t)row * N1 + col0;
                    const f32x4 a0 = acc[ai][0][m][0], b0 = acc[ai][0][m][1], a1 = acc[ai][1][m][0], b1 = acc[ai][1][m][1];
                    *(u32x4*)(rp) = pack8(a0, b0); *(u32x4*)(rp + 128) = pack8(a1, b1);
                    float s = (a0[0] * a0[0] + a0[1] * a0[1]) + (a0[2] * a0[2] + a0[3] * a0[3]) + (b0[0] * b0[0] + b0[1] * b0[1]) + (b0[2] * b0[2] + b0[3] * b0[3]);
                    if (isq) s += (a1[0] * a1[0] + a1[1] * a1[1]) + (a1[2] * a1[2] + a1[3] * a1[3]) + (b1[0] * b1[0] + b1[1] * b1[1]) + (b1[2] * b1[2] + b1[3] * b1[3]);
                    s += __shfl_xor(s, 16); s += __shfl_xor(s, 32);
                    if (fq == 0) (isq ? SSQ : SSKV)[row * 4 + wc] = s;
                    if (!isq) {
                        if (row < NCTX) { float* cp = CKVRAW + (size_t)row * 128 + wc * 32 + 8 * fq; *(f32x4*)cp = a0; *(f32x4*)(cp + 4) = b0; }
                        if (wc == 0) { float* kp = KRRAW + (size_t)row * 32 + 8 * fq; *(f32x4*)kp = a1; *(f32x4*)(kp + 4) = b1; }
                    }
                    asm volatile("" ::: "memory"); }
        }
    }
};
struct EpiQ {
    static constexpr bool PERM = true, AFTER_DRAIN = false;
    bf16_t* Q; const float* SSQ; const float* rope;
    __device__ __forceinline__ void operator()(AccT acc, const Unit& u, int wr, int wc, int fr, int fq) const {
        int z_ = 0; asm volatile("" : "+s"(z_));
        const int row0 = u.pm * 256 + wr * 64 + fr + z_, col0 = u.pn * 256 + wc * 32 + 8 * fq;
#pragma unroll
        for (int ai = 0; ai < 2; ++ai)
#pragma unroll
            for (int m = 0; m < 4; ++m) { const int row = row0 + ai * 128 + m * 16;
                const f32x4 ss = *(const f32x4*)(SSQ + row * 4); const float rstd = __builtin_amdgcn_rsqf(((ss[0] + ss[1]) + (ss[2] + ss[3])) * (1.0f / 256.0f) + EPSV);
#pragma unroll
                for (int bj = 0; bj < 2; ++bj) { const int c = col0 + bj * 128, within = c % 96;
                    f32x4 a = acc[ai][bj][m][0] * rstd, b = acc[ai][bj][m][1] * rstd;
                    if (within >= 64 && row >= NCTX) { const int pp = within - 64, part = pp >> 4, ib = (pp & 15) >> 1; const int t = (row - NCTX) & 2047, pos = part == 0 ? (t >> 6) : (t & 63);
                        const float* rt = rope + (pos * 8 + ib) * 2; const f32x4 r0 = *(const f32x4*)rt, r1 = *(const f32x4*)(rt + 4);
                        f32x4 a2, b2; a2[0] = a[0] * r0[0] - a[1] * r0[1]; a2[1] = a[1] * r0[0] + a[0] * r0[1]; a2[2] = a[2] * r0[2] - a[3] * r0[3]; a2[3] = a[3] * r0[2] + a[2] * r0[3];
                        b2[0] = b[0] * r1[0] - b[1] * r1[1]; b2[1] = b[1] * r1[0] + b[0] * r1[1]; b2[2] = b[2] * r1[2] - b[3] * r1[3]; b2[3] = b[3] * r1[2] + b[2] * r1[3]; a = a2; b = b2; }
                    *(u32x4*)(Q + (size_t)row * 768 + c) = pack8(a, b); }
                asm volatile("" ::: "memory"); }
    }
};
template <bool CACHED> struct EpiKV {
    static constexpr bool PERM = true, AFTER_DRAIN = false;
    bf16_t* KV; const float* SS;
    __device__ __forceinline__ void operator()(AccT acc, const Unit& u, int wr, int wc, int fr, int fq) const {
        int z_ = 0; asm volatile("" : "+s"(z_));
        const int row0 = u.pm * 256 + wr * 64 + fr + z_, col0 = u.pn * 256 + wc * 32 + 8 * fq;
#pragma unroll
        for (int ai = 0; ai < 2; ++ai)
#pragma unroll
            for (int m = 0; m < 4; ++m) { const int row = row0 + ai * 128 + m * 16; float rstd = 1.0f; int drow;
                if (CACHED) drow = NCTX + (row >> 9) * 2560 + 2048 + (row & 511);
                else { drow = kvrow_of(row); const f32x4 ss = *(const f32x4*)(SS + row * 4); rstd = __builtin_amdgcn_rsqf(((ss[0] + ss[1]) + (ss[2] + ss[3])) * (1.0f / 128.0f) + EPSV); }
#pragma unroll
                for (int bj = 0; bj < 2; ++bj) *(u32x4*)(KV + (size_t)drow * 1024 + col0 + bj * 128) = pack8(acc[ai][bj][m][0] * rstd, acc[ai][bj][m][1] * rstd);
                asm volatile("" ::: "memory"); }
    }
};
struct EpiT {
    static constexpr bool PERM = true, AFTER_DRAIN = false;
    bf16_t* HYT; bf16_t* XCTL; bf16_t* XCTC;
    __device__ __forceinline__ void operator()(AccT acc, const Unit& u, int wr, int wc, int fr, int fq) const {
        int z_ = 0; asm volatile("" : "+s"(z_));
        const int row0 = u.pm * 256 + wr * 64 + fr + z_, tok0 = u.pn * 256 + wc * 32 + 8 * fq;
#pragma unroll
        for (int ai = 0; ai < 2; ++ai)
#pragma unroll
            for (int m = 0; m < 4; ++m) { const int n = row0 + ai * 128 + m * 16;
#pragma unroll
                for (int bj = 0; bj < 2; ++bj) { const int tok = tok0 + bj * 128; bf16_t* dp;
                    if (u.pm < 3) dp = HYT + (size_t)n * MTOK + tok;
                    else { const int isS = u.pm - 3, col = n - 768 - 256 * isS;
                        if (tok < NCTX) dp = XCTC + ((size_t)((tok >> 8) * 256 + col)) * 512 + isS * 256 + (tok & 255);
                        else dp = XCTL + ((size_t)(((tok - NCTX) >> 11) * 256 + col)) * 4096 + isS * 2048 + ((tok - NCTX) & 2047); }
                    *(u32x4*)dp = pack8(acc[ai][bj][m][0], acc[ai][bj][m][1]); } }
    }
};
struct EpiFn {
    static constexpr bool PERM = true, AFTER_DRAIN = false;
    bf16_t* FN; int lat; float scale;
    __device__ __forceinline__ void operator()(AccT acc, const Unit& u, int wr, int wc, int fr, int fq) const {
        int z_ = 0; asm volatile("" : "+s"(z_));
        const int rb = lat ? (NCTX + u.pn * 2048 + u.pm * 256) : (u.pn * 256);
        const int row0 = rb + wr * 64 + fr + z_, col0 = wc * 32 + 8 * fq;
#pragma unroll
        for (int ai = 0; ai < 2; ++ai)
#pragma unroll
            for (int m = 0; m < 4; ++m) { bf16_t* rp = FN + (size_t)(row0 + ai * 128 + m * 16) * 256 + col0;
#pragma unroll
                for (int bj = 0; bj < 2; ++bj) *(u32x4*)(rp + bj * 128) = pack8(acc[ai][bj][m][0] * scale, acc[ai][bj][m][1] * scale); }
    }
};
template <int MODE> struct EpiGate {
    static constexpr bool PERM = true, AFTER_DRAIN = false;
    float* Y; bf16_t* YB; const bf16_t* G; float gsc;
    __device__ __forceinline__ void operator()(AccT acc, const Unit& u, int wr, int wc, int fr, int fq) const {
        int z_ = 0; asm volatile("" : "+s"(z_));
        const int row0 = u.pm * 256 + wr * 64 + fr + z_, col0 = u.pn * 256 + wc * 32 + 8 * fq;
#pragma unroll
        for (int ai = 0; ai < 2; ++ai)
#pragma unroll
            for (int m = 0; m < 4; ++m) { const int row = row0 + ai * 128 + m * 16;
#pragma unroll
                for (int bj = 0; bj < 2; ++bj) { const int c = col0 + bj * 128;
                    const u32x4 gw = *(const u32x4*)(G + (size_t)row * N1 + c);
                    f32x4 g0, g1; g0[0] = bflo(gw.x); g0[1] = bfhi(gw.x); g0[2] = bflo(gw.y); g0[3] = bfhi(gw.y); g1[0] = bflo(gw.z); g1[1] = bfhi(gw.z); g1[2] = bflo(gw.w); g1[3] = bfhi(gw.w);
                    f32x4 a = g0 * acc[ai][bj][m][0] * gsc, b = g1 * acc[ai][bj][m][1] * gsc;
                    float* yp = Y + (size_t)row * DM + c;
                    if (MODE >= 1) { a += *(const f32x4*)yp; b += *(const f32x4*)(yp + 4); }
                    if (MODE <= 1) { *(f32x4*)yp = a; *(f32x4*)(yp + 4) = b; }
                    else *(u32x4*)(YB + (size_t)row * DM + c) = pack8(a, b); }
                asm volatile("" ::: "memory"); }
    }
};

namespace att {
constexpr int KVBLK = 64;
constexpr float SCALE = 0.10206207261596575f;
constexpr float THR = 8.f;
constexpr int SHM_V = KVBLK * 128 * 2, SHM_K = KVBLK * 128 * 2, SHM_ATTN = 2 * SHM_V + 2 * SHM_K + NWAVES * 64 * 4;
#define KSWZ(row, colB) ((row) * 256 + ((colB) ^ (((row) & 7) << 4)))
#define SBAR() __builtin_amdgcn_sched_barrier(0)
__device__ __forceinline__ int crow(int r, int hi) { return (r & 3) + 8 * (r >> 2) + 4 * hi; }
__device__ __forceinline__ void partialSM(f32x16& p0, f32x16& p1, float& m_reg, float& mn, float& alpha) {
  constexpr float C = SCALE * 1.4426950408889634f;
  float pmax = p0[0];
#pragma unroll
  for (int r = 1; r < 16; ++r) pmax = fmaxf(pmax, p0[r]);
#pragma unroll
  for (int r = 0; r < 16; ++r) pmax = fmaxf(pmax, p1[r]);
  { auto rr = __builtin_amdgcn_permlane32_swap(__float_as_uint(pmax), __float_as_uint(pmax), false, false);
    pmax = fmaxf(__uint_as_float(rr[0]), __uint_as_float(rr[1])); }
  if (__builtin_expect(__all(pmax - m_reg <= THR / SCALE), 1)) { mn = m_reg; alpha = 1.f; }
  else { mn = fmaxf(m_reg, pmax); alpha = __builtin_amdgcn_exp2f((m_reg - mn) * C); m_reg = mn; }
  float mnC = -mn * C;
#pragma unroll
  for (int r = 0; r < 16; ++r) p0[r] = fmaf(p0[r], C, mnC);
#pragma unroll
  for (int r = 0; r < 16; ++r) p1[r] = fmaf(p1[r], C, mnC);
#pragma unroll
  for (int r = 0; r < 16; ++r) p0[r] = __builtin_amdgcn_exp2f(p0[r]);
}
__device__ __forceinline__ void finishSM(f32x16& p0, f32x16& p1, float alpha, float& l_reg, bf16x8& pa0, bf16x8& pa1, bf16x8& pa2, bf16x8& pa3) {
#pragma unroll
  for (int r = 0; r < 16; ++r) p1[r] = __builtin_amdgcn_exp2f(p1[r]);
  float ps = 0;
#pragma unroll
  for (int r = 0; r < 16; ++r) ps += p0[r];
#pragma unroll
  for (int r = 0; r < 16; ++r) ps += p1[r];
  { auto rr = __builtin_amdgcn_permlane32_swap(__float_as_uint(ps), __float_as_uint(ps), false, false);
    ps = __uint_as_float(rr[0]) + __uint_as_float(rr[1]); }
  l_reg = l_reg * alpha + ps;
#define PK4(P, BASE, OUT) do { unsigned a0 = cvtpk(P[BASE + 0], P[BASE + 1]), a1 = cvtpk(P[BASE + 2], P[BASE + 3]);   \
    unsigned b0 = cvtpk(P[BASE + 4], P[BASE + 5]), b1 = cvtpk(P[BASE + 6], P[BASE + 7]);                              \
    auto r0 = __builtin_amdgcn_permlane32_swap(a0, b0, false, false); auto r1 = __builtin_amdgcn_permlane32_swap(a1, b1, false, false); \
    u32x4 w = {r0[0], r1[0], r0[1], r1[1]}; OUT = *reinterpret_cast<bf16x8*>(&w); } while (0)
  PK4(p0, 0, pa0); PK4(p0, 8, pa1); PK4(p1, 0, pa2); PK4(p1, 8, pa3);
#undef PK4
}
__device__ __forceinline__ void qkt(f32x16& p0, f32x16& p1, const char* Ks, const bf16x8* qr, int r32, int hi) {
  p0 = f32x16{}; p1 = f32x16{};
#pragma unroll
  for (int d0 = 0; d0 < 6; ++d0) { int cb = (d0 * 16 + hi * 8) * 2;
    bf16x8 b0 = *reinterpret_cast<const bf16x8*>(Ks + KSWZ(r32, cb));
    bf16x8 b1 = *reinterpret_cast<const bf16x8*>(Ks + KSWZ(32 + r32, cb));
    p0 = __builtin_amdgcn_mfma_f32_32x32x16_bf16(b0, qr[d0], p0, 0, 0, 0);
    p1 = __builtin_amdgcn_mfma_f32_32x32x16_bf16(b1, qr[d0], p1, 0, 0, 0); }
}
__device__ __forceinline__ int v_st(int k, int c) { const int kk = (k & ~0xC) | ((k & 4) << 1) | ((k & 8) >> 1); return ((kk >> 3) * 4 + (c >> 5)) * 512 + ((kk & 7) * 32 + (c & 31)) * 2; }
__device__ __forceinline__ int v_rd_base(int lane) { return ((lane & 3) << 3) | (((lane >> 2) & 3) << 6) | (((lane >> 4) & 1) << 5) | (((lane >> 5) & 1) << 8); }
constexpr int v_rd_off(int d0, int ks, int half) { return d0 * 512 + ks * 4096 + half * 2048; }
template <int OFF> __device__ __forceinline__ s16x4 tr_read(int vb) {
  s16x4 r; asm volatile("ds_read_b64_tr_b16 %0, %1 offset:%2" : "=&v"(r) : "v"(vb), "i"(OFF) : "memory"); return r;
}
template <int D0> __device__ __forceinline__ void pv_one(f32x16& od, int vb, bf16x8 pa0, bf16x8 pa1, bf16x8 pa2, bf16x8 pa3) {
  const s16x4 l0 = tr_read<v_rd_off(D0, 0, 0)>(vb), h0 = tr_read<v_rd_off(D0, 0, 1)>(vb), l1 = tr_read<v_rd_off(D0, 1, 0)>(vb), h1 = tr_read<v_rd_off(D0, 1, 1)>(vb);
  const s16x4 l2 = tr_read<v_rd_off(D0, 2, 0)>(vb), h2 = tr_read<v_rd_off(D0, 2, 1)>(vb), l3 = tr_read<v_rd_off(D0, 3, 0)>(vb), h3 = tr_read<v_rd_off(D0, 3, 1)>(vb);
  asm volatile("s_waitcnt lgkmcnt(0)" ::: "memory"); SBAR();
#define PK(L, H) (bf16x8){L[0], L[1], L[2], L[3], H[0], H[1], H[2], H[3]}
  od = __builtin_amdgcn_mfma_f32_32x32x16_bf16(pa0, PK(l0, h0), od, 0, 0, 0);
  od = __builtin_amdgcn_mfma_f32_32x32x16_bf16(pa1, PK(l1, h1), od, 0, 0, 0);
  od = __builtin_amdgcn_mfma_f32_32x32x16_bf16(pa2, PK(l2, h2), od, 0, 0, 0);
  od = __builtin_amdgcn_mfma_f32_32x32x16_bf16(pa3, PK(l3, h3), od, 0, 0, 0);
#undef PK
}
__device__ __forceinline__ void pv_d0(f32x16* o, int vb, bf16x8 pa0, bf16x8 pa1, bf16x8 pa2, bf16x8 pa3) {
  pv_one<0>(o[0], vb, pa0, pa1, pa2, pa3); pv_one<1>(o[1], vb, pa0, pa1, pa2, pa3);
}
__device__ __forceinline__ void attn_unit(const bf16_t* __restrict__ Qb, const bf16_t* __restrict__ KVh, const bf16_t* __restrict__ KRr, bf16_t* __restrict__ Ob, int seq, char* lds) {
  int tid_ = threadIdx.x; asm volatile("" : "+v"(tid_));
  const int tid = tid_, wid = tid >> 6, lane = tid & 63, r32 = lane & 31, hi = lane >> 5;
  char* V_lds = lds; char* K_lds = lds + 2 * SHM_V;
  float* ws = (float*)(lds + 2 * SHM_V + 2 * SHM_K) + wid * 64; float* li_l = ws; float* al_l = ws + 32;
  float m_reg = -1e30f, l_reg = 0; f32x16 o[2] = {}; bf16x8 qr[6];
  const bf16_t* Qw = Qb + (long)(wid * 32 + r32) * 768 + hi * 8;
#pragma unroll
  for (int d0 = 0; d0 < 6; ++d0) qr[d0] = *reinterpret_cast<const bf16x8*>(Qw + d0 * 16);
  const int sr = tid >> 4, sc = (tid & 15) * 8, vst0 = v_st(sr, sc & 63), vst1 = v_st(32 + sr, sc & 63);
  const bool kn = sc < 64, krp = (sc >= 64 && sc < 96);
  const int vb0 = (int)(uintptr_t)V_lds + v_rd_base(lane);
  struct { bf16x8 vs0, vs1, ks0, ks1; } sr_[2];
#define SLOAD(i, k0) do { if (kn) { sr_[i].vs0 = *reinterpret_cast<const bf16x8*>(&KVh[(long)((k0) + sr) * 1024 + 64 + sc]); sr_[i].vs1 = *reinterpret_cast<const bf16x8*>(&KVh[(long)((k0) + 32 + sr) * 1024 + 64 + sc]); \
      sr_[i].ks0 = *reinterpret_cast<const bf16x8*>(&KVh[(long)((k0) + sr) * 1024 + sc]); sr_[i].ks1 = *reinterpret_cast<const bf16x8*>(&KVh[(long)((k0) + 32 + sr) * 1024 + sc]); } \
    else if (krp) { sr_[i].ks0 = *reinterpret_cast<const bf16x8*>(&KRr[(long)((k0) + sr) * 32 + sc - 64]); sr_[i].ks1 = *reinterpret_cast<const bf16x8*>(&KRr[(long)((k0) + 32 + sr) * 32 + sc - 64]); } } while (0)
#define SWRITE(b, i) do { if (kn) { *(bf16x8*)(V_lds + (b) * SHM_V + vst0) = sr_[i].vs0; *(bf16x8*)(V_lds + (b) * SHM_V + vst1) = sr_[i].vs1; } \
    if (kn || krp) { int kc = sc * 2; *(bf16x8*)(K_lds + (b) * SHM_K + KSWZ(sr, kc)) = sr_[i].ks0; *(bf16x8*)(K_lds + (b) * SHM_K + KSWZ(32 + sr, kc)) = sr_[i].ks1; } } while (0)
#define RESC(a) do { if (__any((a) < 1.f)) { if (hi == 0) al_l[r32] = (a); asm volatile("s_waitcnt lgkmcnt(0)" ::: "memory"); \
    _Pragma("unroll") for (int d = 0; d < 2; ++d) _Pragma("unroll") for (int r = 0; r < 16; ++r) o[d][r] *= al_l[crow(r, hi)]; } } while (0)
  f32x16 pA0, pA1, pB0, pB1; float mnA, mnB, alA, alB; bf16x8 pa0, pa1, pa2, pa3; const int NT = seq / KVBLK;
  SLOAD(0, 0); SWRITE(0, 0); __syncthreads();
  qkt(pA0, pA1, K_lds, qr, r32, hi); partialSM(pA0, pA1, m_reg, mnA, alA);
  SLOAD(1, KVBLK); if (2 < NT) SLOAD(0, 2 * KVBLK);
  SWRITE(1, 1); __syncthreads();
  for (int j = 1; j + 1 < NT; j += 2) {
    SBAR(); qkt(pB0, pB1, K_lds + SHM_K, qr, r32, hi);
    finishSM(pA0, pA1, alA, l_reg, pa0, pa1, pa2, pa3); SBAR();
    SLOAD(1, (j + 2) * KVBLK); SBAR();
    pv_d0(o, vb0, pa0, pa1, pa2, pa3); partialSM(pB0, pB1, m_reg, mnB, alB);
    __syncthreads(); SWRITE(0, 0);
    RESC(alB); __syncthreads();
    SBAR(); qkt(pA0, pA1, K_lds, qr, r32, hi);
    finishSM(pB0, pB1, alB, l_reg, pa0, pa1, pa2, pa3); SBAR();
    if (j + 3 < NT) SLOAD(0, (j + 3) * KVBLK); SBAR();
    pv_d0(o, vb0 + SHM_V, pa0, pa1, pa2, pa3); partialSM(pA0, pA1, m_reg, mnA, alA);
    __syncthreads(); SWRITE(1, 1);
    RESC(alA); __syncthreads();
  }
  SBAR(); qkt(pB0, pB1, K_lds + SHM_K, qr, r32, hi);
  finishSM(pA0, pA1, alA, l_reg, pa0, pa1, pa2, pa3); SBAR();
  pv_d0(o, vb0, pa0, pa1, pa2, pa3); partialSM(pB0, pB1, m_reg, mnB, alB);
  __syncthreads(); RESC(alB);
  finishSM(pB0, pB1, alB, l_reg, pa0, pa1, pa2, pa3); SBAR();
  pv_d0(o, vb0 + SHM_V, pa0, pa1, pa2, pa3);
  if (hi == 0) li_l[r32] = l_reg; asm volatile("s_waitcnt lgkmcnt(0)" ::: "memory");
  float rli[16];
#pragma unroll
  for (int r = 0; r < 16; ++r) rli[r] = __builtin_amdgcn_rcpf(li_l[crow(r, hi)]);
  bf16_t* Ow = Ob + (long)(wid * 32) * 512;
#pragma unroll
  for (int r = 0; r < 16; ++r) { int orow = crow(r, hi);
#pragma unroll
    for (int d0 = 0; d0 < 2; ++d0) Ow[(long)orow * 512 + d0 * 32 + r32] = (bf16_t)f2bf(o[d0][r] * rli[r]); }
  __syncthreads();
#undef SLOAD
#undef SWRITE
#undef RESC
}
#undef KSWZ
#undef SBAR
}

struct Args { const float* in[29]; float* out; unsigned char* ws; int ph_lo, ph_hi, use_bar, pad; };
enum { I_XP = 0, I_XS, I_CCKV, I_CKR, I_C, I_CCTX, I_WADA, I_BADA, I_NORMG, I_WUP, I_WDN, I_WIN, I_HCW, I_HCB, I_FW1, I_FB1, I_FW2, I_FB2, I_FW3, I_SKIP,
       I_WHY, I_QNG, I_WQB, I_KVNG, I_WKVB, I_WMLA, I_WFN, I_WOUT, I_FING };

struct Frame {
    LAS unsigned char* lds; char* ldsg;
    int G, bid;
    unsigned char* ws;
};
#define WSP(T, off) ((T*)(F.ws + (off)))
#define TLW() int tid_ = threadIdx.x; asm volatile("" : "+v"(tid_)); const int tid = tid_, lane = tid & 63, wave = __builtin_amdgcn_readfirstlane(tid >> 6); (void)lane; (void)wave
__device__ __forceinline__ const float* argin(int i) { size_t off = (size_t)i * 8; asm volatile("" : "+s"(off)); const __attribute__((address_space(4))) char* k = (const __attribute__((address_space(4))) char*)__builtin_amdgcn_kernarg_segment_ptr(); return (const float*)(*(const GAS float* const __attribute__((address_space(4)))*)(k + off)); }
#define AIN(i) argin(i)

enum { CK_ID = 0, CK_UP, CK_IN, CK_QB };
__device__ __forceinline__ bf16_t* conv_dst(int kind, bf16_t* d0, bf16_t* d1, int ldd, int n) {
    if (kind == CK_ID) return d0 + (size_t)n * ldd;
    if (kind == CK_UP) { const int isU = n >= DFF, f = n - DFF * isU; const int R = (f >> 7) * 256 + ((f >> 6) & 1) * 128 + ((f >> 4) & 3) * 32 + 16 * isU + (f & 15); return d0 + (size_t)R * ldd; }
    if (kind == CK_IN) {
        if (n < 768) return d1 + (size_t)n * ldd;
        if (n < 1024) return d0 + (size_t)(n - 768) * ldd;
        if (n < 1152) return d0 + (size_t)(256 + n - 1024) * ldd;
        if (n < 1184) { const int p = n - 1152, part = p >> 4, w = p & 15, half = w >> 3, i = w & 7; return d0 + (size_t)(384 + part * 16 + 2 * i + half) * ldd; }
        if (n < 1440) return nullptr;
        return d0 + (size_t)(512 + n - 1440) * ldd;
    }
    { const int h = n / 96, w96 = n - h * 96; int d = w96;
      if (w96 >= 64) { const int p = w96 - 64, part = p >> 4, w = p & 15, half = w >> 3, i = w & 7; d = 64 + part * 16 + 2 * i + half; }
      return d0 + (size_t)(h * 96 + d) * ldd; }
}
__device__ __forceinline__ void conv_item(const float* W, int ldw, int ncols, int k0, int n0, int kind, bf16_t* d0, bf16_t* d1, int ldd, const float* kscale, bf16_t* dextra, LAS float* scr, int lane) {
    const int lr = lane >> 4, lc = (lane & 15) * 4;
    const bool cok = (n0 + lc) < ncols;
    f32x4 v[16];
#pragma unroll
    for (int i = 0; i < 16; ++i) v[i] = cok ? *(const f32x4*)(W + (size_t)(k0 + i * 4 + lr) * ldw + n0 + lc) : (f32x4){0.f, 0.f, 0.f, 0.f};
#pragma unroll
    for (int i = 0; i < 16; ++i) *(LAS f32x4*)(scr + (i * 4 + lr) * 68 + lc) = v[i];
    asm volatile("s_waitcnt lgkmcnt(0)" ::: "memory");
    const int n = n0 + lane;
    bf16_t* dp = (n < ncols) ? conv_dst(kind, d0, d1, ldd, n) : nullptr;
#pragma unroll
    for (int c = 0; c < 8; ++c) {
        float x[8];
#pragma unroll
        for (int e2 = 0; e2 < 8; ++e2) x[e2] = scr[(8 * c + e2) * 68 + lane];
        if (dp) {
            if (dextra) { u32x4 r; r.x = cvtpk(x[0], x[1]); r.y = cvtpk(x[2], x[3]); r.z = cvtpk(x[4], x[5]); r.w = cvtpk(x[6], x[7]); *(u32x4*)(dextra + (size_t)n * ldd + k0 + 8 * c) = r; }
            if (kscale) {
#pragma unroll
                for (int e2 = 0; e2 < 8; ++e2) x[e2] *= kscale[k0 + 8 * c + e2]; }
            u32x4 o; o.x = cvtpk(x[0], x[1]); o.y = cvtpk(x[2], x[3]); o.z = cvtpk(x[4], x[5]); o.w = cvtpk(x[6], x[7]);
            *(u32x4*)(dp + k0 + 8 * c) = o; }
    }
    asm volatile("s_waitcnt lgkmcnt(0)" ::: "memory");
}

__device__ __forceinline__ void p0_phase(Frame& F, const Args& A) {
    TLW();
    LAS float* scr = (LAS float*)(F.lds + wave * 17408);
    const int gw = F.bid * NWAVES + wave, NGW = F.G * NWAVES;
    const int gt = F.bid * NTHR + tid, NGT = F.G * NTHR;
    {
        constexpr int I_UP = 16 * 88, I_DN = 44 * 16, I_IN = 16 * 71, I_QB = 4 * 12, I_KVB = 2 * 16, I_HY = 4 * 16, I_MLA = 8 * 16, I_FN = 4 * 16, I_OUT = 16 * 16;
        constexpr int PER_L = 2 * I_UP + 2 * I_DN + I_IN + I_QB + I_KVB + I_HY + I_MLA + I_FN + I_OUT;
        for (int it = gw; it < 2 * PER_L; it += NGW) {
            const int l = it / PER_L; int r = it - l * PER_L;
            if (r < 2 * I_UP) { const int f = r / I_UP; r -= f * I_UP; const int nb = 88, kb = r / nb, n_ = r % nb;
                conv_item(AIN(I_WUP) + (size_t)(l * 2 + f) * DM * NUP, NUP, NUP, kb * 64, n_ * 64, CK_UP, WSP(bf16_t, WS_WUP) + (size_t)(l * 2 + f) * NUP * DM, nullptr, DM, nullptr, nullptr, scr, lane); continue; }
            r -= 2 * I_UP;
            if (r < 2 * I_DN) { const int f = r / I_DN; r -= f * I_DN; const int nb = 16, kb = r / nb, n_ = r % nb;
                conv_item(AIN(I_WDN) + (size_t)(l * 2 + f) * DFF * DM, DM, DM, kb * 64, n_ * 64, CK_ID, WSP(bf16_t, WS_WDN) + (size_t)(l * 2 + f) * DM * DFF, nullptr, DFF, nullptr, nullptr, scr, lane); continue; }
            r -= 2 * I_DN;
            if (r < I_IN) { const int nb = 71, kb = r / nb, n_ = r % nb;
                conv_item(AIN(I_WIN) + (size_t)l * DM * INC, INC, INC, kb * 64, n_ * 64, CK_IN, WSP(bf16_t, WS_W1T) + (size_t)l * N1 * DM, WSP(bf16_t, WS_W2T) + (size_t)l * N2 * DM, DM, nullptr, nullptr, scr, lane); continue; }
            r -= I_IN;
            if (r < I_QB) { const int nb = 12, kb = r / nb, n_ = r % nb;
                conv_item(AIN(I_WQB) + (size_t)l * 256 * 768, 768, 768, kb * 64, n_ * 64, CK_QB, WSP(bf16_t, WS_WQB) + (size_t)l * 768 * 256, nullptr, 256, AIN(I_QNG) + l * 256, nullptr, scr, lane); continue; }
            r -= I_QB;
            if (r < I_KVB) { const int nb = 16, kb = r / nb, n_ = r % nb;
                conv_item(AIN(I_WKVB) + (size_t)l * 128 * 1024, 1024, 1024, kb * 64, n_ * 64, CK_ID, WSP(bf16_t, WS_WKVB) + (size_t)l * 1024 * 256, nullptr, 256, AIN(I_KVNG) + l * 128, WSP(bf16_t, WS_WKVR) + (size_t)l * 1024 * 256, scr, lane); continue; }
            r -= I_KVB;
            if (r < I_HY) { const int nb = 16, kb = r / nb, n_ = r % nb;
                conv_item(AIN(I_WHY) + (size_t)l * 256 * 1024, 1024, 1024, kb * 64, n_ * 64, CK_ID, WSP(bf16_t, WS_WHY) + (size_t)l * 1024 * 256, nullptr, 256, nullptr, nullptr, scr, lane); continue; }
            r -= I_HY;
            if (r < I_MLA) { const int nb = 16, kb = r / nb, n_ = r % nb;
                conv_item(AIN(I_WMLA) + (size_t)l * 512 * 1024, 1024, 1024, kb * 64, n_ * 64, CK_ID, WSP(bf16_t, WS_WMLA) + (size_t)l * 1024 * 512, nullptr, 512, nullptr, nullptr, scr, lane); continue; }
            r -= I_MLA;
            if (r < I_FN) { const int nb = 16, kb = r / nb, n_ = r % nb;
                conv_item(AIN(I_WFN) + (size_t)l * 256 * 1024, 1024, 1024, kb * 64, n_ * 64, CK_ID, WSP(bf16_t, WS_WFN) + (size_t)l * 1024 * 256, nullptr, 256, nullptr, nullptr, scr, lane); continue; }
            r -= I_FN;
            { const int nb = 16, kb = r / nb, n_ = r % nb;
                conv_item(AIN(I_WOUT) + (size_t)l * 1024 * 1024, 1024, 1024, kb * 64, n_ * 64, CK_ID, WSP(bf16_t, WS_WOUT) + (size_t)l * 1024 * 1024, nullptr, 1024, nullptr, nullptr, scr, lane); }
        }
    }
    __syncthreads();
    LAS float* scv = (LAS float*)(F.lds);
    LAS float* ctab = (LAS float*)(F.lds + 16384);
    for (int i = tid; i < 3 * DM; i += NTHR) { const int g = i >> 10, k = i & 1023; const float c = (g == 0) ? AIN(I_CCTX)[k] : AIN(I_C)[(g - 1) * DM + k]; scv[i] = siluf_(c); }
    for (int i = tid; i < 2048; i += NTHR) ctab[i] = cospif((float)i * (1.0f / 1024.0f));
    __syncthreads();
    for (int it = gw; it < 2 * 4 * 16 * 4; it += NGW) {
        const int mq = it & 3, kc = (it >> 2) & 15, g = (it >> 6) & 3, l = it >> 8; const int k = kc * 64 + lane;
        const float* src = AIN(I_WIN) + (size_t)l * DM * INC + (size_t)k * INC + 1184 + g * 64;
        float x[64];
#pragma unroll
        for (int j = 0; j < 16; ++j) { const f32x4 v = *(const f32x4*)(src + 4 * j); x[4 * j] = v[0]; x[4 * j + 1] = v[1]; x[4 * j + 2] = v[2]; x[4 * j + 3] = v[3]; }
        bf16_t* dst = WSP(bf16_t, WS_W2T) + (size_t)l * N2 * DM;
        for (int mm = 0; mm < 16; ++mm) { const int m = mq * 16 + mm; float sc_ = 0.f, ss_ = 0.f;
#pragma unroll
            for (int j = 0; j < 64; ++j) { const int ph = (j * m) & 63; sc_ += x[j] * ctab[ph * 32]; ss_ += x[j] * ctab[((ph + 48) & 63) * 32]; }
            dst[(size_t)(768 + g * 64 + m) * DM + k] = (bf16_t)f2bf(sc_); dst[(size_t)(1024 + g * 64 + m) * DM + k] = (bf16_t)f2bf(ss_); }
    }
    for (int it = gw; it < 2 * 16 * 36; it += NGW) {
        const int cc = it % 36, kc = (it / 36) & 15, l = it / (36 * 16);
        const float* wp = AIN(I_WADA) + (size_t)l * DM * NADA + (size_t)(kc * 64) * NADA + cc * 256 + lane * 4;
        f32x4 a0 = {0, 0, 0, 0}, a1 = a0, a2 = a0;
#pragma unroll 8
        for (int k = 0; k < 64; ++k) { const f32x4 w = *(const f32x4*)(wp + (size_t)k * NADA); const int kk = kc * 64 + k; a0 += w * scv[kk]; a1 += w * scv[1024 + kk]; a2 += w * scv[2048 + kk]; }
        float* op = WSP(float, WS_ADAP) + ((size_t)(kc * 2 + l) * 3) * NADA + cc * 256 + lane * 4;
        *(f32x4*)op = a0; *(f32x4*)(op + NADA) = a1; *(f32x4*)(op + 2 * NADA) = a2;
    }
    for (int it = gw; it < 2 * 288; it += NGW) {
        const int l = it / 288, r0 = (it % 288) * 8;
        const float* W1 = AIN(I_FW1) + l * 17 * 64; const float* W2 = AIN(I_FW2) + l * 64 * 64;
        float w1c[17], w2c[64];
#pragma unroll
        for (int i = 0; i < 17; ++i) w1c[i] = W1[i * 64 + lane];
#pragma unroll
        for (int k = 0; k < 64; ++k) w2c[k] = W2[k * 64 + lane];
        const float b1 = AIN(I_FB1)[l * 64 + lane], b2 = AIN(I_FB2)[l * 64 + lane];
        for (int rr = 0; rr < 8; ++rr) { const int row = r0 + rr; const int L = row < 256 ? 256 : 2048, t = row < 256 ? row : row - 256;
            float feat = 0.f;
            { const float tn = (float)t / (float)(L - 1), w = 6.283185307179586f * (float)t / (float)L;
              const int bi = (lane >= 9) ? lane - 9 : lane - 1; const float band = 1e-4f + (float)bi * ((7.0f - 1e-4f) / 7.0f); const float ang = w * band;
              feat = (lane == 0) ? tn : ((lane <= 8) ? cosf(ang) : -sinf(ang)); }
            float h1 = b1;
#pragma unroll
            for (int i = 0; i < 17; ++i) h1 += __builtin_bit_cast(float, __builtin_amdgcn_readlane(__builtin_bit_cast(int, feat), i)) * w1c[i];
            h1 = sinf(h1);
            float h2 = b2;
#pragma unroll
            for (int k = 0; k < 64; ++k) h2 += __builtin_bit_cast(float, __builtin_amdgcn_readlane(__builtin_bit_cast(int, h1), k)) * w2c[k];
            h2 = sinf(h2);
            WSP(float, WS_H2)[((size_t)l * 2304 + row) * 64 + lane] = h2; }
    }
    if (F.bid == 0) { const int pos = tid >> 3, i = tid & 7; const float inv = exp2f(-(float)i * (13.287712379549449f / 8.0f)); float s, c; sincosf((float)pos * inv, &s, &c);
        WSP(float, WS_ROPE)[(pos * 8 + i) * 2] = c; WSP(float, WS_ROPE)[(pos * 8 + i) * 2 + 1] = s; }
    for (int it = gt; it < 2048 * 512 + 256 * 64; it += NGT) {
        const bool isl = it < 2048 * 512; const int L = isl ? 2048 : 256, j = isl ? it : it - 2048 * 512, per = 2 * L / 8, k = j / per, t8 = (j % per) * 8, sh = isl ? 0 : 3;
        float v[8];
#pragma unroll
        for (int e = 0; e < 8; ++e) { const int tt = t8 + e, isS = tt >= L, t = tt - isS * L; const int ph = (k * t) & (L - 1);
            v[e] = isS ? -ctab[(((ph - L / 4) & (L - 1)) << sh)] : ctab[ph << sh]; }
        u32x4 o; o.x = pk2(v[0], v[1]); o.y = pk2(v[2], v[3]); o.z = pk2(v[4], v[5]); o.w = pk2(v[6], v[7]);
        *(u32x4*)((isl ? WSP(bf16_t, WS_DFTL) : WSP(bf16_t, WS_DFTC)) + (size_t)k * 2 * L + t8) = o;
    }
    for (int it = gt; it < 2 * 1024 * 32; it += NGT) { const int c8 = (it & 31) * 8, row = (it >> 5) & 1023, l = it >> 15; const int b = row >> 9, j = row & 511;
        u32x4 o = {0, 0, 0, 0};
        if (c8 < 128) { const float* sp = AIN(I_CCKV) + ((size_t)((b * 2 + l) * 512 + j)) * 128 + c8; const f32x4 x = *(const f32x4*)sp, y = *(const f32x4*)(sp + 4);
            o.x = pk2(x[0], x[1]); o.y = pk2(x[2], x[3]); o.z = pk2(y[0], y[1]); o.w = pk2(y[2], y[3]); }
        *(u32x4*)(WSP(bf16_t, WS_CKVB) + ((size_t)l * 1024 + row) * 256 + c8) = o; }
    for (int it = gt; it < 2 * 96 * 128; it += NGT) { const int c8 = (it & 127) * 8, r = (it >> 7) % 96, l = it / (96 * 128);
        *(u32x4*)(WSP(bf16_t, WS_W1T) + ((size_t)l * N1 + 416 + r) * DM + c8) = (u32x4){0, 0, 0, 0}; }
    for (int it = gt; it < 2 * 2 * 1024 * 16; it += NGT) { const int c8 = 128 + (it & 15) * 8, r = (it >> 4) & 1023, l = (it >> 14) & 1, wsel = it >> 15;
        *(u32x4*)((wsel ? WSP(bf16_t, WS_WKVR) : WSP(bf16_t, WS_WKVB)) + ((size_t)l * 1024 + r) * 256 + c8) = (u32x4){0, 0, 0, 0}; }
    __syncthreads();
}

__device__ __forceinline__ void norm_phase(Frame& F, const Args& A, int l, int which, bool first, bool from_partials) {
    TLW();
    LAS float* gm = (LAS float*)(F.lds);
    LAS float* sv = (LAS float*)(F.lds + 12288);
    for (int i = tid; i < 3 * DM; i += NTHR) { const int g = i >> 10, c = i & 1023; float s, sc;
        if (from_partials) { s = AIN(I_BADA)[l * NADA + (3 * which) * DM + c]; sc = AIN(I_BADA)[l * NADA + (3 * which + 1) * DM + c];
            for (int kc = 0; kc < 16; ++kc) { const float* pp = WSP(float, WS_ADAP) + ((size_t)(kc * 2 + l) * 3 + g) * NADA; s += pp[(3 * which) * DM + c]; sc += pp[(3 * which + 1) * DM + c]; } }
        else { const float* ad = WSP(float, WS_ADA) + ((size_t)l * 3 + g) * NADA; s = ad[(3 * which) * DM + c]; sc = ad[(3 * which + 1) * DM + c]; }
        gm[i] = AIN(I_NORMG)[(l * 3 + which) * DM + c] * (1.0f + sc); sv[i] = s; }
    __syncthreads();
    const int gw = F.bid * NWAVES + wave, NGW = F.G * NWAVES;
    for (int r = gw; r < MTOK; r += NGW) {
        const float* src = first ? (r < NCTX ? AIN(I_XP) + (size_t)r * DM : AIN(I_XS) + (size_t)(r - NCTX) * DM) : WSP(float, WS_H) + (size_t)r * DM;
        const int g = r < NCTX ? 0 : 1 + ((r - NCTX) >> 11);
        f32x4 v[4]; float s = 0.f;
#pragma unroll
        for (int j = 0; j < 4; ++j) { v[j] = *(const f32x4*)(src + 4 * lane + 256 * j); s += (v[j][0] * v[j][0] + v[j][1] * v[j][1]) + (v[j][2] * v[j][2] + v[j][3] * v[j][3]); }
        const float rstd = 1.0f / sqrtf(wave_sum(s) * (1.0f / DM) + EPSV);
        bf16_t* np = WSP(bf16_t, WS_N) + (size_t)r * DM;
#pragma unroll
        for (int j = 0; j < 4; ++j) { const int c = 4 * lane + 256 * j; const f32x4 gg = *(const LAS f32x4*)(gm + g * DM + c), ss = *(const LAS f32x4*)(sv + g * DM + c);
            const f32x4 y = v[j] * rstd * gg + ss; u32x2 w; w.x = cvtpk(y[0], y[1]); w.y = cvtpk(y[2], y[3]); *(u32x2*)(np + c) = w;
            if (first) *(f32x4*)(WSP(float, WS_H) + (size_t)r * DM + c) = v[j]; }
    }
    __syncthreads();
}
__device__ __forceinline__ void final_norm_phase(Frame& F, const Args& A) {
    TLW();
    const int gw = F.bid * NWAVES + wave, NGW = F.G * NWAVES;
    for (int r = gw; r < MTOK; r += NGW) {
        const float* src = WSP(float, WS_H) + (size_t)r * DM;
        f32x4 v[4]; float s = 0.f;
#pragma unroll
        for (int j = 0; j < 4; ++j) { v[j] = *(const f32x4*)(src + 4 * lane + 256 * j); s += (v[j][0] * v[j][0] + v[j][1] * v[j][1]) + (v[j][2] * v[j][2] + v[j][3] * v[j][3]); }
        const float rstd = 1.0f / sqrtf(wave_sum(s) * (1.0f / DM) + EPSV);
#pragma unroll
        for (int j = 0; j < 4; ++j) { const int c = 4 * lane + 256 * j; const f32x4 gg = *(const f32x4*)(AIN(I_FING) + c); *(f32x4*)(A.out + (size_t)r * DM + c) = v[j] * rstd * gg; }
    }
}

__device__ __forceinline__ void p0b_phase(Frame& F, const Args& A) {
    TLW();
    const int gt = F.bid * NTHR + tid, NGT = F.G * NTHR, gw = F.bid * NWAVES + wave, NGW = F.G * NWAVES;
    for (int it = gt; it < 2 * 3 * NADA; it += NGT) { const int c = it % NADA, g = (it / NADA) % 3, l = it / (3 * NADA); float s = AIN(I_BADA)[l * NADA + c];
        for (int kc = 0; kc < 16; ++kc) s += WSP(float, WS_ADAP)[((size_t)(kc * 2 + l) * 3 + g) * NADA + c];
        WSP(float, WS_ADA)[((size_t)l * 3 + g) * NADA + c] = s; }
    LAS float* tl = (LAS float*)(F.lds + wave * 16384);
    for (int it = gw; it < 2 * 36 * 16; it += NGW) {
        const int cc = it & 15, rc = (it >> 4) % 36, l = it / (36 * 16); const int L = rc < 4 ? 256 : 2048, t0 = rc < 4 ? rc * 64 : rc * 64 - 256;
        const float* W3 = AIN(I_FW3) + (size_t)l * 64 * 1024 + cc * 64 + lane;
        float w[64];
#pragma unroll
        for (int k = 0; k < 64; ++k) w[k] = W3[k * 1024];
        const float* hp = WSP(float, WS_H2) + ((size_t)l * 2304 + rc * 64) * 64;
#pragma unroll 2
        for (int tt = 0; tt < 64; ++tt) { float s = 0.f;
#pragma unroll
            for (int k = 0; k < 64; ++k) s += hp[tt * 64 + k] * w[k];
            tl[tt * 64 + (lane ^ tt)] = s; }
        asm volatile("s_waitcnt lgkmcnt(0)" ::: "memory");
        const int t = t0 + lane; const float tn = (float)t / (float)(L - 1);
        float* fb = WSP(float, WS_FILT) + (size_t)l * FILT_LAYER + (rc < 4 ? (size_t)512 * 4096 : 0);
        for (int ci = 0; ci < 64; ++ci) { const int col = cc * 64 + ci, ch = col & 255, oc = col & 511, dir = col >> 9;
            const float delta = -3.0701134573253944f + (float)ch * ((-15.350567286626972f + 3.0701134573253944f) / 255.0f);
            const float s = tl[lane * 64 + (ci ^ lane)] * expf(-tn * fabsf(delta));
            float* fr = fb + (size_t)oc * (2 * L);
            if (dir == 0) fr[L + t] = s; else if (t > 0) fr[L - t] = s; else fr[0] = 0.f; }
        asm volatile("s_waitcnt lgkmcnt(0)" ::: "memory");
    }
}

__device__ __forceinline__ void hyena_unit(Frame& F, const Args& A, int l, int unit) {
    TLW();
    const bool lat = unit < 512; const int uu = lat ? unit : unit - 512; const int sb = uu >> 8, c = uu & 255;
    const int L = lat ? 2048 : 256, tok0 = lat ? NCTX + sb * 2048 : sb * 2048;
    LAS float* Uv = (LAS float*)(F.lds);
    LAS float* Ux1 = Uv + 2048; LAS float* Ux2 = Ux1 + 2048; LAS float* Uz = Ux2 + 2048;
    LAS float* G0 = Uz + 2048;
    LAS float* G1 = G0 + 4104;
    LAS float* red = G1 + 4104;
    const bf16_t* hyt = WSP(bf16_t, WS_HYT);
    for (int i = tid; i < 3 * 2048; i += NTHR) { const int which = i >> 11, p = i & 2047, t = p & (L - 1); const int ch = (which == 0 ? 512 : (which == 1 ? 0 : 256)) + c;
        const bf16_t* hp = hyt + (size_t)ch * MTOK + tok0 + p; const float* cw = AIN(I_HCW) + (size_t)l * 3 * 768 + ch;
        const float xm = t > 0 ? bf2f(hp[-1]) : 0.f, x0 = bf2f(hp[0]), xp = t < L - 1 ? bf2f(hp[1]) : 0.f;
        const float val = xm * cw[0] + x0 * cw[768] + xp * cw[1536] + AIN(I_HCB)[l * 768 + ch];
        (which == 0 ? Uv : (which == 1 ? Ux1 : Ux2))[p] = val; }
    const float* fb = WSP(float, WS_FILT) + (size_t)l * FILT_LAYER + (lat ? 0 : (size_t)512 * 4096);
    float asum0 = 0.f, asum1 = 0.f;
    for (int i = tid; i < 2 * L + 4; i += NTHR) { const int j = i - 3; float f0 = 0.f, f1 = 0.f;
        if (j >= 0 && j < 2 * L) { f0 = fb[(size_t)c * (2 * L) + j]; f1 = fb[(size_t)(256 + c) * (2 * L) + j]; }
        G0[i] = f0; G1[i] = f1; asum0 += fabsf(f0); asum1 += fabsf(f1); }
    asum0 = wave_sum(asum0); asum1 = wave_sum(asum1);
    if (lane == 0) { red[wave] = asum0; red[8 + wave] = asum1; }
    __syncthreads();
    float n0 = 0.f, n1 = 0.f;
#pragma unroll
    for (int w = 0; w < 8; ++w) { n0 += red[w]; n1 += red[8 + w]; }
    const float inv0 = 1.0f / (n0 + EPSV), inv1 = 1.0f / (n1 + EPSV);
    const float sk0 = AIN(I_SKIP)[(l * 2 + 0) * 256 + c], sk1 = AIN(I_SKIP)[(l * 2 + 1) * 256 + c];
    const int o4 = 4 * tid, seg = o4 / L, t0 = o4 - seg * L, ub = seg * L;
#pragma unroll 1
    for (int ord = 0; ord < 2; ++ord) {
        const LAS float* U = ord == 0 ? Uv : Uz; const LAS float* G = ord == 0 ? G0 : G1;
        float acc[4] = {0.f, 0.f, 0.f, 0.f};
        for (int s0 = 0; s0 < L; s0 += 4) {
            const f32x4 u4 = *(const LAS f32x4*)(U + ub + s0);
            const int i0 = t0 - s0 + L;
            const f32x4 ga = *(const LAS f32x4*)(G + i0), gb = *(const LAS f32x4*)(G + i0 + 4);
            const float g[8] = {ga[0], ga[1], ga[2], ga[3], gb[0], gb[1], gb[2], gb[3]};
#pragma unroll
            for (int a = 0; a < 4; ++a)
#pragma unroll
                for (int b = 0; b < 4; ++b) acc[a] += g[a - b + 3] * u4[b];
        }
        if (ord == 0) {
#pragma unroll
            for (int a = 0; a < 4; ++a) Uz[o4 + a] = Ux1[o4 + a] * (acc[a] * inv0 + sk0 * Uv[o4 + a]);
            __syncthreads();
        } else {
#pragma unroll
            for (int a = 0; a < 4; ++a) { const float z = Ux2[o4 + a] * (acc[a] * inv1 + sk1 * Uz[o4 + a]); WSP(bf16_t, WS_Z)[(size_t)(tok0 + o4 + a) * 256 + c] = (bf16_t)f2bf(z); }
        }
    }
    __syncthreads();
}

constexpr int ST_PER_LAYER = 21, N_STEPS = 3 + 2 * ST_PER_LAYER;
#ifndef MK_ONE_LAUNCH
#define MK_ONE_LAUNCH 1
#endif
#ifndef PHSEL
#define PHSEL -1
#endif
#define PSEL(k) (PHSEL < 0 || PHSEL == (k))
#ifndef PROBE_REP
#define PROBE_REP 0
#endif
__host__ __device__ constexpr bool bar_after(int st) {
    if (st < 3) return st != 1;
    const int s = (st - 3) % ST_PER_LAYER;
    return !(s == 3 || s == 5 || s == 6 || s == 7 || s == 9 || s == 10 || s == 11 || s == 13 || s == 14);
}

template <class Epi> __device__ __forceinline__ void run_gemm(Frame& F, const bf16_t* Ap, int lda, const bf16_t* Bp, int ldb, int M, int N, int K, int cshift, const Epi& E) {
    pg8::Gemm g{Ap, Bp, M, N, K, lda, ldb}; pg8::StaticOrder S; S.init(M, N, F.G, (F.bid + F.G - cshift) % F.G);
    pg8::gemm_phase<Epi, pg8::StaticOrder, true, true>(F.lds, g, S, E);
}

__global__ void __launch_bounds__(NTHR, 2) mk_fwd(Args args) {
    extern __shared__ __attribute__((aligned(16))) unsigned char lds[];
    Frame F;
    F.lds = (LAS unsigned char*)lds; F.ldsg = (char*)lds;
    F.G = gridDim.x; F.bid = blockIdx.x;
    volatile LAS unsigned* MISC = (volatile LAS unsigned*)(F.lds + MISC_OFF);
    if (threadIdx.x < 64) ((LAS unsigned*)(F.lds + MISC_OFF))[threadIdx.x] = 0u;
    __syncthreads();
    const int lo = args.ph_lo, hi = args.ph_hi;
    XcdBarrier bar; bar.bar = (unsigned*)(args.ws + WS_CTL) + CW_BAR; bar.x = 0; bar.st = nullptr;
    if (args.use_bar) bar = xcd_barrier_post((unsigned*)(args.ws + WS_CTL) + CW_BAR, MISC + 8);
    const Args& A = args;

#pragma unroll 1
    for (int st = lo; st < hi; ++st) {
        { size_t z_ = 0; asm volatile("" : "+s"(z_)); F.ws = args.ws + z_; }
        int nrep = 1;
        if (PROBE_REP) { const int s_ = st < 3 ? -1 : (st - 3) % ST_PER_LAYER;
            if ((PROBE_REP & 1) && (s_ == 0 || s_ == 18)) nrep = 2;
            if ((PROBE_REP & 2) && (s_ == 1 || s_ == 19)) nrep = 2;
            if ((PROBE_REP & 4) && (s_ == 3 || s_ == 4)) nrep = 2;
            if ((PROBE_REP & 8) && s_ == 11) nrep = 2;
            if ((PROBE_REP & 16) && s_ == 12) nrep = 2;
            if ((PROBE_REP & 32) && (s_ == 9 || s_ == 10)) nrep = 2;
            if ((PROBE_REP & 64) && st == 0) nrep = 2;
            if ((PROBE_REP & 128) && (st == 2 || s_ == 2 || s_ == 17 || s_ == 20)) nrep = 2;
            if ((PROBE_REP & 512) && (s_ >= 5 && s_ <= 8)) nrep = 2;
            if ((PROBE_REP & 1024) && s_ == 16) nrep = 2;
            if ((PROBE_REP & 2048) && st == 1) nrep = 2;
            if ((PROBE_REP & 4096) && (s_ == 13 || s_ == 14 || s_ == 15)) nrep = 2; }
#pragma unroll 1
        for (int rep = 0; rep < nrep; ++rep) {
        const float gsm = (rep + 1 < nrep) ? 0.0f : 1.0f;
        if (st == 0) { if (PSEL(100)) p0_phase(F, A); }
        else if (st == 1) { if (PSEL(101)) p0b_phase(F, A); }
        else if (st == 2) { if (PSEL(102)) norm_phase(F, A, 0, 0, true, true); }
        else {
            const int l = (st - 3) / ST_PER_LAYER, s = (st - 3) % ST_PER_LAYER;
            const float* ada = WSP(float, WS_ADA) + (size_t)l * 3 * NADA;
            if ((s == 0 || s == 18) && PSEL(0)) {
                const int f = s == 0 ? 0 : 1;
                EpiSwiglu E{WSP(bf16_t, WS_ACT)};
                run_gemm(F, WSP(bf16_t, WS_N), DM, WSP(bf16_t, WS_WUP) + (size_t)(l * 2 + f) * NUP * DM, DM, MTOK, NUP, DM, 0, E);
            } else if ((s == 1 || s == 19) && PSEL(1)) {
                const int f = s == 1 ? 0 : 1;
                EpiResid E{WSP(float, WS_H), ada + (f == 0 ? 2 : 8) * DM, 0.5f * gsm};
                run_gemm(F, WSP(bf16_t, WS_ACT), DFF, WSP(bf16_t, WS_WDN) + (size_t)(l * 2 + f) * DM * DFF, DFF, MTOK, DM, DFF, 0, E);
            } else if (s == 2 && PSEL(2)) norm_phase(F, A, l, 1, false, false);
            else if (s == 3 && PSEL(3)) {
                EpiProj1 E1{WSP(bf16_t, WS_P1), WSP(float, WS_SSQ), WSP(float, WS_SSKV), WSP(float, WS_CKVRAW), WSP(float, WS_KRRAW)};
                run_gemm(F, WSP(bf16_t, WS_N), DM, WSP(bf16_t, WS_W1T) + (size_t)l * N1 * DM, DM, MTOK, N1, DM, 0, E1);
            } else if (s == 4 && PSEL(4)) {
                EpiT E2{WSP(bf16_t, WS_HYT), WSP(bf16_t, WS_XCTL), WSP(bf16_t, WS_XCTC)};
                run_gemm(F, WSP(bf16_t, WS_W2T) + (size_t)l * N2 * DM, DM, WSP(bf16_t, WS_N), DM, N2, MTOK, DM, 192, E2);
            } else if (s == 5 && PSEL(5)) {
                EpiQ EQ{WSP(bf16_t, WS_Q), WSP(float, WS_SSQ), WSP(float, WS_ROPE)};
                run_gemm(F, WSP(bf16_t, WS_P1), N1, WSP(bf16_t, WS_WQB) + (size_t)l * 768 * 256, 256, MTOK, 768, 256, 0, EQ);
            } else if (s == 6 && PSEL(6)) {
                EpiKV<false> EK{WSP(bf16_t, WS_KV), WSP(float, WS_SSKV)};
                run_gemm(F, WSP(bf16_t, WS_P1) + 256, N1, WSP(bf16_t, WS_WKVB) + (size_t)l * 1024 * 256, 256, MTOK, 1024, 256, 96, EK);
            } else if (s == 7 && PSEL(7)) {
                EpiKV<true> EC{WSP(bf16_t, WS_KV), nullptr};
                run_gemm(F, WSP(bf16_t, WS_CKVB) + (size_t)l * 1024 * 256, 256, WSP(bf16_t, WS_WKVR) + (size_t)l * 1024 * 256, 256, 1024, 1024, 256, 224, EC);
            } else if (s == 8 && PSEL(8)) {
                TLW(); const int gt = F.bid * NTHR + tid, NGT = F.G * NTHR;
                for (int it = gt; it < NCTX * 32; it += NGT) { const int r = it >> 5, c4 = (it & 31) * 4;
                    const f32x4 ss = *(const f32x4*)(WSP(float, WS_SSKV) + r * 4); const float rstd = 1.0f / sqrtf(((ss[0] + ss[1]) + (ss[2] + ss[3])) * (1.0f / 128.0f) + EPSV);
                    const f32x4 x = *(const f32x4*)(WSP(float, WS_CKVRAW) + (size_t)r * 128 + c4), g = *(const f32x4*)(AIN(I_KVNG) + l * 128 + c4);
                    *(f32x4*)(A.out + (size_t)MTOK * DM + ((size_t)((r >> 8) * 2 + l) * 256 + (r & 255)) * 128 + c4) = x * rstd * g; }
                for (int it = gt; it < MTOK * 4; it += NGT) { const int row = it >> 2, q = it & 3, part = q >> 1, ib = 4 * (q & 1);
                    const float* kp = WSP(float, WS_KRRAW) + (size_t)row * 32 + 8 * q; const f32x4 va = *(const f32x4*)kp, vb = *(const f32x4*)(kp + 4);
                    float v[8] = {va[0], va[1], va[2], va[3], vb[0], vb[1], vb[2], vb[3]};
                    if (row < NCTX) { float* op = A.out + (size_t)MTOK * DM + (size_t)16 * 2 * 256 * 128 + (size_t)((row >> 8) * 2 * 256 + l * 256 + (row & 255)) * 32 + part * 16 + ib;
#pragma unroll
                        for (int e = 0; e < 8; ++e) op[(e & 1) * 8 + (e >> 1)] = v[e];
                    } else { const int t = (row - NCTX) & 2047, pos = part == 0 ? (t >> 6) : (t & 63); const float* rt = WSP(float, WS_ROPE) + (pos * 8 + ib) * 2;
#pragma unroll
                        for (int e = 0; e < 8; e += 2) { const float cs = rt[e], sn = rt[e + 1], x1 = v[e], x2 = v[e + 1]; v[e] = x1 * cs - x2 * sn; v[e + 1] = x2 * cs + x1 * sn; } }
                    u32x4 w; w.x = cvtpk(v[0], v[1]); w.y = cvtpk(v[2], v[3]); w.z = cvtpk(v[4], v[5]); w.w = cvtpk(v[6], v[7]);
                    *(u32x4*)(WSP(bf16_t, WS_KR) + (size_t)kvrow_of(row) * 32 + 8 * q) = w; }
                for (int it = gt; it < 2 * 512 * 32; it += NGT) { const int pp = it & 31, j = (it >> 5) & 511, b = it >> 14; const int part = pp >> 4, w = pp & 15, i = w >> 1, half = w & 1, p = part * 16 + half * 8 + i;
                    WSP(bf16_t, WS_KR)[(size_t)(NCTX + b * 2560 + 2048 + j) * 32 + pp] = (bf16_t)f2bf(AIN(I_CKR)[((size_t)(b * 2 + l) * 512 + j) * 32 + p]); }
            } else if (s == 9 && PSEL(9)) {
                EpiFn EL{WSP(bf16_t, WS_FN), 1, 0.00276213586400995f};
                run_gemm(F, WSP(bf16_t, WS_DFTL), 4096, WSP(bf16_t, WS_XCTL), 4096, 2048, 512, 4096, 128, EL);
            } else if (s == 10 && PSEL(10)) {
                EpiFn EC{WSP(bf16_t, WS_FN), 0, 0.0078125f};
                run_gemm(F, WSP(bf16_t, WS_DFTC), 512, WSP(bf16_t, WS_XCTC), 512, 256, 4096, 512, 144, EC);
            } else if (s == 11 && PSEL(11)) {
                for (int u = F.bid; u < 256; u += F.G) {
                    const bf16_t *Qb, *KVh, *KRr; bf16_t* Ob; int seq;
                    if (u < 128) { const int b = u >> 6, h = (u >> 3) & 7, qb = u & 7; const int r0 = NCTX + b * 2048 + qb * 256, k0 = NCTX + b * 2560;
                        Qb = WSP(bf16_t, WS_Q) + (size_t)r0 * 768 + h * 96; KVh = WSP(bf16_t, WS_KV) + (size_t)k0 * 1024 + h * 128; KRr = WSP(bf16_t, WS_KR) + (size_t)k0 * 32; Ob = WSP(bf16_t, WS_O) + (size_t)r0 * 512 + h * 64; seq = 2560; }
                    else { const int v = u - 128, b = v >> 3, h = v & 7; const int r0 = b * 256;
                        Qb = WSP(bf16_t, WS_Q) + (size_t)r0 * 768 + h * 96; KVh = WSP(bf16_t, WS_KV) + (size_t)r0 * 1024 + h * 128; KRr = WSP(bf16_t, WS_KR) + (size_t)r0 * 32; Ob = WSP(bf16_t, WS_O) + (size_t)r0 * 512 + h * 64; seq = 256; }
                    att::attn_unit(Qb, KVh, KRr, Ob, seq, F.ldsg);
                }
            } else if (s == 12 && PSEL(12)) {
                for (int u = F.bid; u < 1024; u += F.G) hyena_unit(F, A, l, u);
            } else if (s == 13 && PSEL(13)) {
                EpiGate<0> E0{WSP(float, WS_Y), WSP(bf16_t, WS_N), WSP(bf16_t, WS_P1) + 512, 1.0f};
                run_gemm(F, WSP(bf16_t, WS_Z), 256, WSP(bf16_t, WS_WHY) + (size_t)l * 1024 * 256, 256, MTOK, DM, 256, 0, E0);
            } else if (s == 14 && PSEL(14)) {
                EpiGate<1> E1{WSP(float, WS_Y), WSP(bf16_t, WS_N), WSP(bf16_t, WS_P1) + 512 + 1024, gsm};
                run_gemm(F, WSP(bf16_t, WS_O), 512, WSP(bf16_t, WS_WMLA) + (size_t)l * 1024 * 512, 512, MTOK, DM, 512, 0, E1);
            } else if (s == 15 && PSEL(15)) {
                EpiGate<2> E2{WSP(float, WS_Y), WSP(bf16_t, WS_N), WSP(bf16_t, WS_P1) + 512 + 2048, 1.0f};
                run_gemm(F, WSP(bf16_t, WS_FN), 256, WSP(bf16_t, WS_WFN) + (size_t)l * 1024 * 256, 256, MTOK, DM, 256, 0, E2);
            } else if (s == 16 && PSEL(16)) {
                EpiResid E{WSP(float, WS_H), ada + 5 * DM, 1.0f * gsm};
                run_gemm(F, WSP(bf16_t, WS_N), DM, WSP(bf16_t, WS_WOUT) + (size_t)l * DM * DM, DM, MTOK, DM, DM, 0, E);
            } else if (s == 17 && PSEL(17)) norm_phase(F, A, l, 2, false, false);
            else if (s == 20 && PSEL(20)) { if (l == 0) norm_phase(F, A, 1, 0, false, false); else final_norm_phase(F, A); }
        }
        if (rep + 1 < nrep) { asm volatile("s_waitcnt vmcnt(0)" ::: "memory"); __syncthreads(); }
        }
        if (st + 1 < hi) { if (bar_after(st)) { xcd_barrier(bar); if (PROBE_REP & 256) xcd_barrier(bar); } else { asm volatile("s_waitcnt vmcnt(0)" ::: "memory"); __syncthreads(); } }
    }
}

extern "C" void kernel_launch(void* const* d_in, const int* in_sizes, int n_in, void* d_out, int out_size, void* d_ws, size_t ws_size, hipStream_t stream) {
    static int grid = 0;
    if (grid == 0) {
        if (n_in != 29 || ws_size < WS_END) { fprintf(stderr, "kernel_launch: n_in %d ws %zu (need %zu)\n", n_in, ws_size, (size_t)WS_END); grid = -1; return; }
        int dev = 0, cus = 0;
        if (hipGetDevice(&dev) != hipSuccess || hipDeviceGetAttribute(&cus, hipDeviceAttributeMultiprocessorCount, dev) != hipSuccess) { grid = -1; return; }
        if (hipFuncSetAttribute((const void*)mk_fwd, hipFuncAttributeMaxDynamicSharedMemorySize, LDS_BYTES) != hipSuccess) { fprintf(stderr, "kernel_launch: hipFuncSetAttribute failed\n"); grid = -1; return; }
        grid = cus;
    }
    if (grid < 0) return;
    (void)hipMemsetAsync((char*)d_ws + WS_CTL, 0, CTL_BYTES, stream);
    Args a{};
    for (int i = 0; i < 29; ++i) a.in[i] = (const float*)d_in[i];
    a.out = (float*)d_out; a.ws = (unsigned char*)d_ws;
#if MK_ONE_LAUNCH
    a.ph_lo = 0; a.ph_hi = N_STEPS; a.use_bar = 1;
    hipLaunchKernelGGL(mk_fwd, dim3(grid), dim3(NTHR), LDS_BYTES, stream, a);
#else
    a.use_bar = 0;
    for (int s0 = 0; s0 < N_STEPS;) { int s1 = s0; while (!bar_after(s1)) ++s1; a.ph_lo = s0; a.ph_hi = s1 + 1; hipLaunchKernelGGL(mk_fwd, dim3(grid), dim3(NTHR), LDS_BYTES, stream, a); s0 = s1 + 1; }
#endif
}
```

```cpp
#include <hip/hip_runtime.h>
#include <cstdio>
#include <cstdint>
namespace pg8 {
#define PG8_LAS __attribute__((address_space(3)))
typedef unsigned short bf16_t;
typedef short bf16x8 __attribute__((ext_vector_type(8)));
typedef float f32x4 __attribute__((ext_vector_type(4)));
typedef unsigned u32x4 __attribute__((ext_vector_type(4)));
constexpr int BM = 256, BK = 64, HALF = 128, HTB = HALF * BK * 2  , STAGE_BYTES = 8 * HTB, NXCD = 8, WGM = 8;

__host__ __device__ __forceinline__ int lds_byte(int r, int c) { const int st = (r >> 4) * 2 + (c >> 5), rr = r & 15, cc = c & 31, ob = rr * 64 + cc * 2; return st * 1024 + (ob ^ (((ob >> 9) & 1) << 5)); }
__host__ __device__ __forceinline__ void stage_rc(int b, int& R, int& C) { const int st = b / 1024, sb = b % 1024, swz = sb ^ (((sb >> 9) & 1) << 5); R = (st >> 1) * 16 + swz / 64; C = (st & 1) * 32 + (swz % 64) / 2; }
__host__ __device__ __forceinline__ int perm32(int rho) { const int n = rho >> 4, i = rho & 15; return 8 * (i >> 2) + 4 * n + (i & 3); }

struct Unit { int pm, pn; };
struct Gemm { const bf16_t* A; const bf16_t* Bt; int M, N, K, lda, ldb; };

struct StaticOrder {
    int nM, nN, nwg, G, c;
    __host__ __device__ void init(int M, int N, int G_, int c_) { nM = M / BM; nN = N / BM; nwg = nM * nN; G = G_; c = c_; }
    __host__ __device__ bool next(int i, Unit& u) const {
        const long L = (long)i * G + c; if (L >= nwg) return false;
        int wgid = (int)L; { const int q = nwg / NXCD, r = nwg % NXCD, xcd = wgid % NXCD, off = wgid / NXCD; wgid = (xcd < r ? xcd * (q + 1) : r * (q + 1) + (xcd - r) * q) + off; }
        const int nig = WGM * nN, gid = wgid / nig, fm = gid * WGM, gsz = (nM - fm) < WGM ? (nM - fm) : WGM;
        u.pm = fm + ((wgid % nig) % gsz); u.pn = (wgid % nig) / gsz; return true;
    }
    __device__ __forceinline__ void a_ready(const Unit&) const {}
    __device__ __forceinline__ void done(const Unit&) const {}
};


__device__ __forceinline__ f32x4 zero4_() { float a, b, c, d; asm volatile("v_mov_b32 %0, 0\n\tv_mov_b32 %1, 0\n\tv_mov_b32 %2, 0\n\tv_mov_b32 %3, 0" : "=v"(a), "=v"(b), "=v"(c), "=v"(d)); return (f32x4){a, b, c, d}; }
template <class Epi, class Sched, bool ALIGN_EPI = false, bool SP2 = false>
__device__ __forceinline__ void gemm_phase(PG8_LAS unsigned char* lds, const Gemm g, const Sched& S, const Epi& E) {
    int tid_ = threadIdx.x; asm volatile("" : "+v"(tid_));
    const int tid = tid_, wid = __builtin_amdgcn_readfirstlane(tid >> 6), lane = tid & 63, wr = wid >> 2, wc = wid & 3, fr = lane & 15, fq = lane >> 4;
    const int K = g.K, nt = K / BK;
    unsigned voffA[2], voffB[2];
#pragma unroll
    for (int i = 0; i < 2; ++i) { int R, C; stage_rc(tid * 16 + i * 8192, R, C); const int Rb = Epi::PERM ? ((R & ~31) + perm32(R & 31)) : R;
        voffA[i] = (unsigned)(R * g.lda + C) * 2u; voffB[i] = (unsigned)(Rb * g.ldb + C) * 2u; }
    const size_t kstep = (size_t)(BK * 2);
    const size_t hstepA = (size_t)HALF * g.lda * 2, hstepB = (size_t)HALF * g.ldb * 2;
    const size_t tstepA = 2 * hstepA, tstepB = 2 * hstepB;
    const unsigned ldsw = (unsigned)wid * 1024u;
    const int aoff = lds_byte(wr * 64 + fr, fq * 8), boff = lds_byte(wc * 32 + fr, fq * 8);
#define PG8_SA(b, h) (((b) * 2 + (h)) * HTB)
#define PG8_SB(b, h) ((4 + (b) * 2 + (h)) * HTB)
#define PG8_STAGE(bufoff, gbase, voff) do { _Pragma("unroll") for (int _i = 0; _i < 2; ++_i) \
        __builtin_amdgcn_global_load_lds((const unsigned*)((const char*)(gbase) + (voff)[_i]), (PG8_LAS unsigned*)(lds + (bufoff) + ldsw + _i * 8192), 16, 0, 0); } while (0)
#define PG8_LDA(dst, b, h) do { _Pragma("unroll") for (int m = 0; m < 4; ++m) _Pragma("unroll") for (int k = 0; k < 2; ++k) dst[m][k] = *(const PG8_LAS bf16x8*)(lds + PG8_SA(b, h) + aoff + m * 2048 + k * 1024); } while (0)
#define PG8_LDB(dst, b, h) do { _Pragma("unroll") for (int n = 0; n < 2; ++n) _Pragma("unroll") for (int k = 0; k < 2; ++k) dst[n][k] = *(const PG8_LAS bf16x8*)(lds + PG8_SB(b, h) + boff + n * 2048 + k * 1024); } while (0)
#define PG8_MMA(ai, bj, At, Bt) do { __builtin_amdgcn_s_setprio(1); _Pragma("unroll") for (int m = 0; m < 4; ++m) _Pragma("unroll") for (int n = 0; n < 2; ++n) _Pragma("unroll") for (int k = 0; k < 2; ++k) \
        acc[ai][bj][m][n] = __builtin_amdgcn_mfma_f32_16x16x32_bf16(Bt[n][k], At[m][k], acc[ai][bj][m][n], 0, 0, 0); __builtin_amdgcn_s_setprio(0); } while (0)
#define PG8_WAIT_V(n) asm volatile("s_waitcnt vmcnt(" #n ")" ::: "memory")
#define PG8_WAIT_L(n) asm volatile("s_waitcnt lgkmcnt(" #n ")" ::: "memory")
#define PG8_BAR __builtin_amdgcn_s_barrier()
#define PG8_SCHED __builtin_amdgcn_sched_barrier(0)
    Unit cur, nxt; int ui = 0;
    if (!S.next(0, cur)) return;
    f32x4 acc[2][2][4][2];
#pragma unroll
    for (int a = 0; a < 2; ++a)
#pragma unroll
        for (int b = 0; b < 2; ++b)
#pragma unroll
            for (int m = 0; m < 4; ++m)
#pragma unroll
                for (int n = 0; n < 2; ++n) acc[a][b][m][n] = zero4_();
    bf16x8 At[4][2], B0[2][2], B1[2][2];
    const char* cA = (const char*)g.A + (size_t)cur.pm * tstepA; const char* cB = (const char*)g.Bt + (size_t)cur.pn * tstepB;
    S.a_ready(cur);
    if constexpr (SP2) {
        PG8_STAGE(PG8_SB(0, 0), cB, voffB); PG8_STAGE(PG8_SB(0, 1), cB + hstepB, voffB); PG8_STAGE(PG8_SA(0, 0), cA, voffA); PG8_STAGE(PG8_SA(0, 1), cA + hstepA, voffA);
        if (wr == 1) PG8_BAR;
        PG8_WAIT_V(2); PG8_BAR;
        PG8_STAGE(PG8_SB(1, 0), cB + kstep, voffB); PG8_STAGE(PG8_SA(1, 0), cA + kstep, voffA); PG8_STAGE(PG8_SB(1, 1), cB + hstepB + kstep, voffB);
        PG8_WAIT_V(6); PG8_BAR;
    } else {
        PG8_STAGE(PG8_SB(0, 0), cB, voffB); PG8_STAGE(PG8_SA(0, 0), cA, voffA); PG8_STAGE(PG8_SB(0, 1), cB + hstepB, voffB); PG8_STAGE(PG8_SA(0, 1), cA + hstepA, voffA);
        if (wr == 1) PG8_BAR;
        PG8_WAIT_V(4); PG8_BAR;
        PG8_STAGE(PG8_SB(1, 0), cB + kstep, voffB); PG8_STAGE(PG8_SA(1, 0), cA + kstep, voffA); PG8_STAGE(PG8_SB(1, 1), cB + hstepB + kstep, voffB);
        PG8_WAIT_V(6); PG8_BAR;
    }
#pragma unroll 1
    for (;;) {
        const bool has_next = S.next(ui + 1, nxt);
        const char* nA = has_next ? (const char*)g.A + (size_t)nxt.pm * tstepA : cA; const char* nB = has_next ? (const char*)g.Bt + (size_t)nxt.pn * tstepB : cB;
#pragma unroll 1
        for (int t = 0; t < nt; t += 2) {
            const bool last = (t == nt - 2);
            const char* a1 = cA + (size_t)(t + 1) * kstep;
            const char* a2 = last ? nA : cA + (size_t)(t + 2) * kstep; const char* b2 = last ? nB : cB + (size_t)(t + 2) * kstep;
            const char* a3 = a2 + kstep; const char* b3 = b2 + kstep;
            if (last && has_next) S.a_ready(nxt);
            if constexpr (SP2) {
            PG8_LDB(B0, 0, 0); PG8_LDB(B1, 0, 1); PG8_SCHED; PG8_LDA(At, 0, 0); PG8_STAGE(PG8_SA(1, 1), a1 + hstepA, voffA);
            PG8_WAIT_V(8); PG8_WAIT_L(0); PG8_BAR; PG8_MMA(0, 0, At, B0); PG8_MMA(0, 1, At, B1); PG8_BAR; PG8_SCHED;
            PG8_LDA(At, 0, 1); PG8_STAGE(PG8_SB(0, 0), b2, voffB); PG8_STAGE(PG8_SB(0, 1), b2 + hstepB, voffB); PG8_STAGE(PG8_SA(0, 0), a2, voffA);
            PG8_WAIT_V(8); PG8_WAIT_L(0); PG8_BAR; PG8_MMA(1, 0, At, B0); PG8_MMA(1, 1, At, B1); PG8_BAR; PG8_SCHED;
            PG8_LDB(B0, 1, 0); PG8_LDB(B1, 1, 1); PG8_SCHED; PG8_LDA(At, 1, 0); PG8_STAGE(PG8_SA(0, 1), a2 + hstepA, voffA);
            PG8_WAIT_V(8); PG8_WAIT_L(0); PG8_BAR; PG8_MMA(0, 0, At, B0); PG8_MMA(0, 1, At, B1); PG8_BAR; PG8_SCHED;
            PG8_LDA(At, 1, 1); PG8_STAGE(PG8_SB(1, 0), b3, voffB); PG8_STAGE(PG8_SB(1, 1), b3 + hstepB, voffB); PG8_STAGE(PG8_SA(1, 0), a3, voffA);
            PG8_WAIT_V(8); PG8_WAIT_L(0); PG8_BAR; PG8_MMA(1, 0, At, B0); PG8_MMA(1, 1, At, B1); PG8_BAR; PG8_SCHED;
            } else {
            PG8_LDB(B0, 0, 0); PG8_SCHED; PG8_LDA(At, 0, 0); PG8_STAGE(PG8_SA(1, 1), a1 + hstepA, voffA);
            PG8_WAIT_L(8); PG8_BAR; PG8_WAIT_L(0); PG8_MMA(0, 0, At, B0); PG8_BAR; PG8_SCHED;
            PG8_LDB(B1, 0, 1); PG8_STAGE(PG8_SB(0, 0), b2, voffB);
            PG8_BAR; PG8_WAIT_L(0); PG8_MMA(0, 1, At, B1); PG8_BAR;
            PG8_LDA(At, 0, 1); PG8_STAGE(PG8_SA(0, 0), a2, voffA);
            PG8_BAR; PG8_WAIT_L(0); PG8_MMA(1, 0, At, B0); PG8_BAR; PG8_SCHED;
            PG8_STAGE(PG8_SB(0, 1), b2 + hstepB, voffB);
            PG8_WAIT_V(6); PG8_BAR; PG8_MMA(1, 1, At, B1); PG8_BAR;
            PG8_LDB(B0, 1, 0); PG8_SCHED; PG8_LDA(At, 1, 0); PG8_STAGE(PG8_SA(0, 1), a2 + hstepA, voffA);
            PG8_WAIT_L(8); PG8_BAR; PG8_WAIT_L(0); PG8_MMA(0, 0, At, B0); PG8_BAR; PG8_SCHED;
            PG8_LDB(B1, 1, 1); PG8_STAGE(PG8_SB(1, 0), b3, voffB);
            PG8_BAR; PG8_WAIT_L(0); PG8_MMA(0, 1, At, B1); PG8_BAR;
            PG8_LDA(At, 1, 1); PG8_STAGE(PG8_SA(1, 0), a3, voffA);
            PG8_BAR; PG8_WAIT_L(0); PG8_MMA(1, 0, At, B0); PG8_BAR; PG8_SCHED;
            PG8_STAGE(PG8_SB(1, 1), b3 + hstepB, voffB);
            PG8_WAIT_V(6); PG8_BAR; PG8_MMA(1, 1, At, B1); PG8_BAR;
            }
        }
        if constexpr (ALIGN_EPI) { if (wr == 0) PG8_BAR; }
        if constexpr (!Epi::AFTER_DRAIN) { E(acc, cur, wr, wc, fr, fq); S.done(cur); }
        if (!has_next) break;
#pragma unroll
        for (int a = 0; a < 2; ++a)
#pragma unroll
            for (int b = 0; b < 2; ++b)
#pragma unroll
                for (int m = 0; m < 4; ++m)
#pragma unroll
                    for (int n = 0; n < 2; ++n) acc[a][b][m][n] = zero4_();
        cur = nxt; cA = nA; cB = nB; ++ui;
        if constexpr (ALIGN_EPI) { if (wr == 1) PG8_BAR; }
    }
    PG8_WAIT_V(0);
    if constexpr (!ALIGN_EPI) { if (wr == 0) PG8_BAR; }
    PG8_BAR;
    if constexpr (Epi::AFTER_DRAIN) { E.fused(acc, cur, wr, wc, fr, fq, lds, wid, lane); S.done(cur); }
#undef PG8_SA
#undef PG8_SB
#undef PG8_STAGE
#undef PG8_LDA
#undef PG8_LDB
#undef PG8_MMA
#undef PG8_WAIT_V
#undef PG8_WAIT_L
#undef PG8_BAR
#undef PG8_SCHED
}
}

#define GAS __attribute__((address_space(1)))
#define LAS __attribute__((address_space(3)))
typedef unsigned short bf16_t;
typedef float f32x4 __attribute__((ext_vector_type(4)));
typedef float f32x8 __attribute__((ext_vector_type(8)));
typedef float f32x16 __attribute__((ext_vector_type(16)));
typedef short bf16x8 __attribute__((ext_vector_type(8)));
typedef short s16x4 __attribute__((ext_vector_type(4)));
typedef unsigned u32x4 __attribute__((ext_vector_type(4)));
typedef unsigned u32x2 __attribute__((ext_vector_type(2)));

constexpr int DM = 1024, MTOK = 8192, NCTX = 4096, LCTX = 256, LLAT = 2048;
constexpr int DFF = 2816, NUP = 5632, INC = 4512;
constexpr int N1 = 3584;
constexpr int N2 = 1280;
constexpr int KVROWS = 9216;
constexpr int NADA = 9216;
constexpr float EPSV = 1e-6f;
constexpr int NWAVES = 8, NTHR = 512;

constexpr size_t al256(size_t x) { return (x + 255) & ~(size_t)255; }
constexpr size_t WS_CTL = 0, CTL_BYTES = 1u << 20;
constexpr size_t WS_ADAP = WS_CTL + CTL_BYTES;
constexpr size_t WS_ADA  = WS_ADAP + al256((size_t)16 * 2 * 3 * NADA * 4);
constexpr size_t WS_SSQ  = WS_ADA + al256((size_t)2 * 3 * NADA * 4);
constexpr size_t WS_SSKV = WS_SSQ + al256((size_t)MTOK * 4 * 4);
constexpr size_t WS_ROPE = WS_SSKV + al256((size_t)MTOK * 4 * 4);
constexpr size_t WS_H2   = WS_ROPE + al256(64 * 8 * 2 * 4);
constexpr size_t WS_FILT = WS_H2 + al256((size_t)2 * 2304 * 64 * 4);
constexpr size_t FILT_LAYER = (size_t)512 * 4096 + (size_t)512 * 512;
constexpr size_t WS_CKVRAW = WS_FILT + al256(2 * FILT_LAYER * 4);
constexpr size_t WS_KRRAW = WS_CKVRAW + al256((size_t)NCTX * 128 * 4);
constexpr size_t WS_CKVB = WS_KRRAW + al256((size_t)MTOK * 32 * 4);
constexpr size_t WS_WUP  = WS_CKVB + al256((size_t)2 * 1024 * 256 * 2);
constexpr size_t WS_WDN  = WS_WUP + al256((size_t)4 * NUP * DM * 2);
constexpr size_t WS_W1T  = WS_WDN + al256((size_t)4 * DM * DFF * 2);
constexpr size_t WS_W2T  = WS_W1T + al256((size_t)2 * N1 * DM * 2);
constexpr size_t WS_WQB  = WS_W2T + al256((size_t)2 * N2 * DM * 2);
constexpr size_t WS_WKVB = WS_WQB + al256((size_t)2 * 768 * 256 * 2);
constexpr size_t WS_WKVR = WS_WKVB + al256((size_t)2 * 1024 * 256 * 2);
constexpr size_t WS_WHY  = WS_WKVR + al256((size_t)2 * 1024 * 256 * 2);
constexpr size_t WS_WMLA = WS_WHY + al256((size_t)2 * 1024 * 256 * 2);
constexpr size_t WS_WFN  = WS_WMLA + al256((size_t)2 * 1024 * 512 * 2);
constexpr size_t WS_WOUT = WS_WFN + al256((size_t)2 * 1024 * 256 * 2);
constexpr size_t WS_DFTL = WS_WOUT + al256((size_t)2 * 1024 * 1024 * 2);
constexpr size_t WS_DFTC = WS_DFTL + al256((size_t)2048 * 4096 * 2);
constexpr size_t WS_H    = WS_DFTC + al256((size_t)256 * 512 * 2);
constexpr size_t WS_N    = WS_H + al256((size_t)MTOK * DM * 4);
constexpr size_t WS_KV   = WS_N + al256((size_t)MTOK * DM * 2);
constexpr size_t WS_KR   = WS_KV + al256((size_t)KVROWS * 1024 * 2);
constexpr size_t WS_R1   = WS_KR + al256((size_t)KVROWS * 32 * 2);
constexpr size_t WS_ACT  = WS_R1;
constexpr size_t WS_P1   = WS_R1;
constexpr size_t WS_HYT  = WS_P1 + al256((size_t)MTOK * N1 * 2);
constexpr size_t WS_XCTL = WS_HYT + al256((size_t)768 * MTOK * 2);
constexpr size_t WS_XCTC = WS_XCTL + al256((size_t)512 * 4096 * 2);
constexpr size_t WS_Q    = WS_XCTC + al256((size_t)4096 * 512 * 2);
constexpr size_t WS_O    = WS_Q + al256((size_t)MTOK * 768 * 2);
constexpr size_t WS_Z    = WS_O + al256((size_t)MTOK * 512 * 2);
constexpr size_t WS_FN   = WS_Z + al256((size_t)MTOK * 256 * 2);
constexpr size_t WS_Y    = WS_FN + al256((size_t)MTOK * 256 * 2);
constexpr size_t WS_END  = WS_Y + al256((size_t)MTOK * DM * 4);
static_assert(WS_ACT + (size_t)MTOK * DFF * 2 <= WS_END, "ws map");

constexpr int CW_BAR = 4096;

constexpr int RING_BYTES = 131072;
constexpr int MISC_OFF = 155648 - 256;
constexpr int LDS_BYTES = 155648;

__device__ __forceinline__ unsigned f2bf(float f) { unsigned u = __builtin_bit_cast(unsigned, f); return (u + 0x7fffu + ((u >> 16) & 1u)) >> 16; }
__device__ __forceinline__ unsigned pk2(float lo, float hi) { return f2bf(lo) | (f2bf(hi) << 16); }
__device__ __forceinline__ float bf2f(unsigned short b) { return __builtin_bit_cast(float, (unsigned)b << 16); }
__device__ __forceinline__ float bflo(unsigned w) { return __builtin_bit_cast(float, w << 16); }
__device__ __forceinline__ float bfhi(unsigned w) { return __builtin_bit_cast(float, w & 0xffff0000u); }
__device__ __forceinline__ unsigned cvtpk(float lo, float hi) { unsigned r; asm volatile("v_cvt_pk_bf16_f32 %0, %1, %2" : "=v"(r) : "v"(lo), "v"(hi)); return r; }
__device__ __forceinline__ u32x4 pack8(f32x4 a, f32x4 b) { u32x4 w; w.x = cvtpk(a[0], a[1]); w.y = cvtpk(a[2], a[3]); w.z = cvtpk(b[0], b[1]); w.w = cvtpk(b[2], b[3]); return w; }
__device__ __forceinline__ float wave_sum(float v) {
#pragma unroll
    for (int o = 1; o < 64; o <<= 1) v += __shfl_xor(v, o);
    return v;
}
__device__ __forceinline__ float sigmoidf_(float x) { return 1.0f / (1.0f + __expf(-x)); }
__device__ __forceinline__ float siluf_(float x) { return x / (1.0f + __expf(-x)); }
__device__ __forceinline__ int grp_of_pm(int pm) { return pm < 16 ? 0 : (pm < 24 ? 1 : 2); }
__device__ __forceinline__ int kvrow_of(int r) { return r < NCTX ? r : NCTX + ((r - NCTX) >> 11) * 2560 + ((r - NCTX) & 2047); }

#define XB_TMO      128
#define XB_XCNT(j)  (256  + 64 * (j))
#define XB_XSUB(j)  (1280 + 64 * (j))
#define XB_XGEN(j)  (2304 + 64 * (j))
#define XB_TOP      3328
#define XB_TOPGEN   3392
#define XCD_BAR_WORDS 3456
#define XB_SPIN_CAP (1u << 20)
__device__ __forceinline__ unsigned xb_ld(unsigned* p)              { return __hip_atomic_load(p, __ATOMIC_RELAXED, __HIP_MEMORY_SCOPE_AGENT); }
__device__ __forceinline__ unsigned xb_add(unsigned* p, unsigned v) { return __hip_atomic_fetch_add(p, v, __ATOMIC_RELAXED, __HIP_MEMORY_SCOPE_AGENT); }
__device__ __forceinline__ unsigned xb_xcc_id() { return (unsigned)__builtin_amdgcn_s_getreg((3 << 11) | 20) & 0xFu; }
#define XB_SPIN(cond, bar) do { unsigned _sp = 0; while (cond) { __builtin_amdgcn_s_sleep(1); \
    if ((++_sp & 255u) == 0u) { if (xb_ld(&(bar)[XB_TMO])) break; if (_sp > XB_SPIN_CAP) { atomicAdd(&(bar)[XB_TMO], 1u); break; } } } } while (0)
struct XcdBarrier { unsigned* bar; unsigned x; volatile LAS unsigned* st; };
__device__ __forceinline__ XcdBarrier xcd_barrier_post(unsigned* bar, volatile LAS unsigned* st) {
    XcdBarrier b; b.bar = bar; b.x = xb_xcc_id(); b.st = st;
    if (threadIdx.x == 0) (void)xb_add(&bar[XB_XCNT(b.x)], 1u);
    return b;
}
__device__ __forceinline__ void xcd_barrier_complete(unsigned* bar, unsigned x, unsigned& nloc, unsigned& nx) {
    const unsigned G = gridDim.x * gridDim.y * gridDim.z;
    unsigned sum, cnt, mine, sp = 0u;
    for (;;) {
        sum = 0u; cnt = 0u; mine = 0u;
#pragma unroll 1
        for (unsigned j = 0; j < 16; ++j) { const unsigned c = xb_ld(&bar[XB_XCNT(j)]); sum += c; cnt += (c > 0u) ? 1u : 0u; mine = (j == x) ? c : mine; }
        if (sum == G) break;
        __builtin_amdgcn_s_sleep(1);
        if ((++sp & 255u) == 0u) { if (xb_ld(&bar[XB_TMO])) break; if (sp > XB_SPIN_CAP) { atomicAdd(&bar[XB_TMO], 1u); break; } }
    }
    nloc = mine > 0u ? mine : 1u; nx = cnt > 0u ? cnt : 1u;
}
__device__ __forceinline__ void xcd_barrier(const XcdBarrier& b) {
    asm volatile("s_waitcnt vmcnt(0)" ::: "memory");
    __syncthreads();
    if (threadIdx.x == 0) {
        size_t z_ = 0; asm volatile("" : "+s"(z_));
        unsigned* bar = b.bar + z_;
        __builtin_amdgcn_s_waitcnt(0);
        unsigned nloc = b.st[0], nx = b.st[1];
        if (nloc == 0u) { xcd_barrier_complete(bar, b.x, nloc, nx); b.st[0] = nloc; b.st[1] = nx; }
        const unsigned old = xb_add(&bar[XB_XSUB(b.x)], 1u);
        const unsigned gen = old / nloc;
        if (old + 1u == (gen + 1u) * nloc) {
            __builtin_amdgcn_fence(__ATOMIC_RELEASE, "agent");
            asm volatile("s_waitcnt vmcnt(0)" ::: "memory");
            const unsigned og = xb_add(&bar[XB_TOP], 1u);
            const unsigned tg = og / nx;
            if (og + 1u == (tg + 1u) * nx) xb_add(&bar[XB_TOPGEN], 1u);
            else XB_SPIN(xb_ld(&bar[XB_TOPGEN]) == tg, bar);
            __builtin_amdgcn_fence(__ATOMIC_ACQUIRE, "agent");
            xb_add(&bar[XB_XGEN(b.x)], 1u);
            asm volatile("s_waitcnt vmcnt(0)" ::: "memory");
        } else {
            XB_SPIN(xb_ld(&bar[XB_XGEN(b.x)]) == gen, bar);
            __builtin_amdgcn_fence(__ATOMIC_ACQUIRE, "agent");
            asm volatile("s_waitcnt vmcnt(0)" ::: "memory");
        }
    }
    __syncthreads();
}

using pg8::Unit;
typedef const f32x4 (&AccT)[2][2][4][2];

struct EpiSwiglu {
    static constexpr bool PERM = false, AFTER_DRAIN = false;
    bf16_t* ACT;
    __device__ __forceinline__ void operator()(AccT acc, const Unit& u, int wr, int wc, int fr, int fq) const {
        int z_ = 0; asm volatile("" : "+s"(z_));
        const int row0 = u.pm * 256 + wr * 64 + fr + z_, f0 = u.pn * 128 + wc * 16 + 4 * fq;
#pragma unroll
        for (int ai = 0; ai < 2; ++ai)
#pragma unroll
            for (int m = 0; m < 4; ++m) { bf16_t* rp = ACT + (size_t)(row0 + ai * 128 + m * 16) * DFF + f0;
#pragma unroll
                for (int bj = 0; bj < 2; ++bj) { const f32x4 g = acc[ai][bj][m][0], x = acc[ai][bj][m][1];
                    u32x2 w; w.x = cvtpk(siluf_(g[0]) * x[0], siluf_(g[1]) * x[1]); w.y = cvtpk(siluf_(g[2]) * x[2], siluf_(g[3]) * x[3]);
                    *(u32x2*)(rp + 64 * bj) = w; } }
    }
};
struct EpiResid {
    static constexpr bool PERM = true, AFTER_DRAIN = false;
    float* H; const float* gate; float gs;
    __device__ __forceinline__ void operator()(AccT acc, const Unit& u, int wr, int wc, int fr, int fq) const {
        int z_ = 0; asm volatile("" : "+s"(z_));
        const int row0 = u.pm * 256 + wr * 64 + fr + z_, col0 = u.pn * 256 + wc * 32 + 8 * fq;
        const float* gp = gate + grp_of_pm(u.pm) * NADA + col0;
        f32x4 gv[2][2];
#pragma unroll
        for (int bj = 0; bj < 2; ++bj) { gv[bj][0] = *(const f32x4*)(gp + bj * 128) * gs; gv[bj][1] = *(const f32x4*)(gp + bj * 128 + 4) * gs; }
#pragma unroll
        for (int ai = 0; ai < 2; ++ai)
#pragma unroll
            for (int m = 0; m < 4; ++m) { float* rp = H + (size_t)(row0 + ai * 128 + m * 16) * DM + col0;
#pragma unroll
                for (int bj = 0; bj < 2; ++bj) {
                    f32x4 h0 = *(const f32x4*)(rp + bj * 128), h1 = *(const f32x4*)(rp + bj * 128 + 4);
                    h0 += gv[bj][0] * acc[ai][bj][m][0]; h1 += gv[bj][1] * acc[ai][bj][m][1];
                    *(f32x4*)(rp + bj * 128) = h0; *(f32x4*)(rp + bj * 128 + 4) = h1; }
                if (m & 1) asm volatile("" ::: "memory"); }
    }
};
struct EpiProj1 {
    static constexpr bool PERM = true, AFTER_DRAIN = false;
    bf16_t* P1; float* SSQ; float* SSKV; float* CKVRAW; float* KRRAW;
    __device__ __forceinline__ void operator()(AccT acc, const Unit& u, int wr, int wc, int fr, int fq) const {
        int z_ = 0; asm volatile("" : "+s"(z_));
        fq += z_; wc += z_;
        const int row0 = u.pm * 256 + wr * 64 + fr + z_, col0 = u.pn * 256 + wc * 32 + 8 * fq;
        if (u.pn >= 2) {
#pragma unroll
            for (int ai = 0; ai < 2; ++ai)
#pragma unroll
                for (int m = 0; m < 4; ++m) { bf16_t* rp = P1 + (size_t)(row0 + ai * 128 + m * 16) * N1 + col0;
#pragma unroll
                    for (int bj = 0; bj < 2; ++bj) { f32x4 a = acc[ai][bj][m][0], b = acc[ai][bj][m][1];
#pragma unroll
                        for (int j = 0; j < 4; ++j) { a[j] = sigmoidf_(a[j]); b[j] = sigmoidf_(b[j]); }
                        *(u32x4*)(rp + bj * 128) = pack8(a, b); } }
        } else {
            const bool isq = (u.pn == 0);
#pragma unroll
            for (int ai = 0; ai < 2; ++ai)
#pragma unroll
                for (int m = 0; m < 4; ++m) { const int row = row0 + ai * 128 + m * 16; bf16_t* rp = P1 + (size_t)row * N1 + col0;
                    const f32x4 a0 = acc[ai][0][m][0], b0 = acc[ai][0][m][1], a1 = acc[ai][1][m][0], b1 = acc[ai][1][m][1];
                    *(u32x4*)(rp) = pack8(a0, b0); *(u32x4*)(rp + 128) = pack8(a1, b1);
                    float s = (a0[0] * a0[0] + a0[1] * a0[1]) + (a0[2] * a0[2] + a0[3] * a0[3]) + (b0[0] * b0[0] + b0[1] * b0[1]) + (b0[2] * b0[2] + b0[3] * b0[3]);
                    if (isq) s += (a1[0] * a1[0] + a1[1] * a1[1]) + (a1[2] * a1[2] + a1[3] * a1[3]) + (b1[0] * b1[0] + b1[1] * b1[1]) + (b1[2] * b1[2] + b1[3] * b1[3]);
                    s += __shfl_xor(s, 16); s += __shfl_xor(s, 32);
                    if (fq == 0) (isq ? SSQ : SSKV)[row * 4 + wc] = s;
                    if (!isq) {
                        if (row < NCTX) { float* cp = CKVRAW + (size_t)row * 128 + wc * 32 + 8 * fq; *(f32x4*)cp = a0; *(f32x4*)(cp + 4) = b0; }
                        if (wc == 0) { float* kp = KRRAW + (size_t)row * 32 + 8 * fq; *(f32x4*)kp = a1; *(f32x4*)(kp + 4) = b1; }
                    }
                    asm volatile("" ::: "memory"); }
        }
    }
};
struct EpiQ {
    static constexpr bool PERM = true, AFTER_DRAIN = false;
    bf16_t* Q; const float* SSQ; const float* rope;
    __device__ __forceinline__ void operator()(AccT acc, const Unit& u, int wr, int wc, int fr, int fq) const {
        int z_ = 0; asm volatile("" : "+s"(z_));
        const int row0 = u.pm * 256 + wr * 64 + fr + z_, col0 = u.pn * 256 + wc * 32 + 8 * fq;
#pragma unroll
        for (int ai = 0; ai < 2; ++ai)
#pragma unroll
            for (int m = 0; m < 4; ++m) { const int row = row0 + ai * 128 + m * 16;
                const f32x4 ss = *(const f32x4*)(SSQ + row * 4); const float rstd = __builtin_amdgcn_rsqf(((ss[0] + ss[1]) + (ss[2] + ss[3])) * (1.0f / 256.0f) + EPSV);
#pragma unroll
                for (int bj = 0; bj < 2; ++bj) { const int c = col0 + bj * 128, within = c % 96;
                    f32x4 a = acc[ai][bj][m][0] * rstd, b = acc[ai][bj][m][1] * rstd;
                    if (within >= 64 && row >= NCTX) { const int pp = within - 64, part = pp >> 4, ib = (pp & 15) >> 1; const int t = (row - NCTX) & 2047, pos = part == 0 ? (t >> 6) : (t & 63);
                        const float* rt = rope + (pos * 8 + ib) * 2; const f32x4 r0 = *(const f32x4*)rt, r1 = *(const f32x4*)(rt + 4);
                        f32x4 a2, b2; a2[0] = a[0] * r0[0] - a[1] * r0[1]; a2[1] = a[1] * r0[0] + a[0] * r0[1]; a2[2] = a[2] * r0[2] - a[3] * r0[3]; a2[3] = a[3] * r0[2] + a[2] * r0[3];
                        b2[0] = b[0] * r1[0] - b[1] * r1[1]; b2[1] = b[1] * r1[0] + b[0] * r1[1]; b2[2] = b[2] * r1[2] - b[3] * r1[3]; b2[3] = b[3] * r1[2] + b[2] * r1[3]; a = a2; b = b2; }
                    *(u32x4*)(Q + (size_t)row * 768 + c) = pack8(a, b); }
                asm volatile("" ::: "memory"); }
    }
};
template <bool CACHED> struct EpiKV {
    static constexpr bool PERM = true, AFTER_DRAIN = false;
    bf16_t* KV; const float* SS;
    __device__ __forceinline__ void operator()(AccT acc, const Unit& u, int wr, int wc, int fr, int fq) const {
        int z_ = 0; asm volatile("" : "+s"(z_));
        const int row0 = u.pm * 256 + wr * 64 + fr + z_, col0 = u.pn * 256 + wc * 32 + 8 * fq;
#pragma unroll
        for (int ai = 0; ai < 2; ++ai)
#pragma unroll
            for (int m = 0; m < 4; ++m) { const int row = row0 + ai * 128 + m * 16; float rstd = 1.0f; int drow;
                if (CACHED) drow = NCTX + (row >> 9) * 2560 + 2048 + (row & 511);
                else { drow = kvrow_of(row); const f32x4 ss = *(const f32x4*)(SS + row * 4); rstd = __builtin_amdgcn_rsqf(((ss[0] + ss[1]) + (ss[2] + ss[3])) * (1.0f / 128.0f) + EPSV); }
#pragma unroll
                for (int bj = 0; bj < 2; ++bj) *(u32x4*)(KV + (size_t)drow * 1024 + col0 + bj * 128) = pack8(acc[ai][bj][m][0] * rstd, acc[ai][bj][m][1] * rstd);
                asm volatile("" ::: "memory"); }
    }
};
struct EpiT {
    static constexpr bool PERM = true, AFTER_DRAIN = false;
    bf16_t* HYT; bf16_t* XCTL; bf16_t* XCTC;
    __device__ __forceinline__ void operator()(AccT acc, const Unit& u, int wr, int wc, int fr, int fq) const {
        int z_ = 0; asm volatile("" : "+s"(z_));
        const int row0 = u.pm * 256 + wr * 64 + fr + z_, tok0 = u.pn * 256 + wc * 32 + 8 * fq;
#pragma unroll
        for (int ai = 0; ai < 2; ++ai)
#pragma unroll
            for (int m = 0; m < 4; ++m) { const int n = row0 + ai * 128 + m * 16;
#pragma unroll
                for (int bj = 0; bj < 2; ++bj) { const int tok = tok0 + bj * 128; bf16_t* dp;
                    if (u.pm < 3) dp = HYT + (size_t)n * MTOK + tok;
                    else { const int isS = u.pm - 3, col = n - 768 - 256 * isS;
                        if (tok < NCTX) dp = XCTC + ((size_t)((tok >> 8) * 256 + col)) * 512 + isS * 256 + (tok & 255);
                        else dp = XCTL + ((size_t)(((tok - NCTX) >> 11) * 256 + col)) * 4096 + isS * 2048 + ((tok - NCTX) & 2047); }
                    *(u32x4*)dp = pack8(acc[ai][bj][m][0], acc[ai][bj][m][1]); } }
    }
};
struct EpiFn {
    static constexpr bool PERM = true, AFTER_DRAIN = false;
    bf16_t* FN; int lat; float scale;
    __device__ __forceinline__ void operator()(AccT acc, const Unit& u, int wr, int wc, int fr, int fq) const {
        int z_ = 0; asm volatile("" : "+s"(z_));
        const int rb = lat ? (NCTX + u.pn * 2048 + u.pm * 256) : (u.pn * 256);
        const int row0 = rb + wr * 64 + fr + z_, col0 = wc * 32 + 8 * fq;
#pragma unroll
        for (int ai = 0; ai < 2; ++ai)
#pragma unroll
            for (int m = 0; m < 4; ++m) { bf16_t* rp = FN + (size_t)(row0 + ai * 128 + m * 16) * 256 + col0;
#pragma unroll
                for (int bj = 0; bj < 2; ++bj) *(u32x4*)(rp + bj * 128) = pack8(acc[ai][bj][m][0] * scale, acc[ai][bj][m][1] * scale); }
    }
};
template <int MODE> struct EpiGate {
    static constexpr bool PERM = true, AFTER_DRAIN = false;
    float* Y; bf16_t* YB; const bf16_t* G; float gsc;
    __device__ __forceinline__ void operator()(AccT acc, const Unit& u, int wr, int wc, int fr, int fq) const {
        int z_ = 0; asm volatile("" : "+s"(z_));
        const int row0 = u.pm * 256 + wr * 64 + fr + z_, col0 = u.pn * 256 + wc * 32 + 8 * fq;
#pragma unroll
        for (int ai = 0; ai < 2; ++ai)
#pragma unroll
            for (int m = 0; m < 4; ++m) { const int row = row0 + ai * 128 + m * 16;
#pragma unroll
                for (int bj = 0; bj < 2; ++bj) { const int c = col0 + bj * 128;
                    const u32x4 gw = *(const u32x4*)(G + (size_t)row * N1 + c);
                    f32x4 g0, g1; g0[0] = bflo(gw.x); g0[1] = bfhi(gw.x); g0[2] = bflo(gw.y); g0[3] = bfhi(gw.y); g1[0] = bflo(gw.z); g1[1] = bfhi(gw.z); g1[2] = bflo(gw.w); g1[3] = bfhi(gw.w);
                    f32x4 a = g0 * acc[ai][bj][m][0] * gsc, b = g1 * acc[ai][bj][m][1] * gsc;
                    float* yp = Y + (size_t)row * DM + c;
                    if (MODE >= 1) { a += *(const f32x4*)yp; b += *(const f32x4*)(yp + 4); }
                    if (MODE <= 1) { *(f32x4*)yp = a; *(f32x4*)(yp + 4) = b; }
                    else *(u32x4*)(YB + (size_t)row * DM + c) = pack8(a, b); }
                asm volatile("" ::: "memory"); }
    }
};

namespace att {
constexpr int KVBLK = 64;
constexpr float SCALE = 0.10206207261596575f;
constexpr float THR = 8.f;
constexpr int SHM_V = KVBLK * 128 * 2, SHM_K = KVBLK * 128 * 2, SHM_ATTN = 2 * SHM_V + 2 * SHM_K + NWAVES * 64 * 4;
#define KSWZ(row, colB) ((row) * 256 + ((colB) ^ (((row) & 7) << 4)))
#define SBAR() __builtin_amdgcn_sched_barrier(0)
__device__ __forceinline__ int crow(int r, int hi) { return (r & 3) + 8 * (r >> 2) + 4 * hi; }
__device__ __forceinline__ void partialSM(f32x16& p0, f32x16& p1, float& m_reg, float& mn, float& alpha) {
  constexpr float C = SCALE * 1.4426950408889634f;
  float pmax = p0[0];
#pragma unroll
  for (int r = 1; r < 16; ++r) pmax = fmaxf(pmax, p0[r]);
#pragma unroll
  for (int r = 0; r < 16; ++r) pmax = fmaxf(pmax, p1[r]);
  { auto rr = __builtin_amdgcn_permlane32_swap(__float_as_uint(pmax), __float_as_uint(pmax), false, false);
    pmax = fmaxf(__uint_as_float(rr[0]), __uint_as_float(rr[1])); }
  if (__builtin_expect(__all(pmax - m_reg <= THR / SCALE), 1)) { mn = m_reg; alpha = 1.f; }
  else { mn = fmaxf(m_reg, pmax); alpha = __builtin_amdgcn_exp2f((m_reg - mn) * C); m_reg = mn; }
  float mnC = -mn * C;
#pragma unroll
  for (int r = 0; r < 16; ++r) p0[r] = fmaf(p0[r], C, mnC);
#pragma unroll
  for (int r = 0; r < 16; ++r) p1[r] = fmaf(p1[r], C, mnC);
#pragma unroll
  for (int r = 0; r < 16; ++r) p0[r] = __builtin_amdgcn_exp2f(p0[r]);
}
__device__ __forceinline__ void finishSM(f32x16& p0, f32x16& p1, float alpha, float& l_reg, bf16x8& pa0, bf16x8& pa1, bf16x8& pa2, bf16x8& pa3) {
#pragma unroll
  for (int r = 0; r < 16; ++r) p1[r] = __builtin_amdgcn_exp2f(p1[r]);
  float ps = 0;
#pragma unroll
  for (int r = 0; r < 16; ++r) ps += p0[r];
#pragma unroll
  for (int r = 0; r < 16; ++r) ps += p1[r];
  { auto rr = __builtin_amdgcn_permlane32_swap(__float_as_uint(ps), __float_as_uint(ps), false, false);
    ps = __uint_as_float(rr[0]) + __uint_as_float(rr[1]); }
  l_reg = l_reg * alpha + ps;
#define PK4(P, BASE, OUT) do { unsigned a0 = cvtpk(P[BASE + 0], P[BASE + 1]), a1 = cvtpk(P[BASE + 2], P[BASE + 3]);   \
    unsigned b0 = cvtpk(P[BASE + 4], P[BASE + 5]), b1 = cvtpk(P[BASE + 6], P[BASE + 7]);                              \
    auto r0 = __builtin_amdgcn_permlane32_swap(a0, b0, false, false); auto r1 = __builtin_amdgcn_permlane32_swap(a1, b1, false, false); \
    u32x4 w = {r0[0], r1[0], r0[1], r1[1]}; OUT = *reinterpret_cast<bf16x8*>(&w); } while (0)
  PK4(p0, 0, pa0); PK4(p0, 8, pa1); PK4(p1, 0, pa2); PK4(p1, 8, pa3);
#undef PK4
}
__device__ __forceinline__ void qkt(f32x16& p0, f32x16& p1, const char* Ks, const bf16x8* qr, int r32, int hi) {
  p0 = f32x16{}; p1 = f32x16{};
#pragma unroll
  for (int d0 = 0; d0 < 6; ++d0) { int cb = (d0 * 16 + hi * 8) * 2;
    bf16x8 b0 = *reinterpret_cast<const bf16x8*>(Ks + KSWZ(r32, cb));
    bf16x8 b1 = *reinterpret_cast<const bf16x8*>(Ks + KSWZ(32 + r32, cb));
    p0 = __builtin_amdgcn_mfma_f32_32x32x16_bf16(b0, qr[d0], p0, 0, 0, 0);
    p1 = __builtin_amdgcn_mfma_f32_32x32x16_bf16(b1, qr[d0], p1, 0, 0, 0); }
}
__device__ __forceinline__ int v_st(int k, int c) { const int kk = (k & ~0xC) | ((k & 4) << 1) | ((k & 8) >> 1); return ((kk >> 3) * 4 + (c >> 5)) * 512 + ((kk & 7) * 32 + (c & 31)) * 2; }
__device__ __forceinline__ int v_rd_base(int lane) { return ((lane & 3) << 3) | (((lane >> 2) & 3) << 6) | (((lane >> 4) & 1) << 5) | (((lane >> 5) & 1) << 8); }
constexpr int v_rd_off(int d0, int ks, int half) { return d0 * 512 + ks * 4096 + half * 2048; }
template <int OFF> __device__ __forceinline__ s16x4 tr_read(int vb) {
  s16x4 r; asm volatile("ds_read_b64_tr_b16 %0, %1 offset:%2" : "=&v"(r) : "v"(vb), "i"(OFF) : "memory"); return r;
}
template <int D0> __device__ __forceinline__ void pv_one(f32x16& od, int vb, bf16x8 pa0, bf16x8 pa1, bf16x8 pa2, bf16x8 pa3) {
  const s16x4 l0 = tr_read<v_rd_off(D0, 0, 0)>(vb), h0 = tr_read<v_rd_off(D0, 0, 1)>(vb), l1 = tr_read<v_rd_off(D0, 1, 0)>(vb), h1 = tr_read<v_rd_off(D0, 1, 1)>(vb);
  const s16x4 l2 = tr_read<v_rd_off(D0, 2, 0)>(vb), h2 = tr_read<v_rd_off(D0, 2, 1)>(vb), l3 = tr_read<v_rd_off(D0, 3, 0)>(vb), h3 = tr_read<v_rd_off(D0, 3, 1)>(vb);
  asm volatile("s_waitcnt lgkmcnt(0)" ::: "memory"); SBAR();
#define PK(L, H) (bf16x8){L[0], L[1], L[2], L[3], H[0], H[1], H[2], H[3]}
  od = __builtin_amdgcn_mfma_f32_32x32x16_bf16(pa0, PK(l0, h0), od, 0, 0, 0);
  od = __builtin_amdgcn_mfma_f32_32x32x16_bf16(pa1, PK(l1, h1), od, 0, 0, 0);
  od = __builtin_amdgcn_mfma_f32_32x32x16_bf16(pa2, PK(l2, h2), od, 0, 0, 0);
  od = __builtin_amdgcn_mfma_f32_32x32x16_bf16(pa3, PK(l3, h3), od, 0, 0, 0);
#undef PK
}
__device__ __forceinline__ void pv_d0(f32x16* o, int vb, bf16x8 pa0, bf16x8 pa1, bf16x8 pa2, bf16x8 pa3) {
  pv_one<0>(o[0], vb, pa0, pa1, pa2, pa3); pv_one<1>(o[1], vb, pa0, pa1, pa2, pa3);
}
__device__ __forceinline__ void attn_unit(const bf16_t* __restrict__ Qb, const bf16_t* __restrict__ KVh, const bf16_t* __restrict__ KRr, bf16_t* __restrict__ Ob, int seq, char* lds) {
  int tid_ = threadIdx.x; asm volatile("" : "+v"(tid_));
  const int tid = tid_, wid = tid >> 6, lane = tid & 63, r32 = lane & 31, hi = lane >> 5;
  char* V_lds = lds; char* K_lds = lds + 2 * SHM_V;
  float* ws = (float*)(lds + 2 * SHM_V + 2 * SHM_K) + wid * 64; float* li_l = ws; float* al_l = ws + 32;
  float m_reg = -1e30f, l_reg = 0; f32x16 o[2] = {}; bf16x8 qr[6];
  const bf16_t* Qw = Qb + (long)(wid * 32 + r32) * 768 + hi * 8;
#pragma unroll
  for (int d0 = 0; d0 < 6; ++d0) qr[d0] = *reinterpret_cast<const bf16x8*>(Qw + d0 * 16);
  const int sr = tid >> 4, sc = (tid & 15) * 8, vst0 = v_st(sr, sc & 63), vst1 = v_st(32 + sr, sc & 63);
  const bool kn = sc < 64, krp = (sc >= 64 && sc < 96);
  const int vb0 = (int)(uintptr_t)V_lds + v_rd_base(lane);
  struct { bf16x8 vs0, vs1, ks0, ks1; } sr_[2];
#define SLOAD(i, k0) do { if (kn) { sr_[i].vs0 = *reinterpret_cast<const bf16x8*>(&KVh[(long)((k0) + sr) * 1024 + 64 + sc]); sr_[i].vs1 = *reinterpret_cast<const bf16x8*>(&KVh[(long)((k0) + 32 + sr) * 1024 + 64 + sc]); \
      sr_[i].ks0 = *reinterpret_cast<const bf16x8*>(&KVh[(long)((k0) + sr) * 1024 + sc]); sr_[i].ks1 = *reinterpret_cast<const bf16x8*>(&KVh[(long)((k0) + 32 + sr) * 1024 + sc]); } \
    else if (krp) { sr_[i].ks0 = *reinterpret_cast<const bf16x8*>(&KRr[(long)((k0) + sr) * 32 + sc - 64]); sr_[i].ks1 = *reinterpret_cast<const bf16x8*>(&KRr[(long)((k0) + 32 + sr) * 32 + sc - 64]); } } while (0)
#define SWRITE(b, i) do { if (kn) { *(bf16x8*)(V_lds + (b) * SHM_V + vst0) = sr_[i].vs0; *(bf16x8*)(V_lds + (b) * SHM_V + vst1) = sr_[i].vs1; } \
    if (kn || krp) { int kc = sc * 2; *(bf16x8*)(K_lds + (b) * SHM_K + KSWZ(sr, kc)) = sr_[i].ks0; *(bf16x8*)(K_lds + (b) * SHM_K + KSWZ(32 + sr, kc)) = sr_[i].ks1; } } while (0)
#define RESC(a) do { if (__any((a) < 1.f)) { if (hi == 0) al_l[r32] = (a); asm volatile("s_waitcnt lgkmcnt(0)" ::: "memory"); \
    _Pragma("unroll") for (int d = 0; d < 2; ++d) _Pragma("unroll") for (int r = 0; r < 16; ++r) o[d][r] *= al_l[crow(r, hi)]; } } while (0)
  f32x16 pA0, pA1, pB0, pB1; float mnA, mnB, alA, alB; bf16x8 pa0, pa1, pa2, pa3; const int NT = seq / KVBLK;
  SLOAD(0, 0); SWRITE(0, 0); __syncthreads();
  qkt(pA0, pA1, K_lds, qr, r32, hi); partialSM(pA0, pA1, m_reg, mnA, alA);
  SLOAD(1, KVBLK); if (2 < NT) SLOAD(0, 2 * KVBLK);
  SWRITE(1, 1); __syncthreads();
  for (int j = 1; j + 1 < NT; j += 2) {
    SBAR(); qkt(pB0, pB1, K_lds + SHM_K, qr, r32, hi);
    finishSM(pA0, pA1, alA, l_reg, pa0, pa1, pa2, pa3); SBAR();
    SLOAD(1, (j + 2) * KVBLK); SBAR();
    pv_d0(o, vb0, pa0, pa1, pa2, pa3); partialSM(pB0, pB1, m_reg, mnB, alB);
    __syncthreads(); SWRITE(0, 0);
    RESC(alB); __syncthreads();
    SBAR(); qkt(pA0, pA1, K_lds, qr, r32, hi);
    finishSM(pB0, pB1, alB, l_reg, pa0, pa1, pa2, pa3); SBAR();
    if (j + 3 < NT) SLOAD(0, (j + 3) * KVBLK); SBAR();
    pv_d0(o, vb0 + SHM_V, pa0, pa1, pa2, pa3); partialSM(pA0, pA1, m_reg, mnA, alA);
    __syncthreads(); SWRITE(1, 1);
    RESC(alA); __syncthreads();
  }
  SBAR(); qkt(pB0, pB1, K_lds + SHM_K, qr, r32, hi);
  finishSM(pA0, pA1, alA, l_reg, pa0, pa1, pa2, pa3); SBAR();
  pv_d0(o, vb0, pa0, pa1, pa2, pa3); partialSM(pB0, pB1, m_reg, mnB, alB);
  __syncthreads(); RESC(alB);
  finishSM(pB0, pB1, alB, l_reg, pa0, pa1, pa2, pa3); SBAR();
  pv_d0(o, vb0 + SHM_V, pa0, pa1, pa2, pa3);
  if (hi == 0) li_l[r32] = l_reg; asm volatile("s_waitcnt lgkmcnt(0)" ::: "memory");
  float rli[16];
#pragma unroll
  for (int r = 0; r < 16; ++r) rli[r] = __builtin_amdgcn_rcpf(li_l[crow(r, hi)]);
  bf16_t* Ow = Ob + (long)(wid * 32) * 512;
#pragma unroll
  for (int r = 0; r < 16; ++r) { int orow = crow(r, hi);
#pragma unroll
    for (int d0 = 0; d0 < 2; ++d0) Ow[(long)orow * 512 + d0 * 32 + r32] = (bf16_t)f2bf(o[d0][r] * rli[r]); }
  __syncthreads();
#undef SLOAD
#undef SWRITE
#undef RESC
}
#undef KSWZ
#undef SBAR
}

struct Args { const float* in[29]; float* out; unsigned char* ws; int ph_lo, ph_hi, use_bar, pad; };
enum { I_XP = 0, I_XS, I_CCKV, I_CKR, I_C, I_CCTX, I_WADA, I_BADA, I_NORMG, I_WUP, I_WDN, I_WIN, I_HCW, I_HCB, I_FW1, I_FB1, I_FW2, I_FB2, I_FW3, I_SKIP,
       I_WHY, I_QNG, I_WQB, I_KVNG, I_WKVB, I_WMLA, I_WFN, I_WOUT, I_FING };

struct Frame {
    LAS unsigned char* lds; char* ldsg;
    int G, bid;
    unsigned char* ws;
};
#define WSP(T, off) ((T*)(F.ws + (off)))
#define TLW() int tid_ = threadIdx.x; asm volatile("" : "+v"(tid_)); const int tid = tid_, lane = tid & 63, wave = __builtin_amdgcn_readfirstlane(tid >> 6); (void)lane; (void)wave
__device__ __forceinline__ const float* argin(int i) { size_t off = (size_t)i * 8; asm volatile("" : "+s"(off)); const __attribute__((address_space(4))) char* k = (const __attribute__((address_space(4))) char*)__builtin_amdgcn_kernarg_segment_ptr(); return (const float*)(*(const GAS float* const __attribute__((address_space(4)))*)(k + off)); }
#define AIN(i) argin(i)

enum { CK_ID = 0, CK_UP, CK_IN, CK_QB };
__device__ __forceinline__ bf16_t* conv_dst(int kind, bf16_t* d0, bf16_t* d1, int ldd, int n) {
    if (kind == CK_ID) return d0 + (size_t)n * ldd;
    if (kind == CK_UP) { const int isU = n >= DFF, f = n - DFF * isU; const int R = (f >> 7) * 256 + ((f >> 6) & 1) * 128 + ((f >> 4) & 3) * 32 + 16 * isU + (f & 15); return d0 + (size_t)R * ldd; }
    if (kind == CK_IN) {
        if (n < 768) return d1 + (size_t)n * ldd;
        if (n < 1024) return d0 + (size_t)(n - 768) * ldd;
        if (n < 1152) return d0 + (size_t)(256 + n - 1024) * ldd;
        if (n < 1184) { const int p = n - 1152, part = p >> 4, w = p & 15, half = w >> 3, i = w & 7; return d0 + (size_t)(384 + part * 16 + 2 * i + half) * ldd; }
        if (n < 1440) return nullptr;
        return d0 + (size_t)(512 + n - 1440) * ldd;
    }
    { const int h = n / 96, w96 = n - h * 96; int d = w96;
      if (w96 >= 64) { const int p = w96 - 64, part = p >> 4, w = p & 15, half = w >> 3, i = w & 7; d = 64 + part * 16 + 2 * i + half; }
      return d0 + (size_t)(h * 96 + d) * ldd; }
}
__device__ __forceinline__ void conv_item(const float* W, int ldw, int ncols, int k0, int n0, int kind, bf16_t* d0, bf16_t* d1, int ldd, const float* kscale, bf16_t* dextra, LAS float* scr, int lane) {
    const int lr = lane >> 4, lc = (lane & 15) * 4;
    const bool cok = (n0 + lc) < ncols;
    f32x4 v[16];
#pragma unroll
    for (int i = 0; i < 16; ++i) v[i] = cok ? *(const f32x4*)(W + (size_t)(k0 + i * 4 + lr) * ldw + n0 + lc) : (f32x4){0.f, 0.f, 0.f, 0.f};
#pragma unroll
    for (int i = 0; i < 16; ++i) *(LAS f32x4*)(scr + (i * 4 + lr) * 68 + lc) = v[i];
    asm volatile("s_waitcnt lgkmcnt(0)" ::: "memory");
    const int n = n0 + lane;
    bf16_t* dp = (n < ncols) ? conv_dst(kind, d0, d1, ldd, n) : nullptr;
#pragma unroll
    for (int c = 0; c < 8; ++c) {
        float x[8];
#pragma unroll
        for (int e2 = 0; e2 < 8; ++e2) x[e2] = scr[(8 * c + e2) * 68 + lane];
        if (dp) {
            if (dextra) { u32x4 r; r.x = cvtpk(x[0], x[1]); r.y = cvtpk(x[2], x[3]); r.z = cvtpk(x[4], x[5]); r.w = cvtpk(x[6], x[7]); *(u32x4*)(dextra + (size_t)n * ldd + k0 + 8 * c) = r; }
            if (kscale) {
#pragma unroll
                for (int e2 = 0; e2 < 8; ++e2) x[e2] *= kscale[k0 + 8 * c + e2]; }
            u32x4 o; o.x = cvtpk(x[0], x[1]); o.y = cvtpk(x[2], x[3]); o.z = cvtpk(x[4], x[5]); o.w = cvtpk(x[6], x[7]);
            *(u32x4*)(dp + k0 + 8 * c) = o; }
    }
    asm volatile("s_waitcnt lgkmcnt(0)" ::: "memory");
}

__device__ __forceinline__ void p0_phase(Frame& F, const Args& A) {
    TLW();
    LAS float* scr = (LAS float*)(F.lds + wave * 17408);
    const int gw = F.bid * NWAVES + wave, NGW = F.G * NWAVES;
    const int gt = F.bid * NTHR + tid, NGT = F.G * NTHR;
    {
        constexpr int I_UP = 16 * 88, I_DN = 44 * 16, I_IN = 16 * 71, I_QB = 4 * 12, I_KVB = 2 * 16, I_HY = 4 * 16, I_MLA = 8 * 16, I_FN = 4 * 16, I_OUT = 16 * 16;
        constexpr int PER_L = 2 * I_UP + 2 * I_DN + I_IN + I_QB + I_KVB + I_HY + I_MLA + I_FN + I_OUT;
        for (int it = gw; it < 2 * PER_L; it += NGW) {
            const int l = it / PER_L; int r = it - l * PER_L;
            if (r < 2 * I_UP) { const int f = r / I_UP; r -= f * I_UP; const int nb = 88, kb = r / nb, n_ = r % nb;
                conv_item(AIN(I_WUP) + (size_t)(l * 2 + f) * DM * NUP, NUP, NUP, kb * 64, n_ * 64, CK_UP, WSP(bf16_t, WS_WUP) + (size_t)(l * 2 + f) * NUP * DM, nullptr, DM, nullptr, nullptr, scr, lane); continue; }
            r -= 2 * I_UP;
            if (r < 2 * I_DN) { const int f = r / I_DN; r -= f * I_DN; const int nb = 16, kb = r / nb, n_ = r % nb;
                conv_item(AIN(I_WDN) + (size_t)(l * 2 + f) * DFF * DM, DM, DM, kb * 64, n_ * 64, CK_ID, WSP(bf16_t, WS_WDN) + (size_t)(l * 2 + f) * DM * DFF, nullptr, DFF, nullptr, nullptr, scr, lane); continue; }
            r -= 2 * I_DN;
            if (r < I_IN) { const int nb = 71, kb = r / nb, n_ = r % nb;
                conv_item(AIN(I_WIN) + (size_t)l * DM * INC, INC, INC, kb * 64, n_ * 64, CK_IN, WSP(bf16_t, WS_W1T) + (size_t)l * N1 * DM, WSP(bf16_t, WS_W2T) + (size_t)l * N2 * DM, DM, nullptr, nullptr, scr, lane); continue; }
            r -= I_IN;
            if (r < I_QB) { const int nb = 12, kb = r / nb, n_ = r % nb;
                conv_item(AIN(I_WQB) + (size_t)l * 256 * 768, 768, 768, kb * 64, n_ * 64, CK_QB, WSP(bf16_t, WS_WQB) + (size_t)l * 768 * 256, nullptr, 256, AIN(I_QNG) + l * 256, nullptr, scr, lane); continue; }
            r -= I_QB;
            if (r < I_KVB) { const int nb = 16, kb = r / nb, n_ = r % nb;
                conv_item(AIN(I_WKVB) + (size_t)l * 128 * 1024, 1024, 1024, kb * 64, n_ * 64, CK_ID, WSP(bf16_t, WS_WKVB) + (size_t)l * 1024 * 256, nullptr, 256, AIN(I_KVNG) + l * 128, WSP(bf16_t, WS_WKVR) + (size_t)l * 1024 * 256, scr, lane); continue; }
            r -= I_KVB;
            if (r < I_HY) { const int nb = 16, kb = r / nb, n_ = r % nb;
                conv_item(AIN(I_WHY) + (size_t)l * 256 * 1024, 1024, 1024, kb * 64, n_ * 64, CK_ID, WSP(bf16_t, WS_WHY) + (size_t)l * 1024 * 256, nullptr, 256, nullptr, nullptr, scr, lane); continue; }
            r -= I_HY;
            if (r < I_MLA) { const int nb = 16, kb = r / nb, n_ = r % nb;
                conv_item(AIN(I_WMLA) + (size_t)l * 512 * 1024, 1024, 1024, kb * 64, n_ * 64, CK_ID, WSP(bf16_t, WS_WMLA) + (size_t)l * 1024 * 512, nullptr, 512, nullptr, nullptr, scr, lane); continue; }
            r -= I_MLA;
            if (r < I_FN) { const int nb = 16, kb = r / nb, n_ = r % nb;
                conv_item(AIN(I_WFN) + (size_t)l * 256 * 1024, 1024, 1024, kb * 64, n_ * 64, CK_ID, WSP(bf16_t, WS_WFN) + (size_t)l * 1024 * 256, nullptr, 256, nullptr, nullptr, scr, lane); continue; }
            r -= I_FN;
            { const int nb = 16, kb = r / nb, n_ = r % nb;
                conv_item(AIN(I_WOUT) + (size_t)l * 1024 * 1024, 1024, 1024, kb * 64, n_ * 64, CK_ID, WSP(bf16_t, WS_WOUT) + (size_t)l * 1024 * 1024, nullptr, 1024, nullptr, nullptr, scr, lane); }
        }
    }
    __syncthreads();
    LAS float* scv = (LAS float*)(F.lds);
    LAS float* ctab = (LAS float*)(F.lds + 16384);
    for (int i = tid; i < 3 * DM; i += NTHR) { const int g = i >> 10, k = i & 1023; const float c = (g == 0) ? AIN(I_CCTX)[k] : AIN(I_C)[(g - 1) * DM + k]; scv[i] = siluf_(c); }
    for (int i = tid; i < 2048; i += NTHR) ctab[i] = cospif((float)i * (1.0f / 1024.0f));
    __syncthreads();
    for (int it = gw; it < 2 * 4 * 16 * 4; it += NGW) {
        const int mq = it & 3, kc = (it >> 2) & 15, g = (it >> 6) & 3, l = it >> 8; const int k = kc * 64 + lane;
        const float* src = AIN(I_WIN) + (size_t)l * DM * INC + (size_t)k * INC + 1184 + g * 64;
        float x[64];
#pragma unroll
        for (int j = 0; j < 16; ++j) { const f32x4 v = *(const f32x4*)(src + 4 * j); x[4 * j] = v[0]; x[4 * j + 1] = v[1]; x[4 * j + 2] = v[2]; x[4 * j + 3] = v[3]; }
        bf16_t* dst = WSP(bf16_t, WS_W2T) + (size_t)l * N2 * DM;
        for (int mm = 0; mm < 16; ++mm) { const int m = mq * 16 + mm; float sc_ = 0.f, ss_ = 0.f;
#pragma unroll
            for (int j = 0; j < 64; ++j) { const int ph = (j * m) & 63; sc_ += x[j] * ctab[ph * 32]; ss_ += x[j] * ctab[((ph + 48) & 63) * 32]; }
            dst[(size_t)(768 + g * 64 + m) * DM + k] = (bf16_t)f2bf(sc_); dst[(size_t)(1024 + g * 64 + m) * DM + k] = (bf16_t)f2bf(ss_); }
    }
    for (int it = gw; it < 2 * 16 * 36; it += NGW) {
        const int cc = it % 36, kc = (it / 36) & 15, l = it / (36 * 16);
        const float* wp = AIN(I_WADA) + (size_t)l * DM * NADA + (size_t)(kc * 64) * NADA + cc * 256 + lane * 4;
        f32x4 a0 = {0, 0, 0, 0}, a1 = a0, a2 = a0;
#pragma unroll 8
        for (int k = 0; k < 64; ++k) { const f32x4 w = *(const f32x4*)(wp + (size_t)k * NADA); const int kk = kc * 64 + k; a0 += w * scv[kk]; a1 += w * scv[1024 + kk]; a2 += w * scv[2048 + kk]; }
        float* op = WSP(float, WS_ADAP) + ((size_t)(kc * 2 + l) * 3) * NADA + cc * 256 + lane * 4;
        *(f32x4*)op = a0; *(f32x4*)(op + NADA) = a1; *(f32x4*)(op + 2 * NADA) = a2;
    }
    for (int it = gw; it < 2 * 288; it += NGW) {
        const int l = it / 288, r0 = (it % 288) * 8;
        const float* W1 = AIN(I_FW1) + l * 17 * 64; const float* W2 = AIN(I_FW2) + l * 64 * 64;
        float w1c[17], w2c[64];
#pragma unroll
        for (int i = 0; i < 17; ++i) w1c[i] = W1[i * 64 + lane];
#pragma unroll
        for (int k = 0; k < 64; ++k) w2c[k] = W2[k * 64 + lane];
        const float b1 = AIN(I_FB1)[l * 64 + lane], b2 = AIN(I_FB2)[l * 64 + lane];
        for (int rr = 0; rr < 8; ++rr) { const int row = r0 + rr; const int L = row < 256 ? 256 : 2048, t = row < 256 ? row : row - 256;
            float feat = 0.f;
            { const float tn = (float)t / (float)(L - 1), w = 6.283185307179586f * (float)t / (float)L;
              const int bi = (lane >= 9) ? lane - 9 : lane - 1; const float band = 1e-4f + (float)bi * ((7.0f - 1e-4f) / 7.0f); const float ang = w * band;
              feat = (lane == 0) ? tn : ((lane <= 8) ? cosf(ang) : -sinf(ang)); }
            float h1 = b1;
#pragma unroll
            for (int i = 0; i < 17; ++i) h1 += __builtin_bit_cast(float, __builtin_amdgcn_readlane(__builtin_bit_cast(int, feat), i)) * w1c[i];
            h1 = sinf(h1);
            float h2 = b2;
#pragma unroll
            for (int k = 0; k < 64; ++k) h2 += __builtin_bit_cast(float, __builtin_amdgcn_readlane(__builtin_bit_cast(int, h1), k)) * w2c[k];
            h2 = sinf(h2);
            WSP(float, WS_H2)[((size_t)l * 2304 + row) * 64 + lane] = h2; }
    }
    if (F.bid == 0) { const int pos = tid >> 3, i = tid & 7; const float inv = exp2f(-(float)i * (13.287712379549449f / 8.0f)); float s, c; sincosf((float)pos * inv, &s, &c);
        WSP(float, WS_ROPE)[(pos * 8 + i) * 2] = c; WSP(float, WS_ROPE)[(pos * 8 + i) * 2 + 1] = s; }
    for (int it = gt; it < 2048 * 512 + 256 * 64; it += NGT) {
        const bool isl = it < 2048 * 512; const int L = isl ? 2048 : 256, j = isl ? it : it - 2048 * 512, per = 2 * L / 8, k = j / per, t8 = (j % per) * 8, sh = isl ? 0 : 3;
        float v[8];
#pragma unroll
        for (int e = 0; e < 8; ++e) { const int tt = t8 + e, isS = tt >= L, t = tt - isS * L; const int ph = (k * t) & (L - 1);
            v[e] = isS ? -ctab[(((ph - L / 4) & (L - 1)) << sh)] : ctab[ph << sh]; }
        u32x4 o; o.x = pk2(v[0], v[1]); o.y = pk2(v[2], v[3]); o.z = pk2(v[4], v[5]); o.w = pk2(v[6], v[7]);
        *(u32x4*)((isl ? WSP(bf16_t, WS_DFTL) : WSP(bf16_t, WS_DFTC)) + (size_t)k * 2 * L + t8) = o;
    }
    for (int it = gt; it < 2 * 1024 * 32; it += NGT) { const int c8 = (it & 31) * 8, row = (it >> 5) & 1023, l = it >> 15; const int b = row >> 9, j = row & 511;
        u32x4 o = {0, 0, 0, 0};
        if (c8 < 128) { const float* sp = AIN(I_CCKV) + ((size_t)((b * 2 + l) * 512 + j)) * 128 + c8; const f32x4 x = *(const f32x4*)sp, y = *(const f32x4*)(sp + 4);
            o.x = pk2(x[0], x[1]); o.y = pk2(x[2], x[3]); o.z = pk2(y[0], y[1]); o.w = pk2(y[2], y[3]); }
        *(u32x4*)(WSP(bf16_t, WS_CKVB) + ((size_t)l * 1024 + row) * 256 + c8) = o; }
    for (int it = gt; it < 2 * 96 * 128; it += NGT) { const int c8 = (it & 127) * 8, r = (it >> 7) % 96, l = it / (96 * 128);
        *(u32x4*)(WSP(bf16_t, WS_W1T) + ((size_t)l * N1 + 416 + r) * DM + c8) = (u32x4){0, 0, 0, 0}; }
    for (int it = gt; it < 2 * 2 * 1024 * 16; it += NGT) { const int c8 = 128 + (it & 15) * 8, r = (it >> 4) & 1023, l = (it >> 14) & 1, wsel = it >> 15;
        *(u32x4*)((wsel ? WSP(bf16_t, WS_WKVR) : WSP(bf16_t, WS_WKVB)) + ((size_t)l * 1024 + r) * 256 + c8) = (u32x4){0, 0, 0, 0}; }
    __syncthreads();
}

__device__ __forceinline__ void norm_phase(Frame& F, const Args& A, int l, int which, bool first, bool from_partials) {
    TLW();
    LAS float* gm = (LAS float*)(F.lds);
    LAS float* sv = (LAS float*)(F.lds + 12288);
    for (int i = tid; i < 3 * DM; i += NTHR) { const int g = i >> 10, c = i & 1023; float s, sc;
        if (from_partials) { s = AIN(I_BADA)[l * NADA + (3 * which) * DM + c]; sc = AIN(I_BADA)[l * NADA + (3 * which + 1) * DM + c];
            for (int kc = 0; kc < 16; ++kc) { const float* pp = WSP(float, WS_ADAP) + ((size_t)(kc * 2 + l) * 3 + g) * NADA; s += pp[(3 * which) * DM + c]; sc += pp[(3 * which + 1) * DM + c]; } }
        else { const float* ad = WSP(float, WS_ADA) + ((size_t)l * 3 + g) * NADA; s = ad[(3 * which) * DM + c]; sc = ad[(3 * which + 1) * DM + c]; }
        gm[i] = AIN(I_NORMG)[(l * 3 + which) * DM + c] * (1.0f + sc); sv[i] = s; }
    __syncthreads();
    const int gw = F.bid * NWAVES + wave, NGW = F.G * NWAVES;
    for (int r = gw; r < MTOK; r += NGW) {
        const float* src = first ? (r < NCTX ? AIN(I_XP) + (size_t)r * DM : AIN(I_XS) + (size_t)(r - NCTX) * DM) : WSP(float, WS_H) + (size_t)r * DM;
        const int g = r < NCTX ? 0 : 1 + ((r - NCTX) >> 11);
        f32x4 v[4]; float s = 0.f;
#pragma unroll
        for (int j = 0; j < 4; ++j) { v[j] = *(const f32x4*)(src + 4 * lane + 256 * j); s += (v[j][0] * v[j][0] + v[j][1] * v[j][1]) + (v[j][2] * v[j][2] + v[j][3] * v[j][3]); }
        const float rstd = 1.0f / sqrtf(wave_sum(s) * (1.0f / DM) + EPSV);
        bf16_t* np = WSP(bf16_t, WS_N) + (size_t)r * DM;
#pragma unroll
        for (int j = 0; j < 4; ++j) { const int c = 4 * lane + 256 * j; const f32x4 gg = *(const LAS f32x4*)(gm + g * DM + c), ss = *(const LAS f32x4*)(sv + g * DM + c);
            const f32x4 y = v[j] * rstd * gg + ss; u32x2 w; w.x = cvtpk(y[0], y[1]); w.y = cvtpk(y[2], y[3]); *(u32x2*)(np + c) = w;
            if (first) *(f32x4*)(WSP(float, WS_H) + (size_t)r * DM + c) = v[j]; }
    }
    __syncthreads();
}
__device__ __forceinline__ void final_norm_phase(Frame& F, const Args& A) {
    TLW();
    const int gw = F.bid * NWAVES + wave, NGW = F.G * NWAVES;
    for (int r = gw; r < MTOK; r += NGW) {
        const float* src = WSP(float, WS_H) + (size_t)r * DM;
        f32x4 v[4]; float s = 0.f;
#pragma unroll
        for (int j = 0; j < 4; ++j) { v[j] = *(const f32x4*)(src + 4 * lane + 256 * j); s += (v[j][0] * v[j][0] + v[j][1] * v[j][1]) + (v[j][2] * v[j][2] + v[j][3] * v[j][3]); }
        const float rstd = 1.0f / sqrtf(wave_sum(s) * (1.0f / DM) + EPSV);
#pragma unroll
        for (int j = 0; j < 4; ++j) { const int c = 4 * lane + 256 * j; const f32x4 gg = *(const f32x4*)(AIN(I_FING) + c); *(f32x4*)(A.out + (size_t)r * DM + c) = v[j] * rstd * gg; }
    }
}

__device__ __forceinline__ void p0b_phase(Frame& F, const Args& A) {
    TLW();
    const int gt = F.bid * NTHR + tid, NGT = F.G * NTHR, gw = F.bid * NWAVES + wave, NGW = F.G * NWAVES;
    for (int it = gt; it < 2 * 3 * NADA; it += NGT) { const int c = it % NADA, g = (it / NADA) % 3, l = it / (3 * NADA); float s = AIN(I_BADA)[l * NADA + c];
        for (int kc = 0; kc < 16; ++kc) s += WSP(float, WS_ADAP)[((size_t)(kc * 2 + l) * 3 + g) * NADA + c];
        WSP(float, WS_ADA)[((size_t)l * 3 + g) * NADA + c] = s; }
    LAS float* tl = (LAS float*)(F.lds + wave * 16384);
    for (int it = gw; it < 2 * 36 * 16; it += NGW) {
        const int cc = it & 15, rc = (it >> 4) % 36, l = it / (36 * 16); const int L = rc < 4 ? 256 : 2048, t0 = rc < 4 ? rc * 64 : rc * 64 - 256;
        const float* W3 = AIN(I_FW3) + (size_t)l * 64 * 1024 + cc * 64 + lane;
        float w[64];
#pragma unroll
        for (int k = 0; k < 64; ++k) w[k] = W3[k * 1024];
        const float* hp = WSP(float, WS_H2) + ((size_t)l * 2304 + rc * 64) * 64;
#pragma unroll 2
        for (int tt = 0; tt < 64; ++tt) { float s = 0.f;
#pragma unroll
            for (int k = 0; k < 64; ++k) s += hp[tt * 64 + k] * w[k];
            tl[tt * 64 + (lane ^ tt)] = s; }
        asm volatile("s_waitcnt lgkmcnt(0)" ::: "memory");
        const int t = t0 + lane; const float tn = (float)t / (float)(L - 1);
        float* fb = WSP(float, WS_FILT) + (size_t)l * FILT_LAYER + (rc < 4 ? (size_t)512 * 4096 : 0);
        for (int ci = 0; ci < 64; ++ci) { const int col = cc * 64 + ci, ch = col & 255, oc = col & 511, dir = col >> 9;
            const float delta = -3.0701134573253944f + (float)ch * ((-15.350567286626972f + 3.0701134573253944f) / 255.0f);
            const float s = tl[lane * 64 + (ci ^ lane)] * expf(-tn * fabsf(delta));
            float* fr = fb + (size_t)oc * (2 * L);
            if (dir == 0) fr[L + t] = s; else if (t > 0) fr[L - t] = s; else fr[0] = 0.f; }
        asm volatile("s_waitcnt lgkmcnt(0)" ::: "memory");
    }
}

constexpr int HY_HC = 0, HY_HV = 65536, HY_HZ = HY_HV + 16320, HY_X1 = HY_HZ + 16320, HY_X2 = HY_X1 + 8192, HY_ST = HY_X2 + 8192, HY_END = HY_ST + 32768;
static_assert(HY_END <= MISC_OFF, "hyena LDS map");
__device__ __forceinline__ void hyena_unit(Frame& F, const Args& A, int l, int unit) {
    TLW();
    const bool lat = unit < 64; const int c0 = (lat ? unit : unit - 64) * 4;
    const int L = lat ? 2048 : 256, tokbase = lat ? NCTX : 0, NQ = lat ? 512 : 64;
    LAS unsigned char* lds = F.lds;
    const bf16_t* hyt = WSP(bf16_t, WS_HYT);
    for (int i = tid; i < (2 * 16320) / 16; i += NTHR) *(LAS u32x4*)(lds + HY_HV + i * 16) = (u32x4){0, 0, 0, 0};
    __syncthreads();
    const int rho = wave, rp = lane & 15, g4 = lane >> 4;
    LAS unsigned char* HCw = lds + HY_HC + wave * 8192;
#pragma unroll 1
    for (int ci = 0; ci < 4; ++ci) {
        const int c = c0 + ci;
#pragma unroll 1
        for (int which = 0; which < 3; ++which) {
            const int ch = (which == 0 ? 512 : (which == 1 ? 0 : 256)) + c, idx = tid * 8, pos = idx & (L - 1), b = idx / L;
            const bf16_t* hp = hyt + (size_t)ch * MTOK + tokbase + idx;
            const u32x4 raw = *(const u32x4*)hp;
            const float xm = pos > 0 ? bf2f(hp[-1]) : 0.f, xp = (pos + 8 < L) ? bf2f(hp[8]) : 0.f;
            const float* cw = AIN(I_HCW) + (size_t)l * 3 * 768 + ch; const float w0 = cw[0], w1 = cw[768], w2 = cw[1536], bb = AIN(I_HCB)[l * 768 + ch];
            float x[10]; x[0] = xm; x[1] = bflo(raw.x); x[2] = bfhi(raw.x); x[3] = bflo(raw.y); x[4] = bfhi(raw.y); x[5] = bflo(raw.z); x[6] = bfhi(raw.z); x[7] = bflo(raw.w); x[8] = bfhi(raw.w); x[9] = xp;
            float u[8];
#pragma unroll
            for (int e = 0; e < 8; ++e) u[e] = x[e] * w0 + x[e + 1] * w1 + x[e + 2] * w2 + bb;
            u32x4 o; o.x = cvtpk(u[0], u[1]); o.y = cvtpk(u[2], u[3]); o.z = cvtpk(u[4], u[5]); o.w = cvtpk(u[6], u[7]);
            if (which == 0) { const int J = pos >> 7, slot = lat ? b * 30 + 7 + J : b * 2 + J; *(LAS u32x4*)(lds + HY_HV + slot * 272 + (pos & 127) * 2) = o; }
            else *(LAS u32x4*)(lds + (which == 1 ? HY_X1 : HY_X2) + idx * 2) = o;
        }
#pragma unroll 1
        for (int ord = 0; ord < 2; ++ord) {
            const float* fb = WSP(float, WS_FILT) + (size_t)l * FILT_LAYER + (lat ? 0 : (size_t)512 * 4096) + (size_t)(ord * 256 + c) * (2 * L);
            float asum = 0.f;
            for (int qi = lane; qi < NQ; qi += 64) { const int q = qi - NQ / 2; float tp[8];
#pragma unroll
                for (int j = 0; j < 8; ++j) { const int ti = 8 * q + rho - j + L; tp[j] = (ti >= 0 && ti < 2 * L) ? fb[ti] : 0.f; asum += fabsf(tp[j]); }
                u32x4 o; o.x = cvtpk(tp[0], tp[1]); o.y = cvtpk(tp[2], tp[3]); o.z = cvtpk(tp[4], tp[5]); o.w = cvtpk(tp[6], tp[7]);
                *(LAS u32x4*)(HCw + qi * 16) = o; }
            const float inv = 1.0f / (wave_sum(asum) + EPSV);
            __syncthreads();
            const LAS unsigned char* Ub = lds + (ord == 0 ? HY_HV : HY_HZ) + 16 * g4;
            const int slot0 = lat ? (rp & 1) * 30 + 7 + (rp >> 1) : rp * 2, slot1 = lat ? slot0 + 8 : slot0 + 1;
            const int dmin = lat ? -15 : -1, dmax = lat ? 15 : 1, hi0 = lat ? 7 : 0, lo1 = lat ? -7 : 0;
            f32x4 acc0 = {0.f, 0.f, 0.f, 0.f}, acc1 = {0.f, 0.f, 0.f, 0.f};
            const LAS unsigned char* ap = HCw + (NQ / 2 + rp - g4 + 16 * dmin) * 16;
            const LAS unsigned char* bp0 = Ub + (slot0 - dmin) * 272; const LAS unsigned char* bp1 = Ub + (slot1 - dmin) * 272;
#pragma unroll 1
            for (int d = dmin; d <= dmax; ++d, ap += 256, bp0 -= 272, bp1 -= 272) {
                const bool u0 = d <= hi0, u1 = d >= lo1;
#pragma unroll
                for (int s = 0; s < 4; ++s) {
                    const bf16x8 af = *(const LAS bf16x8*)(ap - 64 * s);
                    if (u0) { const bf16x8 bf = *(const LAS bf16x8*)(bp0 + 64 * s); acc0 = __builtin_amdgcn_mfma_f32_16x16x32_bf16(af, bf, acc0, 0, 0, 0); }
                    if (u1) { const bf16x8 bf = *(const LAS bf16x8*)(bp1 + 64 * s); acc1 = __builtin_amdgcn_mfma_f32_16x16x32_bf16(af, bf, acc1, 0, 0, 0); }
                }
            }
            const float sk = AIN(I_SKIP)[(l * 2 + ord) * 256 + c];
#pragma unroll
            for (int t = 0; t < 2; ++t)
#pragma unroll
                for (int reg = 0; reg < 4; ++reg) {
                    const int a = 32 * g4 + 8 * reg + rho;
                    const int I = lat ? 8 * t + (rp >> 1) : t, b = lat ? (rp & 1) : rp;
                    const int idx = lat ? b * 2048 + 128 * I + a : b * 256 + 128 * I + a, slot = lat ? b * 30 + 7 + I : b * 2 + I;
                    const int la = slot * 272 + a * 2;
                    const float y = (t == 0 ? acc0[reg] : acc1[reg]) * inv;
                    if (ord == 0) { const float v = bf2f(*(const LAS bf16_t*)(lds + HY_HV + la)), x = bf2f(*(const LAS bf16_t*)(lds + HY_X1 + idx * 2));
                        *(LAS bf16_t*)(lds + HY_HZ + la) = (bf16_t)f2bf(x * (y + sk * v)); }
                    else { const float v = bf2f(*(const LAS bf16_t*)(lds + HY_HZ + la)), x = bf2f(*(const LAS bf16_t*)(lds + HY_X2 + idx * 2));
                        *(LAS bf16_t*)(lds + HY_ST + (idx * 4 + ci) * 2) = (bf16_t)f2bf(x * (y + sk * v)); }
                }
            __syncthreads();
        }
    }
    for (int i = tid; i < 4096; i += NTHR) *(u32x2*)(WSP(bf16_t, WS_Z) + (size_t)(tokbase + i) * 256 + c0) = *(const LAS u32x2*)(lds + HY_ST + i * 8);
    __syncthreads();
}

constexpr int ST_PER_LAYER = 21, N_STEPS = 3 + 2 * ST_PER_LAYER;
#ifndef MK_ONE_LAUNCH
#define MK_ONE_LAUNCH 1
#endif
#ifndef PHSEL
#define PHSEL -1
#endif
#define PSEL(k) (PHSEL < 0 || PHSEL == (k))
#ifndef PROBE_REP
#define PROBE_REP 0
#endif
__host__ __device__ constexpr bool bar_after(int st) {
    if (st < 3) return st != 1;
    const int s = (st - 3) % ST_PER_LAYER;
    return !(s == 3 || s == 5 || s == 6 || s == 7 || s == 9 || s == 10 || s == 11 || s == 13 || s == 14);
}

template <class Epi> __device__ __forceinline__ void run_gemm(Frame& F, const bf16_t* Ap, int lda, const bf16_t* Bp, int ldb, int M, int N, int K, int cshift, const Epi& E) {
    pg8::Gemm g{Ap, Bp, M, N, K, lda, ldb}; pg8::StaticOrder S; S.init(M, N, F.G, (F.bid + F.G - cshift) % F.G);
    pg8::gemm_phase<Epi, pg8::StaticOrder, true, true>(F.lds, g, S, E);
}

__global__ void __launch_bounds__(NTHR, 2) mk_fwd(Args args) {
    extern __shared__ __attribute__((aligned(16))) unsigned char lds[];
    Frame F;
    F.lds = (LAS unsigned char*)lds; F.ldsg = (char*)lds;
    F.G = gridDim.x; F.bid = blockIdx.x;
    volatile LAS unsigned* MISC = (volatile LAS unsigned*)(F.lds + MISC_OFF);
    if (threadIdx.x < 64) ((LAS unsigned*)(F.lds + MISC_OFF))[threadIdx.x] = 0u;
    __syncthreads();
    const int lo = args.ph_lo, hi = args.ph_hi;
    XcdBarrier bar; bar.bar = (unsigned*)(args.ws + WS_CTL) + CW_BAR; bar.x = 0; bar.st = nullptr;
    if (args.use_bar) bar = xcd_barrier_post((unsigned*)(args.ws + WS_CTL) + CW_BAR, MISC + 8);
    const Args& A = args;

#pragma unroll 1
    for (int st = lo; st < hi; ++st) {
        { size_t z_ = 0; asm volatile("" : "+s"(z_)); F.ws = args.ws + z_; }
        int nrep = 1;
        if (PROBE_REP) { const int s_ = st < 3 ? -1 : (st - 3) % ST_PER_LAYER;
            if ((PROBE_REP & 1) && (s_ == 0 || s_ == 18)) nrep = 2;
            if ((PROBE_REP & 2) && (s_ == 1 || s_ == 19)) nrep = 2;
            if ((PROBE_REP & 4) && (s_ == 3 || s_ == 4)) nrep = 2;
            if ((PROBE_REP & 8) && s_ == 11) nrep = 2;
            if ((PROBE_REP & 16) && s_ == 12) nrep = 2;
            if ((PROBE_REP & 32) && (s_ == 9 || s_ == 10)) nrep = 2;
            if ((PROBE_REP & 64) && st == 0) nrep = 2;
            if ((PROBE_REP & 128) && (st == 2 || s_ == 2 || s_ == 17 || s_ == 20)) nrep = 2;
            if ((PROBE_REP & 512) && (s_ >= 5 && s_ <= 8)) nrep = 2;
            if ((PROBE_REP & 1024) && s_ == 16) nrep = 2;
            if ((PROBE_REP & 2048) && st == 1) nrep = 2;
            if ((PROBE_REP & 4096) && (s_ == 13 || s_ == 14 || s_ == 15)) nrep = 2; }
#pragma unroll 1
        for (int rep = 0; rep < nrep; ++rep) {
        const float gsm = (rep + 1 < nrep) ? 0.0f : 1.0f;
        if (st == 0) { if (PSEL(100)) p0_phase(F, A); }
        else if (st == 1) { if (PSEL(101)) p0b_phase(F, A); }
        else if (st == 2) { if (PSEL(102)) norm_phase(F, A, 0, 0, true, true); }
        else {
            const int l = (st - 3) / ST_PER_LAYER, s = (st - 3) % ST_PER_LAYER;
            const float* ada = WSP(float, WS_ADA) + (size_t)l * 3 * NADA;
            if ((s == 0 || s == 18) && PSEL(0)) {
                const int f = s == 0 ? 0 : 1;
                EpiSwiglu E{WSP(bf16_t, WS_ACT)};
                run_gemm(F, WSP(bf16_t, WS_N), DM, WSP(bf16_t, WS_WUP) + (size_t)(l * 2 + f) * NUP * DM, DM, MTOK, NUP, DM, 0, E);
            } else if ((s == 1 || s == 19) && PSEL(1)) {
                const int f = s == 1 ? 0 : 1;
                EpiResid E{WSP(float, WS_H), ada + (f == 0 ? 2 : 8) * DM, 0.5f * gsm};
                run_gemm(F, WSP(bf16_t, WS_ACT), DFF, WSP(bf16_t, WS_WDN) + (size_t)(l * 2 + f) * DM * DFF, DFF, MTOK, DM, DFF, 0, E);
            } else if (s == 2 && PSEL(2)) norm_phase(F, A, l, 1, false, false);
            else if (s == 3 && PSEL(3)) {
                EpiProj1 E1{WSP(bf16_t, WS_P1), WSP(float, WS_SSQ), WSP(float, WS_SSKV), WSP(float, WS_CKVRAW), WSP(float, WS_KRRAW)};
                run_gemm(F, WSP(bf16_t, WS_N), DM, WSP(bf16_t, WS_W1T) + (size_t)l * N1 * DM, DM, MTOK, N1, DM, 0, E1);
            } else if (s == 4 && PSEL(4)) {
                EpiT E2{WSP(bf16_t, WS_HYT), WSP(bf16_t, WS_XCTL), WSP(bf16_t, WS_XCTC)};
                run_gemm(F, WSP(bf16_t, WS_W2T) + (size_t)l * N2 * DM, DM, WSP(bf16_t, WS_N), DM, N2, MTOK, DM, 192, E2);
            } else if (s == 5 && PSEL(5)) {
                EpiQ EQ{WSP(bf16_t, WS_Q), WSP(float, WS_SSQ), WSP(float, WS_ROPE)};
                run_gemm(F, WSP(bf16_t, WS_P1), N1, WSP(bf16_t, WS_WQB) + (size_t)l * 768 * 256, 256, MTOK, 768, 256, 0, EQ);
            } else if (s == 6 && PSEL(6)) {
                EpiKV<false> EK{WSP(bf16_t, WS_KV), WSP(float, WS_SSKV)};
                run_gemm(F, WSP(bf16_t, WS_P1) + 256, N1, WSP(bf16_t, WS_WKVB) + (size_t)l * 1024 * 256, 256, MTOK, 1024, 256, 96, EK);
            } else if (s == 7 && PSEL(7)) {
                EpiKV<true> EC{WSP(bf16_t, WS_KV), nullptr};
                run_gemm(F, WSP(bf16_t, WS_CKVB) + (size_t)l * 1024 * 256, 256, WSP(bf16_t, WS_WKVR) + (size_t)l * 1024 * 256, 256, 1024, 1024, 256, 224, EC);
            } else if (s == 8 && PSEL(8)) {
                TLW(); const int gt = F.bid * NTHR + tid, NGT = F.G * NTHR;
                for (int it = gt; it < NCTX * 32; it += NGT) { const int r = it >> 5, c4 = (it & 31) * 4;
                    const f32x4 ss = *(const f32x4*)(WSP(float, WS_SSKV) + r * 4); const float rstd = 1.0f / sqrtf(((ss[0] + ss[1]) + (ss[2] + ss[3])) * (1.0f / 128.0f) + EPSV);
                    const f32x4 x = *(const f32x4*)(WSP(float, WS_CKVRAW) + (size_t)r * 128 + c4), g = *(const f32x4*)(AIN(I_KVNG) + l * 128 + c4);
                    *(f32x4*)(A.out + (size_t)MTOK * DM + ((size_t)((r >> 8) * 2 + l) * 256 + (r & 255)) * 128 + c4) = x * rstd * g; }
                for (int it = gt; it < MTOK * 4; it += NGT) { const int row = it >> 2, q = it & 3, part = q >> 1, ib = 4 * (q & 1);
                    const float* kp = WSP(float, WS_KRRAW) + (size_t)row * 32 + 8 * q; const f32x4 va = *(const f32x4*)kp, vb = *(const f32x4*)(kp + 4);
                    float v[8] = {va[0], va[1], va[2], va[3], vb[0], vb[1], vb[2], vb[3]};
                    if (row < NCTX) { float* op = A.out + (size_t)MTOK * DM + (size_t)16 * 2 * 256 * 128 + (size_t)((row >> 8) * 2 * 256 + l * 256 + (row & 255)) * 32 + part * 16 + ib;
#pragma unroll
                        for (int e = 0; e < 8; ++e) op[(e & 1) * 8 + (e >> 1)] = v[e];
                    } else { const int t = (row - NCTX) & 2047, pos = part == 0 ? (t >> 6) : (t & 63); const float* rt = WSP(float, WS_ROPE) + (pos * 8 + ib) * 2;
#pragma unroll
                        for (int e = 0; e < 8; e += 2) { const float cs = rt[e], sn = rt[e + 1], x1 = v[e], x2 = v[e + 1]; v[e] = x1 * cs - x2 * sn; v[e + 1] = x2 * cs + x1 * sn; } }
                    u32x4 w; w.x = cvtpk(v[0], v[1]); w.y = cvtpk(v[2], v[3]); w.z = cvtpk(v[4], v[5]); w.w = cvtpk(v[6], v[7]);
                    *(u32x4*)(WSP(bf16_t, WS_KR) + (size_t)kvrow_of(row) * 32 + 8 * q) = w; }
                for (int it = gt; it < 2 * 512 * 32; it += NGT) { const int pp = it & 31, j = (it >> 5) & 511, b = it >> 14; const int part = pp >> 4, w = pp & 15, i = w >> 1, half = w & 1, p = part * 16 + half * 8 + i;
                    WSP(bf16_t, WS_KR)[(size_t)(NCTX + b * 2560 + 2048 + j) * 32 + pp] = (bf16_t)f2bf(AIN(I_CKR)[((size_t)(b * 2 + l) * 512 + j) * 32 + p]); }
            } else if (s == 9 && PSEL(9)) {
                EpiFn EL{WSP(bf16_t, WS_FN), 1, 0.00276213586400995f};
                run_gemm(F, WSP(bf16_t, WS_DFTL), 4096, WSP(bf16_t, WS_XCTL), 4096, 2048, 512, 4096, 192, EL);
            } else if (s == 10 && PSEL(10)) {
                EpiFn EC{WSP(bf16_t, WS_FN), 0, 0.0078125f};
                run_gemm(F, WSP(bf16_t, WS_DFTC), 512, WSP(bf16_t, WS_XCTC), 512, 256, 4096, 512, 208, EC);
            } else if (s == 11 && PSEL(11)) {
                for (int u = F.bid; u < 256; u += F.G) {
                    const bf16_t *Qb, *KVh, *KRr; bf16_t* Ob; int seq;
                    if (u < 128) { const int b = u >> 6, h = (u >> 3) & 7, qb = u & 7; const int r0 = NCTX + b * 2048 + qb * 256, k0 = NCTX + b * 2560;
                        Qb = WSP(bf16_t, WS_Q) + (size_t)r0 * 768 + h * 96; KVh = WSP(bf16_t, WS_KV) + (size_t)k0 * 1024 + h * 128; KRr = WSP(bf16_t, WS_KR) + (size_t)k0 * 32; Ob = WSP(bf16_t, WS_O) + (size_t)r0 * 512 + h * 64; seq = 2560; }
                    else { const int v = u - 128, b = v >> 3, h = v & 7; const int r0 = b * 256;
                        Qb = WSP(bf16_t, WS_Q) + (size_t)r0 * 768 + h * 96; KVh = WSP(bf16_t, WS_KV) + (size_t)r0 * 1024 + h * 128; KRr = WSP(bf16_t, WS_KR) + (size_t)r0 * 32; Ob = WSP(bf16_t, WS_O) + (size_t)r0 * 512 + h * 64; seq = 256; }
                    att::attn_unit(Qb, KVh, KRr, Ob, seq, F.ldsg);
                }
            } else if (s == 12 && PSEL(12)) {
                for (int u = (F.bid + 128) % F.G; u < 128; u += F.G) hyena_unit(F, A, l, u);
            } else if (s == 13 && PSEL(13)) {
                EpiGate<0> E0{WSP(float, WS_Y), WSP(bf16_t, WS_N), WSP(bf16_t, WS_P1) + 512, 1.0f};
                run_gemm(F, WSP(bf16_t, WS_Z), 256, WSP(bf16_t, WS_WHY) + (size_t)l * 1024 * 256, 256, MTOK, DM, 256, 0, E0);
            } else if (s == 14 && PSEL(14)) {
                EpiGate<1> E1{WSP(float, WS_Y), WSP(bf16_t, WS_N), WSP(bf16_t, WS_P1) + 512 + 1024, gsm};
                run_gemm(F, WSP(bf16_t, WS_O), 512, WSP(bf16_t, WS_WMLA) + (size_t)l * 1024 * 512, 512, MTOK, DM, 512, 0, E1);
            } else if (s == 15 && PSEL(15)) {
                EpiGate<2> E2{WSP(float, WS_Y), WSP(bf16_t, WS_N), WSP(bf16_t, WS_P1) + 512 + 2048, 1.0f};
                run_gemm(F, WSP(bf16_t, WS_FN), 256, WSP(bf16_t, WS_WFN) + (size_t)l * 1024 * 256, 256, MTOK, DM, 256, 0, E2);
            } else if (s == 16 && PSEL(16)) {
                EpiResid E{WSP(float, WS_H), ada + 5 * DM, 1.0f * gsm};
                run_gemm(F, WSP(bf16_t, WS_N), DM, WSP(bf16_t, WS_WOUT) + (size_t)l * DM * DM, DM, MTOK, DM, DM, 0, E);
            } else if (s == 17 && PSEL(17)) norm_phase(F, A, l, 2, false, false);
            else if (s == 20 && PSEL(20)) { if (l == 0) norm_phase(F, A, 1, 0, false, false); else final_norm_phase(F, A); }
        }
        if (rep + 1 < nrep) { asm volatile("s_waitcnt vmcnt(0)" ::: "memory"); __syncthreads(); }
        }
        if (st + 1 < hi) { if (bar_after(st)) { xcd_barrier(bar); if (PROBE_REP & 256) xcd_barrier(bar); } else { asm volatile("s_waitcnt vmcnt(0)" ::: "memory"); __syncthreads(); } }
    }
}

extern "C" void kernel_launch(void* const* d_in, const int* in_sizes, int n_in, void* d_out, int out_size, void* d_ws, size_t ws_size, hipStream_t stream) {
    static int grid = 0;
    if (grid == 0) {
        if (n_in != 29 || ws_size < WS_END) { fprintf(stderr, "kernel_launch: n_in %d ws %zu (need %zu)\n", n_in, ws_size, (size_t)WS_END); grid = -1; return; }
        int dev = 0, cus = 0;
        if (hipGetDevice(&dev) != hipSuccess || hipDeviceGetAttribute(&cus, hipDeviceAttributeMultiprocessorCount, dev) != hipSuccess) { grid = -1; return; }
        if (hipFuncSetAttribute((const void*)mk_fwd, hipFuncAttributeMaxDynamicSharedMemorySize, LDS_BYTES) != hipSuccess) { fprintf(stderr, "kernel_launch: hipFuncSetAttribute failed\n"); grid = -1; return; }
        grid = cus;
    }
    if (grid < 0) return;
    (void)hipMemsetAsync((char*)d_ws + WS_CTL, 0, CTL_BYTES, stream);
    Args a{};
    for (int i = 0; i < 29; ++i) a.in[i] = (const float*)d_in[i];
    a.out = (float*)d_out; a.ws = (unsigned char*)d_ws;
#if MK_ONE_LAUNCH
    a.ph_lo = 0; a.ph_hi = N_STEPS; a.use_bar = 1;
    hipLaunchKernelGGL(mk_fwd, dim3(grid), dim3(NTHR), LDS_BYTES, stream, a);
#else
    a.use_bar = 0;
    for (int s0 = 0; s0 < N_STEPS;) { int s1 = s0; while (!bar_after(s1)) ++s1; a.ph_lo = s0; a.ph_hi = s1 + 1; hipLaunchKernelGGL(mk_fwd, dim3(grid), dim3(NTHR), LDS_BYTES, stream, a); s0 = s1 + 1; }
#endif
}
```

```cpp
#include <hip/hip_runtime.h>
#include <cstdio>
#include <cstdint>
namespace pg8 {
#define PG8_LAS __attribute__((address_space(3)))
typedef unsigned short bf16_t;
typedef short bf16x8 __attribute__((ext_vector_type(8)));
typedef float f32x4 __attribute__((ext_vector_type(4)));
typedef unsigned u32x4 __attribute__((ext_vector_type(4)));
constexpr int BM = 256, BK = 64, HALF = 128, HTB = HALF * BK * 2  , STAGE_BYTES = 8 * HTB, NXCD = 8, WGM = 8;

__host__ __device__ __forceinline__ int lds_byte(int r, int c) { const int st = (r >> 4) * 2 + (c >> 5), rr = r & 15, cc = c & 31, ob = rr * 64 + cc * 2; return st * 1024 + (ob ^ (((ob >> 9) & 1) << 5)); }
__host__ __device__ __forceinline__ void stage_rc(int b, int& R, int& C) { const int st = b / 1024, sb = b % 1024, swz = sb ^ (((sb >> 9) & 1) << 5); R = (st >> 1) * 16 + swz / 64; C = (st & 1) * 32 + (swz % 64) / 2; }
__host__ __device__ __forceinline__ int perm32(int rho) { const int n = rho >> 4, i = rho & 15; return 8 * (i >> 2) + 4 * n + (i & 3); }

struct Unit { int pm, pn; };
struct Gemm { const bf16_t* A; const bf16_t* Bt; int M, N, K, lda, ldb; };

struct StaticOrder {
    int nM, nN, nwg, G, c;
    __host__ __device__ void init(int M, int N, int G_, int c_) { nM = M / BM; nN = N / BM; nwg = nM * nN; G = G_; c = c_; }
    __host__ __device__ bool next(int i, Unit& u) const {
        const long L = (long)i * G + c; if (L >= nwg) return false;
        int wgid = (int)L; { const int q = nwg / NXCD, r = nwg % NXCD, xcd = wgid % NXCD, off = wgid / NXCD; wgid = (xcd < r ? xcd * (q + 1) : r * (q + 1) + (xcd - r) * q) + off; }
        const int nig = WGM * nN, gid = wgid / nig, fm = gid * WGM, gsz = (nM - fm) < WGM ? (nM - fm) : WGM;
        u.pm = fm + ((wgid % nig) % gsz); u.pn = (wgid % nig) / gsz; return true;
    }
    __device__ __forceinline__ void a_ready(const Unit&) const {}
    __device__ __forceinline__ void done(const Unit&) const {}
};


__device__ __forceinline__ f32x4 zero4_() { float a, b, c, d; asm volatile("v_mov_b32 %0, 0\n\tv_mov_b32 %1, 0\n\tv_mov_b32 %2, 0\n\tv_mov_b32 %3, 0" : "=v"(a), "=v"(b), "=v"(c), "=v"(d)); return (f32x4){a, b, c, d}; }
template <class Epi, class Sched, bool ALIGN_EPI = false, bool SP2 = false>
__device__ __forceinline__ void gemm_phase(PG8_LAS unsigned char* lds, const Gemm g, const Sched& S, const Epi& E) {
    int tid_ = threadIdx.x; asm volatile("" : "+v"(tid_));
    const int tid = tid_, wid = __builtin_amdgcn_readfirstlane(tid >> 6), lane = tid & 63, wr = wid >> 2, wc = wid & 3, fr = lane & 15, fq = lane >> 4;
    const int K = g.K, nt = K / BK;
    unsigned voffA[2], voffB[2];
#pragma unroll
    for (int i = 0; i < 2; ++i) { int R, C; stage_rc(tid * 16 + i * 8192, R, C); const int Rb = Epi::PERM ? ((R & ~31) + perm32(R & 31)) : R;
        voffA[i] = (unsigned)(R * g.lda + C) * 2u; voffB[i] = (unsigned)(Rb * g.ldb + C) * 2u; }
    const size_t kstep = (size_t)(BK * 2);
    const size_t hstepA = (size_t)HALF * g.lda * 2, hstepB = (size_t)HALF * g.ldb * 2;
    const size_t tstepA = 2 * hstepA, tstepB = 2 * hstepB;
    const unsigned ldsw = (unsigned)wid * 1024u;
    const int aoff = lds_byte(wr * 64 + fr, fq * 8), boff = lds_byte(wc * 32 + fr, fq * 8);
#define PG8_SA(b, h) (((b) * 2 + (h)) * HTB)
#define PG8_SB(b, h) ((4 + (b) * 2 + (h)) * HTB)
#define PG8_STAGE(bufoff, gbase, voff) do { _Pragma("unroll") for (int _i = 0; _i < 2; ++_i) \
        __builtin_amdgcn_global_load_lds((const unsigned*)((const char*)(gbase) + (voff)[_i]), (PG8_LAS unsigned*)(lds + (bufoff) + ldsw + _i * 8192), 16, 0, 0); } while (0)
#define PG8_LDA(dst, b, h) do { _Pragma("unroll") for (int m = 0; m < 4; ++m) _Pragma("unroll") for (int k = 0; k < 2; ++k) dst[m][k] = *(const PG8_LAS bf16x8*)(lds + PG8_SA(b, h) + aoff + m * 2048 + k * 1024); } while (0)
#define PG8_LDB(dst, b, h) do { _Pragma("unroll") for (int n = 0; n < 2; ++n) _Pragma("unroll") for (int k = 0; k < 2; ++k) dst[n][k] = *(const PG8_LAS bf16x8*)(lds + PG8_SB(b, h) + boff + n * 2048 + k * 1024); } while (0)
#define PG8_MMA(ai, bj, At, Bt) do { __builtin_amdgcn_s_setprio(1); _Pragma("unroll") for (int m = 0; m < 4; ++m) _Pragma("unroll") for (int n = 0; n < 2; ++n) _Pragma("unroll") for (int k = 0; k < 2; ++k) \
        acc[ai][bj][m][n] = __builtin_amdgcn_mfma_f32_16x16x32_bf16(Bt[n][k], At[m][k], acc[ai][bj][m][n], 0, 0, 0); __builtin_amdgcn_s_setprio(0); } while (0)
#define PG8_WAIT_V(n) asm volatile("s_waitcnt vmcnt(" #n ")" ::: "memory")
#define PG8_WAIT_L(n) asm volatile("s_waitcnt lgkmcnt(" #n ")" ::: "memory")
#define PG8_BAR __builtin_amdgcn_s_barrier()
#define PG8_SCHED __builtin_amdgcn_sched_barrier(0)
    Unit cur, nxt; int ui = 0;
    if (!S.next(0, cur)) return;
    f32x4 acc[2][2][4][2];
#pragma unroll
    for (int a = 0; a < 2; ++a)
#pragma unroll
        for (int b = 0; b < 2; ++b)
#pragma unroll
            for (int m = 0; m < 4; ++m)
#pragma unroll
                for (int n = 0; n < 2; ++n) acc[a][b][m][n] = zero4_();
    bf16x8 At[4][2], B0[2][2], B1[2][2];
    const char* cA = (const char*)g.A + (size_t)cur.pm * tstepA; const char* cB = (const char*)g.Bt + (size_t)cur.pn * tstepB;
    S.a_ready(cur);
    if constexpr (SP2) {
        PG8_STAGE(PG8_SB(0, 0), cB, voffB); PG8_STAGE(PG8_SB(0, 1), cB + hstepB, voffB); PG8_STAGE(PG8_SA(0, 0), cA, voffA); PG8_STAGE(PG8_SA(0, 1), cA + hstepA, voffA);
        if (wr == 1) PG8_BAR;
        PG8_WAIT_V(2); PG8_BAR;
        PG8_STAGE(PG8_SB(1, 0), cB + kstep, voffB); PG8_STAGE(PG8_SA(1, 0), cA + kstep, voffA); PG8_STAGE(PG8_SB(1, 1), cB + hstepB + kstep, voffB);
        PG8_WAIT_V(6); PG8_BAR;
    } else {
        PG8_STAGE(PG8_SB(0, 0), cB, voffB); PG8_STAGE(PG8_SA(0, 0), cA, voffA); PG8_STAGE(PG8_SB(0, 1), cB + hstepB, voffB); PG8_STAGE(PG8_SA(0, 1), cA + hstepA, voffA);
        if (wr == 1) PG8_BAR;
        PG8_WAIT_V(4); PG8_BAR;
        PG8_STAGE(PG8_SB(1, 0), cB + kstep, voffB); PG8_STAGE(PG8_SA(1, 0), cA + kstep, voffA); PG8_STAGE(PG8_SB(1, 1), cB + hstepB + kstep, voffB);
        PG8_WAIT_V(6); PG8_BAR;
    }
#pragma unroll 1
    for (;;) {
        const bool has_next = S.next(ui + 1, nxt);
        const char* nA = has_next ? (const char*)g.A + (size_t)nxt.pm * tstepA : cA; const char* nB = has_next ? (const char*)g.Bt + (size_t)nxt.pn * tstepB : cB;
#pragma unroll 1
        for (int t = 0; t < nt; t += 2) {
            const bool last = (t == nt - 2);
            const char* a1 = cA + (size_t)(t + 1) * kstep;
            const char* a2 = last ? nA : cA + (size_t)(t + 2) * kstep; const char* b2 = last ? nB : cB + (size_t)(t + 2) * kstep;
            const char* a3 = a2 + kstep; const char* b3 = b2 + kstep;
            if (last && has_next) S.a_ready(nxt);
            if constexpr (SP2) {
            PG8_LDB(B0, 0, 0); PG8_LDB(B1, 0, 1); PG8_SCHED; PG8_LDA(At, 0, 0); PG8_STAGE(PG8_SA(1, 1), a1 + hstepA, voffA);
            PG8_WAIT_V(8); PG8_WAIT_L(0); PG8_BAR; PG8_MMA(0, 0, At, B0); PG8_MMA(0, 1, At, B1); PG8_BAR; PG8_SCHED;
            PG8_LDA(At, 0, 1); PG8_STAGE(PG8_SB(0, 0), b2, voffB); PG8_STAGE(PG8_SB(0, 1), b2 + hstepB, voffB); PG8_STAGE(PG8_SA(0, 0), a2, voffA);
            PG8_WAIT_V(8); PG8_WAIT_L(0); PG8_BAR; PG8_MMA(1, 0, At, B0); PG8_MMA(1, 1, At, B1); PG8_BAR; PG8_SCHED;
            PG8_LDB(B0, 1, 0); PG8_LDB(B1, 1, 1); PG8_SCHED; PG8_LDA(At, 1, 0); PG8_STAGE(PG8_SA(0, 1), a2 + hstepA, voffA);
            PG8_WAIT_V(8); PG8_WAIT_L(0); PG8_BAR; PG8_MMA(0, 0, At, B0); PG8_MMA(0, 1, At, B1); PG8_BAR; PG8_SCHED;
            PG8_LDA(At, 1, 1); PG8_STAGE(PG8_SB(1, 0), b3, voffB); PG8_STAGE(PG8_SB(1, 1), b3 + hstepB, voffB); PG8_STAGE(PG8_SA(1, 0), a3, voffA);
            PG8_WAIT_V(8); PG8_WAIT_L(0); PG8_BAR; PG8_MMA(1, 0, At, B0); PG8_MMA(1, 1, At, B1); PG8_BAR; PG8_SCHED;
            } else {
            PG8_LDB(B0, 0, 0); PG8_SCHED; PG8_LDA(At, 0, 0); PG8_STAGE(PG8_SA(1, 1), a1 + hstepA, voffA);
            PG8_WAIT_L(8); PG8_BAR; PG8_WAIT_L(0); PG8_MMA(0, 0, At, B0); PG8_BAR; PG8_SCHED;
            PG8_LDB(B1, 0, 1); PG8_STAGE(PG8_SB(0, 0), b2, voffB);
            PG8_BAR; PG8_WAIT_L(0); PG8_MMA(0, 1, At, B1); PG8_BAR;
            PG8_LDA(At, 0, 1); PG8_STAGE(PG8_SA(0, 0), a2, voffA);
            PG8_BAR; PG8_WAIT_L(0); PG8_MMA(1, 0, At, B0); PG8_BAR; PG8_SCHED;
            PG8_STAGE(PG8_SB(0, 1), b2 + hstepB, voffB);
            PG8_WAIT_V(6); PG8_BAR; PG8_MMA(1, 1, At, B1); PG8_BAR;
            PG8_LDB(B0, 1, 0); PG8_SCHED; PG8_LDA(At, 1, 0); PG8_STAGE(PG8_SA(0, 1), a2 + hstepA, voffA);
            PG8_WAIT_L(8); PG8_BAR; PG8_WAIT_L(0); PG8_MMA(0, 0, At, B0); PG8_BAR; PG8_SCHED;
            PG8_LDB(B1, 1, 1); PG8_STAGE(PG8_SB(1, 0), b3, voffB);
            PG8_BAR; PG8_WAIT_L(0); PG8_MMA(0, 1, At, B1); PG8_BAR;
            PG8_LDA(At, 1, 1); PG8_STAGE(PG8_SA(1, 0), a3, voffA);
            PG8_BAR; PG8_WAIT_L(0); PG8_MMA(1, 0, At, B0); PG8_BAR; PG8_SCHED;
            PG8_STAGE(PG8_SB(1, 1), b3 + hstepB, voffB);
            PG8_WAIT_V(6); PG8_BAR; PG8_MMA(1, 1, At, B1); PG8_BAR;
            }
        }
        if constexpr (ALIGN_EPI) { if (wr == 0) PG8_BAR; }
        if constexpr (!Epi::AFTER_DRAIN) { E(acc, cur, wr, wc, fr, fq); S.done(cur); }
        if (!has_next) break;
#pragma unroll
        for (int a = 0; a < 2; ++a)
#pragma unroll
            for (int b = 0; b < 2; ++b)
#pragma unroll
                for (int m = 0; m < 4; ++m)
#pragma unroll
                    for (int n = 0; n < 2; ++n) acc[a][b][m][n] = zero4_();
        cur = nxt; cA = nA; cB = nB; ++ui;
        if constexpr (ALIGN_EPI) { if (wr == 1) PG8_BAR; }
    }
    PG8_WAIT_V(0);
    if constexpr (!ALIGN_EPI) { if (wr == 0) PG8_BAR; }
    PG8_BAR;
    if constexpr (Epi::AFTER_DRAIN) { E.fused(acc, cur, wr, wc, fr, fq, lds, wid, lane); S.done(cur); }
#undef PG8_SA
#undef PG8_SB
#undef PG8_STAGE
#undef PG8_LDA
#undef PG8_LDB
#undef PG8_MMA
#undef PG8_WAIT_V
#undef PG8_WAIT_L
#undef PG8_BAR
#undef PG8_SCHED
}
}

#define GAS __attribute__((address_space(1)))
#define LAS __attribute__((address_space(3)))
typedef unsigned short bf16_t;
typedef float f32x4 __attribute__((ext_vector_type(4)));
typedef float f32x8 __attribute__((ext_vector_type(8)));
typedef float f32x16 __attribute__((ext_vector_type(16)));
typedef short bf16x8 __attribute__((ext_vector_type(8)));
typedef short s16x4 __attribute__((ext_vector_type(4)));
typedef unsigned u32x4 __attribute__((ext_vector_type(4)));
typedef unsigned u32x2 __attribute__((ext_vector_type(2)));

constexpr int DM = 1024, MTOK = 8192, NCTX = 4096, LCTX = 256, LLAT = 2048;
constexpr int DFF = 2816, NUP = 5632, INC = 4512;
constexpr int N1 = 3584;
constexpr int N2 = 1280;
constexpr int KVROWS = 9216;
constexpr int NADA = 9216;
constexpr float EPSV = 1e-6f;
constexpr int NWAVES = 8, NTHR = 512;

constexpr size_t al256(size_t x) { return (x + 255) & ~(size_t)255; }
constexpr size_t WS_CTL = 0, CTL_BYTES = 1u << 20;
constexpr size_t WS_ADAP = WS_CTL + CTL_BYTES;
constexpr size_t WS_ADA  = WS_ADAP + al256((size_t)16 * 2 * 3 * NADA * 4);
constexpr size_t WS_SSQ  = WS_ADA + al256((size_t)2 * 3 * NADA * 4);
constexpr size_t WS_SSKV = WS_SSQ + al256((size_t)MTOK * 4 * 4);
constexpr size_t WS_ROPE = WS_SSKV + al256((size_t)MTOK * 4 * 4);
constexpr size_t WS_H2   = WS_ROPE + al256(64 * 8 * 2 * 4);
constexpr size_t WS_FILT = WS_H2 + al256((size_t)2 * 2304 * 64 * 4);
constexpr size_t FILT_LAYER = (size_t)512 * 4096 + (size_t)512 * 512;
constexpr size_t WS_CKVRAW = WS_FILT + al256(2 * FILT_LAYER * 4);
constexpr size_t WS_KRRAW = WS_CKVRAW + al256((size_t)NCTX * 128 * 4);
constexpr size_t WS_CKVB = WS_KRRAW + al256((size_t)MTOK * 32 * 4);
constexpr size_t WS_WUP  = WS_CKVB + al256((size_t)2 * 1024 * 256 * 2);
constexpr size_t WS_WDN  = WS_WUP + al256((size_t)4 * NUP * DM * 2);
constexpr size_t WS_W1T  = WS_WDN + al256((size_t)4 * DM * DFF * 2);
constexpr size_t WS_W2T  = WS_W1T + al256((size_t)2 * N1 * DM * 2);
constexpr size_t WS_WQB  = WS_W2T + al256((size_t)2 * N2 * DM * 2);
constexpr size_t WS_WKVB = WS_WQB + al256((size_t)2 * 768 * 256 * 2);
constexpr size_t WS_WKVR = WS_WKVB + al256((size_t)2 * 1024 * 256 * 2);
constexpr size_t WS_WHY  = WS_WKVR + al256((size_t)2 * 1024 * 256 * 2);
constexpr size_t WS_WMLA = WS_WHY + al256((size_t)2 * 1024 * 256 * 2);
constexpr size_t WS_WFN  = WS_WMLA + al256((size_t)2 * 1024 * 512 * 2);
constexpr size_t WS_WOUT = WS_WFN + al256((size_t)2 * 1024 * 256 * 2);
constexpr size_t WS_DFTL = WS_WOUT + al256((size_t)2 * 1024 * 1024 * 2);
constexpr size_t WS_DFTC = WS_DFTL + al256((size_t)2048 * 4096 * 2);
constexpr size_t WS_H    = WS_DFTC + al256((size_t)256 * 512 * 2);
constexpr size_t WS_N    = WS_H + al256((size_t)MTOK * DM * 4);
constexpr size_t WS_KV   = WS_N + al256((size_t)MTOK * DM * 2);
constexpr size_t WS_KR   = WS_KV + al256((size_t)KVROWS * 1024 * 2);
constexpr size_t WS_R1   = WS_KR + al256((size_t)KVROWS * 32 * 2);
constexpr size_t WS_ACT  = WS_R1;
constexpr size_t WS_P1   = WS_R1;
constexpr size_t WS_HYT  = WS_P1 + al256((size_t)MTOK * N1 * 2);
constexpr size_t WS_XCTL = WS_HYT + al256((size_t)768 * MTOK * 2);
constexpr size_t WS_XCTC = WS_XCTL + al256((size_t)512 * 4096 * 2);
constexpr size_t WS_Q    = WS_XCTC + al256((size_t)4096 * 512 * 2);
constexpr size_t WS_O    = WS_Q + al256((size_t)MTOK * 768 * 2);
constexpr size_t WS_Z    = WS_O + al256((size_t)MTOK * 512 * 2);
constexpr size_t WS_FN   = WS_Z + al256((size_t)MTOK * 256 * 2);
constexpr size_t WS_Y    = WS_FN + al256((size_t)MTOK * 256 * 2);
constexpr size_t WS_END  = WS_Y + al256((size_t)MTOK * DM * 4);
static_assert(WS_ACT + (size_t)MTOK * DFF * 2 <= WS_END, "ws map");

constexpr int CW_BAR = 4096;

constexpr int RING_BYTES = 131072;
constexpr int MISC_OFF = 163840 - 256;
constexpr int LDS_BYTES = 163840;

__device__ __forceinline__ unsigned f2bf(float f) { unsigned u = __builtin_bit_cast(unsigned, f); return (u + 0x7fffu + ((u >> 16) & 1u)) >> 16; }
__device__ __forceinline__ unsigned pk2(float lo, float hi) { return f2bf(lo) | (f2bf(hi) << 16); }
__device__ __forceinline__ float bf2f(unsigned short b) { return __builtin_bit_cast(float, (unsigned)b << 16); }
__device__ __forceinline__ float bflo(unsigned w) { return __builtin_bit_cast(float, w << 16); }
__device__ __forceinline__ float bfhi(unsigned w) { return __builtin_bit_cast(float, w & 0xffff0000u); }
__device__ __forceinline__ unsigned cvtpk(float lo, float hi) { unsigned r; asm volatile("v_cvt_pk_bf16_f32 %0, %1, %2" : "=v"(r) : "v"(lo), "v"(hi)); return r; }
__device__ __forceinline__ u32x4 pack8(f32x4 a, f32x4 b) { u32x4 w; w.x = cvtpk(a[0], a[1]); w.y = cvtpk(a[2], a[3]); w.z = cvtpk(b[0], b[1]); w.w = cvtpk(b[2], b[3]); return w; }
__device__ __forceinline__ float wave_sum(float v) {
#pragma unroll
    for (int o = 1; o < 64; o <<= 1) v += __shfl_xor(v, o);
    return v;
}
__device__ __forceinline__ float sigmoidf_(float x) { return 1.0f / (1.0f + __expf(-x)); }
__device__ __forceinline__ float siluf_(float x) { return x / (1.0f + __expf(-x)); }
__device__ __forceinline__ int grp_of_pm(int pm) { return pm < 16 ? 0 : (pm < 24 ? 1 : 2); }
__device__ __forceinline__ int kvrow_of(int r) { return r < NCTX ? r : NCTX + ((r - NCTX) >> 11) * 2560 + ((r - NCTX) & 2047); }

#define XB_TMO      128
#define XB_XCNT(j)  (256  + 64 * (j))
#define XB_XSUB(j)  (1280 + 64 * (j))
#define XB_XGEN(j)  (2304 + 64 * (j))
#define XB_TOP      3328
#define XB_TOPGEN   3392
#define XCD_BAR_WORDS 3456
#define XB_SPIN_CAP (1u << 20)
__device__ __forceinline__ unsigned xb_ld(unsigned* p)              { return __hip_atomic_load(p, __ATOMIC_RELAXED, __HIP_MEMORY_SCOPE_AGENT); }
__device__ __forceinline__ unsigned xb_add(unsigned* p, unsigned v) { return __hip_atomic_fetch_add(p, v, __ATOMIC_RELAXED, __HIP_MEMORY_SCOPE_AGENT); }
__device__ __forceinline__ unsigned xb_xcc_id() { return (unsigned)__builtin_amdgcn_s_getreg((3 << 11) | 20) & 0xFu; }
#define XB_SPIN(cond, bar) do { unsigned _sp = 0; while (cond) { __builtin_amdgcn_s_sleep(1); \
    if ((++_sp & 255u) == 0u) { if (xb_ld(&(bar)[XB_TMO])) break; if (_sp > XB_SPIN_CAP) { atomicAdd(&(bar)[XB_TMO], 1u); break; } } } } while (0)
struct XcdBarrier { unsigned* bar; unsigned x; volatile LAS unsigned* st; };
__device__ __forceinline__ XcdBarrier xcd_barrier_post(unsigned* bar, volatile LAS unsigned* st) {
    XcdBarrier b; b.bar = bar; b.x = xb_xcc_id(); b.st = st;
    if (threadIdx.x == 0) (void)xb_add(&bar[XB_XCNT(b.x)], 1u);
    return b;
}
__device__ __forceinline__ void xcd_barrier_complete(unsigned* bar, unsigned x, unsigned& nloc, unsigned& nx) {
    const unsigned G = gridDim.x * gridDim.y * gridDim.z;
    unsigned sum, cnt, mine, sp = 0u;
    for (;;) {
        sum = 0u; cnt = 0u; mine = 0u;
#pragma unroll 1
        for (unsigned j = 0; j < 16; ++j) { const unsigned c = xb_ld(&bar[XB_XCNT(j)]); sum += c; cnt += (c > 0u) ? 1u : 0u; mine = (j == x) ? c : mine; }
        if (sum == G) break;
        __builtin_amdgcn_s_sleep(1);
        if ((++sp & 255u) == 0u) { if (xb_ld(&bar[XB_TMO])) break; if (sp > XB_SPIN_CAP) { atomicAdd(&bar[XB_TMO], 1u); break; } }
    }
    nloc = mine > 0u ? mine : 1u; nx = cnt > 0u ? cnt : 1u;
}
__device__ __forceinline__ void xcd_barrier(const XcdBarrier& b) {
    asm volatile("s_waitcnt vmcnt(0)" ::: "memory");
    __syncthreads();
    if (threadIdx.x == 0) {
        size_t z_ = 0; asm volatile("" : "+s"(z_));
        unsigned* bar = b.bar + z_;
        __builtin_amdgcn_s_waitcnt(0);
        unsigned nloc = b.st[0], nx = b.st[1];
        if (nloc == 0u) { xcd_barrier_complete(bar, b.x, nloc, nx); b.st[0] = nloc; b.st[1] = nx; }
        const unsigned old = xb_add(&bar[XB_XSUB(b.x)], 1u);
        const unsigned gen = old / nloc;
        if (old + 1u == (gen + 1u) * nloc) {
            __builtin_amdgcn_fence(__ATOMIC_RELEASE, "agent");
            asm volatile("s_waitcnt vmcnt(0)" ::: "memory");
            const unsigned og = xb_add(&bar[XB_TOP], 1u);
            const unsigned tg = og / nx;
            if (og + 1u == (tg + 1u) * nx) xb_add(&bar[XB_TOPGEN], 1u);
            else XB_SPIN(xb_ld(&bar[XB_TOPGEN]) == tg, bar);
            __builtin_amdgcn_fence(__ATOMIC_ACQUIRE, "agent");
            xb_add(&bar[XB_XGEN(b.x)], 1u);
            asm volatile("s_waitcnt vmcnt(0)" ::: "memory");
        } else {
            XB_SPIN(xb_ld(&bar[XB_XGEN(b.x)]) == gen, bar);
            __builtin_amdgcn_fence(__ATOMIC_ACQUIRE, "agent");
            asm volatile("s_waitcnt vmcnt(0)" ::: "memory");
        }
    }
    __syncthreads();
}

using pg8::Unit;
typedef const f32x4 (&AccT)[2][2][4][2];

struct EpiSwiglu {
    static constexpr bool PERM = false, AFTER_DRAIN = false;
    bf16_t* ACT;
    __device__ __forceinline__ void operator()(AccT acc, const Unit& u, int wr, int wc, int fr, int fq) const {
        int z_ = 0; asm volatile("" : "+s"(z_));
        const int row0 = u.pm * 256 + wr * 64 + fr + z_, f0 = u.pn * 128 + wc * 16 + 4 * fq;
#pragma unroll
        for (int ai = 0; ai < 2; ++ai)
#pragma unroll
            for (int m = 0; m < 4; ++m) { bf16_t* rp = ACT + (size_t)(row0 + ai * 128 + m * 16) * DFF + f0;
#pragma unroll
                for (int bj = 0; bj < 2; ++bj) { const f32x4 g = acc[ai][bj][m][0], x = acc[ai][bj][m][1];
                    u32x2 w; w.x = cvtpk(siluf_(g[0]) * x[0], siluf_(g[1]) * x[1]); w.y = cvtpk(siluf_(g[2]) * x[2], siluf_(g[3]) * x[3]);
                    *(u32x2*)(rp + 64 * bj) = w; } }
    }
};
struct EpiResid {
    static constexpr bool PERM = true, AFTER_DRAIN = false;
    float* H; const float* gate; float gs;
    __device__ __forceinline__ void operator()(AccT acc, const Unit& u, int wr, int wc, int fr, int fq) const {
        int z_ = 0; asm volatile("" : "+s"(z_));
        const int row0 = u.pm * 256 + wr * 64 + fr + z_, col0 = u.pn * 256 + wc * 32 + 8 * fq;
        const float* gp = gate + grp_of_pm(u.pm) * NADA + col0;
        f32x4 gv[2][2];
#pragma unroll
        for (int bj = 0; bj < 2; ++bj) { gv[bj][0] = *(const f32x4*)(gp + bj * 128) * gs; gv[bj][1] = *(const f32x4*)(gp + bj * 128 + 4) * gs; }
#pragma unroll
        for (int ai = 0; ai < 2; ++ai)
#pragma unroll
            for (int m = 0; m < 4; ++m) { float* rp = H + (size_t)(row0 + ai * 128 + m * 16) * DM + col0;
#pragma unroll
                for (int bj = 0; bj < 2; ++bj) {
                    f32x4 h0 = *(const f32x4*)(rp + bj * 128), h1 = *(const f32x4*)(rp + bj * 128 + 4);
                    h0 += gv[bj][0] * acc[ai][bj][m][0]; h1 += gv[bj][1] * acc[ai][bj][m][1];
                    *(f32x4*)(rp + bj * 128) = h0; *(f32x4*)(rp + bj * 128 + 4) = h1; }
                if (m & 1) asm volatile("" ::: "memory"); }
    }
};
struct EpiProj1 {
    static constexpr bool PERM = true, AFTER_DRAIN = false;
    bf16_t* P1; float* SSQ; float* SSKV; float* CKVRAW; float* KRRAW;
    __device__ __forceinline__ void operator()(AccT acc, const Unit& u, int wr, int wc, int fr, int fq) const {
        int z_ = 0; asm volatile("" : "+s"(z_));
        fq += z_; wc += z_;
        const int row0 = u.pm * 256 + wr * 64 + fr + z_, col0 = u.pn * 256 + wc * 32 + 8 * fq;
        if (u.pn >= 2) {
#pragma unroll
            for (int ai = 0; ai < 2; ++ai)
#pragma unroll
                for (int m = 0; m < 4; ++m) { bf16_t* rp = P1 + (size_t)(row0 + ai * 128 + m * 16) * N1 + col0;
#pragma unroll
                    for (int bj = 0; bj < 2; ++bj) { f32x4 a = acc[ai][bj][m][0], b = acc[ai][bj][m][1];
#pragma unroll
                        for (int j = 0; j < 4; ++j) { a[j] = sigmoidf_(a[j]); b[j] = sigmoidf_(b[j]); }
                        *(u32x4*)(rp + bj * 128) = pack8(a, b); } }
        } else {
            const bool isq = (u.pn == 0);
#pragma unroll
            for (int ai = 0; ai < 2; ++ai)
#pragma unroll
                for (int m = 0; m < 4; ++m) { const int row = row0 + ai * 128 + m * 16; bf16_t* rp = P1 + (size_t)row * N1 + col0;
                    const f32x4 a0 = acc[ai][0][m][0], b0 = acc[ai][0][m][1], a1 = acc[ai][1][m][0], b1 = acc[ai][1][m][1];
                    *(u32x4*)(rp) = pack8(a0, b0); *(u32x4*)(rp + 128) = pack8(a1, b1);
                    float s = (a0[0] * a0[0] + a0[1] * a0[1]) + (a0[2] * a0[2] + a0[3] * a0[3]) + (b0[0] * b0[0] + b0[1] * b0[1]) + (b0[2] * b0[2] + b0[3] * b0[3]);
                    if (isq) s += (a1[0] * a1[0] + a1[1] * a1[1]) + (a1[2] * a1[2] + a1[3] * a1[3]) + (b1[0] * b1[0] + b1[1] * b1[1]) + (b1[2] * b1[2] + b1[3] * b1[3]);
                    s += __shfl_xor(s, 16); s += __shfl_xor(s, 32);
                    if (fq == 0) (isq ? SSQ : SSKV)[row * 4 + wc] = s;
                    if (!isq) {
                        if (row < NCTX) { float* cp = CKVRAW + (size_t)row * 128 + wc * 32 + 8 * fq; *(f32x4*)cp = a0; *(f32x4*)(cp + 4) = b0; }
                        if (wc == 0) { float* kp = KRRAW + (size_t)row * 32 + 8 * fq; *(f32x4*)kp = a1; *(f32x4*)(kp + 4) = b1; }
                    }
                    asm volatile("" ::: "memory"); }
        }
    }
};
struct EpiQ {
    static constexpr bool PERM = true, AFTER_DRAIN = false;
    bf16_t* Q; const float* SSQ; const float* rope;
    __device__ __forceinline__ void operator()(AccT acc, const Unit& u, int wr, int wc, int fr, int fq) const {
        int z_ = 0; asm volatile("" : "+s"(z_));
        const int row0 = u.pm * 256 + wr * 64 + fr + z_, col0 = u.pn * 256 + wc * 32 + 8 * fq;
#pragma unroll
        for (int ai = 0; ai < 2; ++ai)
#pragma unroll
            for (int m = 0; m < 4; ++m) { const int row = row0 + ai * 128 + m * 16;
                const f32x4 ss = *(const f32x4*)(SSQ + row * 4); const float rstd = __builtin_amdgcn_rsqf(((ss[0] + ss[1]) + (ss[2] + ss[3])) * (1.0f / 256.0f) + EPSV);
#pragma unroll
                for (int bj = 0; bj < 2; ++bj) { const int c = col0 + bj * 128, within = c % 96;
                    f32x4 a = acc[ai][bj][m][0] * rstd, b = acc[ai][bj][m][1] * rstd;
                    if (within >= 64 && row >= NCTX) { const int pp = within - 64, part = pp >> 4, ib = (pp & 15) >> 1; const int t = (row - NCTX) & 2047, pos = part == 0 ? (t >> 6) : (t & 63);
                        const float* rt = rope + (pos * 8 + ib) * 2; const f32x4 r0 = *(const f32x4*)rt, r1 = *(const f32x4*)(rt + 4);
                        f32x4 a2, b2; a2[0] = a[0] * r0[0] - a[1] * r0[1]; a2[1] = a[1] * r0[0] + a[0] * r0[1]; a2[2] = a[2] * r0[2] - a[3] * r0[3]; a2[3] = a[3] * r0[2] + a[2] * r0[3];
                        b2[0] = b[0] * r1[0] - b[1] * r1[1]; b2[1] = b[1] * r1[0] + b[0] * r1[1]; b2[2] = b[2] * r1[2] - b[3] * r1[3]; b2[3] = b[3] * r1[2] + b[2] * r1[3]; a = a2; b = b2; }
                    *(u32x4*)(Q + (size_t)row * 768 + c) = pack8(a, b); }
                asm volatile("" ::: "memory"); }
    }
};
template <bool CACHED> struct EpiKV {
    static constexpr bool PERM = true, AFTER_DRAIN = false;
    bf16_t* KV; const float* SS;
    __device__ __forceinline__ void operator()(AccT acc, const Unit& u, int wr, int wc, int fr, int fq) const {
        int z_ = 0; asm volatile("" : "+s"(z_));
        const int row0 = u.pm * 256 + wr * 64 + fr + z_, col0 = u.pn * 256 + wc * 32 + 8 * fq;
#pragma unroll
        for (int ai = 0; ai < 2; ++ai)
#pragma unroll
            for (int m = 0; m < 4; ++m) { const int row = row0 + ai * 128 + m * 16; float rstd = 1.0f; int drow;
                if (CACHED) drow = NCTX + (row >> 9) * 2560 + 2048 + (row & 511);
                else { drow = kvrow_of(row); const f32x4 ss = *(const f32x4*)(SS + row * 4); rstd = __builtin_amdgcn_rsqf(((ss[0] + ss[1]) + (ss[2] + ss[3])) * (1.0f / 128.0f) + EPSV); }
#pragma unroll
                for (int bj = 0; bj < 2; ++bj) *(u32x4*)(KV + (size_t)drow * 1024 + col0 + bj * 128) = pack8(acc[ai][bj][m][0] * rstd, acc[ai][bj][m][1] * rstd);
                asm volatile("" ::: "memory"); }
    }
};
struct EpiT {
    static constexpr bool PERM = true, AFTER_DRAIN = false;
    bf16_t* HYT; bf16_t* XCTL; bf16_t* XCTC;
    __device__ __forceinline__ void operator()(AccT acc, const Unit& u, int wr, int wc, int fr, int fq) const {
        int z_ = 0; asm volatile("" : "+s"(z_));
        const int row0 = u.pm * 256 + wr * 64 + fr + z_, tok0 = u.pn * 256 + wc * 32 + 8 * fq;
#pragma unroll
        for (int ai = 0; ai < 2; ++ai)
#pragma unroll
            for (int m = 0; m < 4; ++m) { const int n = row0 + ai * 128 + m * 16;
#pragma unroll
                for (int bj = 0; bj < 2; ++bj) { const int tok = tok0 + bj * 128; bf16_t* dp;
                    if (u.pm < 3) dp = HYT + (size_t)n * MTOK + tok;
                    else { const int isS = u.pm - 3, col = n - 768 - 256 * isS;
                        if (tok < NCTX) dp = XCTC + ((size_t)((tok >> 8) * 256 + col)) * 512 + isS * 256 + (tok & 255);
                        else dp = XCTL + ((size_t)(((tok - NCTX) >> 11) * 256 + col)) * 4096 + isS * 2048 + ((tok - NCTX) & 2047); }
                    *(u32x4*)dp = pack8(acc[ai][bj][m][0], acc[ai][bj][m][1]); } }
    }
};
struct EpiFn {
    static constexpr bool PERM = true, AFTER_DRAIN = false;
    bf16_t* FN; int lat; float scale;
    __device__ __forceinline__ void operator()(AccT acc, const Unit& u, int wr, int wc, int fr, int fq) const {
        int z_ = 0; asm volatile("" : "+s"(z_));
        const int rb = lat ? (NCTX + u.pn * 2048 + u.pm * 256) : (u.pn * 256);
        const int row0 = rb + wr * 64 + fr + z_, col0 = wc * 32 + 8 * fq;
#pragma unroll
        for (int ai = 0; ai < 2; ++ai)
#pragma unroll
            for (int m = 0; m < 4; ++m) { bf16_t* rp = FN + (size_t)(row0 + ai * 128 + m * 16) * 256 + col0;
#pragma unroll
                for (int bj = 0; bj < 2; ++bj) *(u32x4*)(rp + bj * 128) = pack8(acc[ai][bj][m][0] * scale, acc[ai][bj][m][1] * scale); }
    }
};
template <int MODE> struct EpiGate {
    static constexpr bool PERM = true, AFTER_DRAIN = false;
    float* Y; bf16_t* YB; const bf16_t* G; float gsc;
    __device__ __forceinline__ void operator()(AccT acc, const Unit& u, int wr, int wc, int fr, int fq) const {
        int z_ = 0; asm volatile("" : "+s"(z_));
        const int row0 = u.pm * 256 + wr * 64 + fr + z_, col0 = u.pn * 256 + wc * 32 + 8 * fq;
#pragma unroll
        for (int ai = 0; ai < 2; ++ai)
#pragma unroll
            for (int m = 0; m < 4; ++m) { const int row = row0 + ai * 128 + m * 16;
#pragma unroll
                for (int bj = 0; bj < 2; ++bj) { const int c = col0 + bj * 128;
                    const u32x4 gw = *(const u32x4*)(G + (size_t)row * N1 + c);
                    f32x4 g0, g1; g0[0] = bflo(gw.x); g0[1] = bfhi(gw.x); g0[2] = bflo(gw.y); g0[3] = bfhi(gw.y); g1[0] = bflo(gw.z); g1[1] = bfhi(gw.z); g1[2] = bflo(gw.w); g1[3] = bfhi(gw.w);
                    f32x4 a = g0 * acc[ai][bj][m][0] * gsc, b = g1 * acc[ai][bj][m][1] * gsc;
                    float* yp = Y + (size_t)row * DM + c;
                    if (MODE >= 1) { a += *(const f32x4*)yp; b += *(const f32x4*)(yp + 4); }
                    if (MODE <= 1) { *(f32x4*)yp = a; *(f32x4*)(yp + 4) = b; }
                    else *(u32x4*)(YB + (size_t)row * DM + c) = pack8(a, b); }
                asm volatile("" ::: "memory"); }
    }
};

namespace att {
constexpr int KVBLK = 64;
constexpr float SCALE = 0.10206207261596575f;
constexpr float THR = 8.f;
constexpr int SHM_V = KVBLK * 128 * 2, SHM_K = KVBLK * 128 * 2, SHM_ATTN = 2 * SHM_V + 2 * SHM_K + NWAVES * 64 * 4;
#define KSWZ(row, colB) ((row) * 256 + ((colB) ^ (((row) & 7) << 4)))
#define SBAR() __builtin_amdgcn_sched_barrier(0)
__device__ __forceinline__ int crow(int r, int hi) { return (r & 3) + 8 * (r >> 2) + 4 * hi; }
__device__ __forceinline__ void partialSM(f32x16& p0, f32x16& p1, float& m_reg, float& mn, float& alpha) {
  constexpr float C = SCALE * 1.4426950408889634f;
  float pmax = p0[0];
#pragma unroll
  for (int r = 1; r < 16; ++r) pmax = fmaxf(pmax, p0[r]);
#pragma unroll
  for (int r = 0; r < 16; ++r) pmax = fmaxf(pmax, p1[r]);
  { auto rr = __builtin_amdgcn_permlane32_swap(__float_as_uint(pmax), __float_as_uint(pmax), false, false);
    pmax = fmaxf(__uint_as_float(rr[0]), __uint_as_float(rr[1])); }
  if (__builtin_expect(__all(pmax - m_reg <= THR / SCALE), 1)) { mn = m_reg; alpha = 1.f; }
  else { mn = fmaxf(m_reg, pmax); alpha = __builtin_amdgcn_exp2f((m_reg - mn) * C); m_reg = mn; }
  float mnC = -mn * C;
#pragma unroll
  for (int r = 0; r < 16; ++r) p0[r] = fmaf(p0[r], C, mnC);
#pragma unroll
  for (int r = 0; r < 16; ++r) p1[r] = fmaf(p1[r], C, mnC);
#pragma unroll
  for (int r = 0; r < 16; ++r) p0[r] = __builtin_amdgcn_exp2f(p0[r]);
}
__device__ __forceinline__ void finishSM(f32x16& p0, f32x16& p1, float alpha, float& l_reg, bf16x8& pa0, bf16x8& pa1, bf16x8& pa2, bf16x8& pa3) {
#pragma unroll
  for (int r = 0; r < 16; ++r) p1[r] = __builtin_amdgcn_exp2f(p1[r]);
  float ps = 0;
#pragma unroll
  for (int r = 0; r < 16; ++r) ps += p0[r];
#pragma unroll
  for (int r = 0; r < 16; ++r) ps += p1[r];
  { auto rr = __builtin_amdgcn_permlane32_swap(__float_as_uint(ps), __float_as_uint(ps), false, false);
    ps = __uint_as_float(rr[0]) + __uint_as_float(rr[1]); }
  l_reg = l_reg * alpha + ps;
#define PK4(P, BASE, OUT) do { unsigned a0 = cvtpk(P[BASE + 0], P[BASE + 1]), a1 = cvtpk(P[BASE + 2], P[BASE + 3]);   \
    unsigned b0 = cvtpk(P[BASE + 4], P[BASE + 5]), b1 = cvtpk(P[BASE + 6], P[BASE + 7]);                              \
    auto r0 = __builtin_amdgcn_permlane32_swap(a0, b0, false, false); auto r1 = __builtin_amdgcn_permlane32_swap(a1, b1, false, false); \
    u32x4 w = {r0[0], r1[0], r0[1], r1[1]}; OUT = *reinterpret_cast<bf16x8*>(&w); } while (0)
  PK4(p0, 0, pa0); PK4(p0, 8, pa1); PK4(p1, 0, pa2); PK4(p1, 8, pa3);
#undef PK4
}
__device__ __forceinline__ void qkt(f32x16& p0, f32x16& p1, const char* Ks, const bf16x8* qr, int r32, int hi) {
  p0 = f32x16{}; p1 = f32x16{};
#pragma unroll
  for (int d0 = 0; d0 < 6; ++d0) { int cb = (d0 * 16 + hi * 8) * 2;
    bf16x8 b0 = *reinterpret_cast<const bf16x8*>(Ks + KSWZ(r32, cb));
    bf16x8 b1 = *reinterpret_cast<const bf16x8*>(Ks + KSWZ(32 + r32, cb));
    p0 = __builtin_amdgcn_mfma_f32_32x32x16_bf16(b0, qr[d0], p0, 0, 0, 0);
    p1 = __builtin_amdgcn_mfma_f32_32x32x16_bf16(b1, qr[d0], p1, 0, 0, 0); }
}
__device__ __forceinline__ int v_st(int k, int c) { const int kk = (k & ~0xC) | ((k & 4) << 1) | ((k & 8) >> 1); return ((kk >> 3) * 4 + (c >> 5)) * 512 + ((kk & 7) * 32 + (c & 31)) * 2; }
__device__ __forceinline__ int v_rd_base(int lane) { return ((lane & 3) << 3) | (((lane >> 2) & 3) << 6) | (((lane >> 4) & 1) << 5) | (((lane >> 5) & 1) << 8); }
constexpr int v_rd_off(int d0, int ks, int half) { return d0 * 512 + ks * 4096 + half * 2048; }
template <int OFF> __device__ __forceinline__ s16x4 tr_read(int vb) {
  s16x4 r; asm volatile("ds_read_b64_tr_b16 %0, %1 offset:%2" : "=&v"(r) : "v"(vb), "i"(OFF) : "memory"); return r;
}
template <int D0> __device__ __forceinline__ void pv_one(f32x16& od, int vb, bf16x8 pa0, bf16x8 pa1, bf16x8 pa2, bf16x8 pa3) {
  const s16x4 l0 = tr_read<v_rd_off(D0, 0, 0)>(vb), h0 = tr_read<v_rd_off(D0, 0, 1)>(vb), l1 = tr_read<v_rd_off(D0, 1, 0)>(vb), h1 = tr_read<v_rd_off(D0, 1, 1)>(vb);
  const s16x4 l2 = tr_read<v_rd_off(D0, 2, 0)>(vb), h2 = tr_read<v_rd_off(D0, 2, 1)>(vb), l3 = tr_read<v_rd_off(D0, 3, 0)>(vb), h3 = tr_read<v_rd_off(D0, 3, 1)>(vb);
  asm volatile("s_waitcnt lgkmcnt(0)" ::: "memory"); SBAR();
#define PK(L, H) (bf16x8){L[0], L[1], L[2], L[3], H[0], H[1], H[2], H[3]}
  od = __builtin_amdgcn_mfma_f32_32x32x16_bf16(pa0, PK(l0, h0), od, 0, 0, 0);
  od = __builtin_amdgcn_mfma_f32_32x32x16_bf16(pa1, PK(l1, h1), od, 0, 0, 0);
  od = __builtin_amdgcn_mfma_f32_32x32x16_bf16(pa2, PK(l2, h2), od, 0, 0, 0);
  od = __builtin_amdgcn_mfma_f32_32x32x16_bf16(pa3, PK(l3, h3), od, 0, 0, 0);
#undef PK
}
__device__ __forceinline__ void pv_d0(f32x16* o, int vb, bf16x8 pa0, bf16x8 pa1, bf16x8 pa2, bf16x8 pa3) {
  pv_one<0>(o[0], vb, pa0, pa1, pa2, pa3); pv_one<1>(o[1], vb, pa0, pa1, pa2, pa3);
}
__device__ __forceinline__ void attn_unit(const bf16_t* __restrict__ Qb, const bf16_t* __restrict__ KVh, const bf16_t* __restrict__ KRr, bf16_t* __restrict__ Ob, int seq, char* lds) {
  int tid_ = threadIdx.x; asm volatile("" : "+v"(tid_));
  const int tid = tid_, wid = tid >> 6, lane = tid & 63, r32 = lane & 31, hi = lane >> 5;
  char* V_lds = lds; char* K_lds = lds + 2 * SHM_V;
  float* ws = (float*)(lds + 2 * SHM_V + 2 * SHM_K) + wid * 64; float* li_l = ws; float* al_l = ws + 32;
  float m_reg = -1e30f, l_reg = 0; f32x16 o[2] = {}; bf16x8 qr[6];
  const bf16_t* Qw = Qb + (long)(wid * 32 + r32) * 768 + hi * 8;
#pragma unroll
  for (int d0 = 0; d0 < 6; ++d0) qr[d0] = *reinterpret_cast<const bf16x8*>(Qw + d0 * 16);
  const int sr = tid >> 4, sc = (tid & 15) * 8, vst0 = v_st(sr, sc & 63), vst1 = v_st(32 + sr, sc & 63);
  const bool kn = sc < 64, krp = (sc >= 64 && sc < 96);
  const int vb0 = (int)(uintptr_t)V_lds + v_rd_base(lane);
  struct { bf16x8 vs0, vs1, ks0, ks1; } sr_[2];
#define SLOAD(i, k0) do { if (kn) { sr_[i].vs0 = *reinterpret_cast<const bf16x8*>(&KVh[(long)((k0) + sr) * 1024 + 64 + sc]); sr_[i].vs1 = *reinterpret_cast<const bf16x8*>(&KVh[(long)((k0) + 32 + sr) * 1024 + 64 + sc]); \
      sr_[i].ks0 = *reinterpret_cast<const bf16x8*>(&KVh[(long)((k0) + sr) * 1024 + sc]); sr_[i].ks1 = *reinterpret_cast<const bf16x8*>(&KVh[(long)((k0) + 32 + sr) * 1024 + sc]); } \
    else if (krp) { sr_[i].ks0 = *reinterpret_cast<const bf16x8*>(&KRr[(long)((k0) + sr) * 32 + sc - 64]); sr_[i].ks1 = *reinterpret_cast<const bf16x8*>(&KRr[(long)((k0) + 32 + sr) * 32 + sc - 64]); } } while (0)
#define SWRITE(b, i) do { if (kn) { *(bf16x8*)(V_lds + (b) * SHM_V + vst0) = sr_[i].vs0; *(bf16x8*)(V_lds + (b) * SHM_V + vst1) = sr_[i].vs1; } \
    if (kn || krp) { int kc = sc * 2; *(bf16x8*)(K_lds + (b) * SHM_K + KSWZ(sr, kc)) = sr_[i].ks0; *(bf16x8*)(K_lds + (b) * SHM_K + KSWZ(32 + sr, kc)) = sr_[i].ks1; } } while (0)
#define RESC(a) do { if (__any((a) < 1.f)) { if (hi == 0) al_l[r32] = (a); asm volatile("s_waitcnt lgkmcnt(0)" ::: "memory"); \
    _Pragma("unroll") for (int d = 0; d < 2; ++d) _Pragma("unroll") for (int r = 0; r < 16; ++r) o[d][r] *= al_l[crow(r, hi)]; } } while (0)
  f32x16 pA0, pA1, pB0, pB1; float mnA, mnB, alA, alB; bf16x8 pa0, pa1, pa2, pa3; const int NT = seq / KVBLK;
  SLOAD(0, 0); SWRITE(0, 0); __syncthreads();
  qkt(pA0, pA1, K_lds, qr, r32, hi); partialSM(pA0, pA1, m_reg, mnA, alA);
  SLOAD(1, KVBLK); if (2 < NT) SLOAD(0, 2 * KVBLK);
  SWRITE(1, 1); __syncthreads();
  for (int j = 1; j + 1 < NT; j += 2) {
    SBAR(); qkt(pB0, pB1, K_lds + SHM_K, qr, r32, hi);
    finishSM(pA0, pA1, alA, l_reg, pa0, pa1, pa2, pa3); SBAR();
    SLOAD(1, (j + 2) * KVBLK); SBAR();
    pv_d0(o, vb0, pa0, pa1, pa2, pa3); partialSM(pB0, pB1, m_reg, mnB, alB);
    __syncthreads(); SWRITE(0, 0);
    RESC(alB); __syncthreads();
    SBAR(); qkt(pA0, pA1, K_lds, qr, r32, hi);
    finishSM(pB0, pB1, alB, l_reg, pa0, pa1, pa2, pa3); SBAR();
    if (j + 3 < NT) SLOAD(0, (j + 3) * KVBLK); SBAR();
    pv_d0(o, vb0 + SHM_V, pa0, pa1, pa2, pa3); partialSM(pA0, pA1, m_reg, mnA, alA);
    __syncthreads(); SWRITE(1, 1);
    RESC(alA); __syncthreads();
  }
  SBAR(); qkt(pB0, pB1, K_lds + SHM_K, qr, r32, hi);
  finishSM(pA0, pA1, alA, l_reg, pa0, pa1, pa2, pa3); SBAR();
  pv_d0(o, vb0, pa0, pa1, pa2, pa3); partialSM(pB0, pB1, m_reg, mnB, alB);
  __syncthreads(); RESC(alB);
  finishSM(pB0, pB1, alB, l_reg, pa0, pa1, pa2, pa3); SBAR();
  pv_d0(o, vb0 + SHM_V, pa0, pa1, pa2, pa3);
  if (hi == 0) li_l[r32] = l_reg; asm volatile("s_waitcnt lgkmcnt(0)" ::: "memory");
  float rli[16];
#pragma unroll
  for (int r = 0; r < 16; ++r) rli[r] = __builtin_amdgcn_rcpf(li_l[crow(r, hi)]);
  bf16_t* Ow = Ob + (long)(wid * 32) * 512;
#pragma unroll
  for (int r = 0; r < 16; ++r) { int orow = crow(r, hi);
#pragma unroll
    for (int d0 = 0; d0 < 2; ++d0) Ow[(long)orow * 512 + d0 * 32 + r32] = (bf16_t)f2bf(o[d0][r] * rli[r]); }
  __syncthreads();
#undef SLOAD
#undef SWRITE
#undef RESC
}
#undef KSWZ
#undef SBAR
}

struct Args { const float* in[29]; float* out; unsigned char* ws; int ph_lo, ph_hi, use_bar, pad; };
enum { I_XP = 0, I_XS, I_CCKV, I_CKR, I_C, I_CCTX, I_WADA, I_BADA, I_NORMG, I_WUP, I_WDN, I_WIN, I_HCW, I_HCB, I_FW1, I_FB1, I_FW2, I_FB2, I_FW3, I_SKIP,
       I_WHY, I_QNG, I_WQB, I_KVNG, I_WKVB, I_WMLA, I_WFN, I_WOUT, I_FING };

struct Frame {
    LAS unsigned char* lds; char* ldsg;
    int G, bid;
    unsigned char* ws;
};
#define WSP(T, off) ((T*)(F.ws + (off)))
#define TLW() int tid_ = threadIdx.x; asm volatile("" : "+v"(tid_)); const int tid = tid_, lane = tid & 63, wave = __builtin_amdgcn_readfirstlane(tid >> 6); (void)lane; (void)wave
__device__ __forceinline__ const float* argin(int i) { size_t off = (size_t)i * 8; asm volatile("" : "+s"(off)); const __attribute__((address_space(4))) char* k = (const __attribute__((address_space(4))) char*)__builtin_amdgcn_kernarg_segment_ptr(); return (const float*)(*(const GAS float* const __attribute__((address_space(4)))*)(k + off)); }
#define AIN(i) argin(i)

enum { CK_ID = 0, CK_UP, CK_IN, CK_QB };
__device__ __forceinline__ bf16_t* conv_dst(int kind, bf16_t* d0, bf16_t* d1, int ldd, int n) {
    if (kind == CK_ID) return d0 + (size_t)n * ldd;
    if (kind == CK_UP) { const int isU = n >= DFF, f = n - DFF * isU; const int R = (f >> 7) * 256 + ((f >> 6) & 1) * 128 + ((f >> 4) & 3) * 32 + 16 * isU + (f & 15); return d0 + (size_t)R * ldd; }
    if (kind == CK_IN) {
        if (n < 768) return d1 + (size_t)n * ldd;
        if (n < 1024) return d0 + (size_t)(n - 768) * ldd;
        if (n < 1152) return d0 + (size_t)(256 + n - 1024) * ldd;
        if (n < 1184) { const int p = n - 1152, part = p >> 4, w = p & 15, half = w >> 3, i = w & 7; return d0 + (size_t)(384 + part * 16 + 2 * i + half) * ldd; }
        if (n < 1440) return nullptr;
        return d0 + (size_t)(512 + n - 1440) * ldd;
    }
    { const int h = n / 96, w96 = n - h * 96; int d = w96;
      if (w96 >= 64) { const int p = w96 - 64, part = p >> 4, w = p & 15, half = w >> 3, i = w & 7; d = 64 + part * 16 + 2 * i + half; }
      return d0 + (size_t)(h * 96 + d) * ldd; }
}
__device__ __forceinline__ void conv_item(const float* W, int ldw, int ncols, int k0, int n0, int kind, bf16_t* d0, bf16_t* d1, int ldd, const float* kscale, bf16_t* dextra, LAS float* scr, int lane) {
    const int lr = lane >> 4, lc = (lane & 15) * 4;
    const bool cok = (n0 + lc) < ncols;
    f32x4 v[16];
#pragma unroll
    for (int i = 0; i < 16; ++i) v[i] = cok ? *(const f32x4*)(W + (size_t)(k0 + i * 4 + lr) * ldw + n0 + lc) : (f32x4){0.f, 0.f, 0.f, 0.f};
#pragma unroll
    for (int i = 0; i < 16; ++i) *(LAS f32x4*)(scr + (i * 4 + lr) * 68 + lc) = v[i];
    asm volatile("s_waitcnt lgkmcnt(0)" ::: "memory");
    const int n = n0 + lane;
    bf16_t* dp = (n < ncols) ? conv_dst(kind, d0, d1, ldd, n) : nullptr;
#pragma unroll
    for (int c = 0; c < 8; ++c) {
        float x[8];
#pragma unroll
        for (int e2 = 0; e2 < 8; ++e2) x[e2] = scr[(8 * c + e2) * 68 + lane];
        if (dp) {
            if (dextra) { u32x4 r; r.x = cvtpk(x[0], x[1]); r.y = cvtpk(x[2], x[3]); r.z = cvtpk(x[4], x[5]); r.w = cvtpk(x[6], x[7]); *(u32x4*)(dextra + (size_t)n * ldd + k0 + 8 * c) = r; }
            if (kscale) {
#pragma unroll
                for (int e2 = 0; e2 < 8; ++e2) x[e2] *= kscale[k0 + 8 * c + e2]; }
            u32x4 o; o.x = cvtpk(x[0], x[1]); o.y = cvtpk(x[2], x[3]); o.z = cvtpk(x[4], x[5]); o.w = cvtpk(x[6], x[7]);
            *(u32x4*)(dp + k0 + 8 * c) = o; }
    }
    asm volatile("s_waitcnt lgkmcnt(0)" ::: "memory");
}

__device__ __forceinline__ void p0_phase(Frame& F, const Args& A) {
    TLW();
    LAS float* scr = (LAS float*)(F.lds + wave * 17408);
    const int gw = F.bid * NWAVES + wave, NGW = F.G * NWAVES;
    const int gt = F.bid * NTHR + tid, NGT = F.G * NTHR;
    {
        constexpr int I_UP = 16 * 88, I_DN = 44 * 16, I_IN = 16 * 71, I_QB = 4 * 12, I_KVB = 2 * 16, I_HY = 4 * 16, I_MLA = 8 * 16, I_FN = 4 * 16, I_OUT = 16 * 16;
        constexpr int PER_L = 2 * I_UP + 2 * I_DN + I_IN + I_QB + I_KVB + I_HY + I_MLA + I_FN + I_OUT;
        for (int it = gw; it < 2 * PER_L; it += NGW) {
            const int l = it / PER_L; int r = it - l * PER_L;
            if (r < 2 * I_UP) { const int f = r / I_UP; r -= f * I_UP; const int nb = 88, kb = r / nb, n_ = r % nb;
                conv_item(AIN(I_WUP) + (size_t)(l * 2 + f) * DM * NUP, NUP, NUP, kb * 64, n_ * 64, CK_UP, WSP(bf16_t, WS_WUP) + (size_t)(l * 2 + f) * NUP * DM, nullptr, DM, nullptr, nullptr, scr, lane); continue; }
            r -= 2 * I_UP;
            if (r < 2 * I_DN) { const int f = r / I_DN; r -= f * I_DN; const int nb = 16, kb = r / nb, n_ = r % nb;
                conv_item(AIN(I_WDN) + (size_t)(l * 2 + f) * DFF * DM, DM, DM, kb * 64, n_ * 64, CK_ID, WSP(bf16_t, WS_WDN) + (size_t)(l * 2 + f) * DM * DFF, nullptr, DFF, nullptr, nullptr, scr, lane); continue; }
            r -= 2 * I_DN;
            if (r < I_IN) { const int nb = 71, kb = r / nb, n_ = r % nb;
                conv_item(AIN(I_WIN) + (size_t)l * DM * INC, INC, INC, kb * 64, n_ * 64, CK_IN, WSP(bf16_t, WS_W1T) + (size_t)l * N1 * DM, WSP(bf16_t, WS_W2T) + (size_t)l * N2 * DM, DM, nullptr, nullptr, scr, lane); continue; }
            r -= I_IN;
            if (r < I_QB) { const int nb = 12, kb = r / nb, n_ = r % nb;
                conv_item(AIN(I_WQB) + (size_t)l * 256 * 768, 768, 768, kb * 64, n_ * 64, CK_QB, WSP(bf16_t, WS_WQB) + (size_t)l * 768 * 256, nullptr, 256, AIN(I_QNG) + l * 256, nullptr, scr, lane); continue; }
            r -= I_QB;
            if (r < I_KVB) { const int nb = 16, kb = r / nb, n_ = r % nb;
                conv_item(AIN(I_WKVB) + (size_t)l * 128 * 1024, 1024, 1024, kb * 64, n_ * 64, CK_ID, WSP(bf16_t, WS_WKVB) + (size_t)l * 1024 * 256, nullptr, 256, AIN(I_KVNG) + l * 128, WSP(bf16_t, WS_WKVR) + (size_t)l * 1024 * 256, scr, lane); continue; }
            r -= I_KVB;
            if (r < I_HY) { const int nb = 16, kb = r / nb, n_ = r % nb;
                conv_item(AIN(I_WHY) + (size_t)l * 256 * 1024, 1024, 1024, kb * 64, n_ * 64, CK_ID, WSP(bf16_t, WS_WHY) + (size_t)l * 1024 * 256, nullptr, 256, nullptr, nullptr, scr, lane); continue; }
            r -= I_HY;
            if (r < I_MLA) { const int nb = 16, kb = r / nb, n_ = r % nb;
                conv_item(AIN(I_WMLA) + (size_t)l * 512 * 1024, 1024, 1024, kb * 64, n_ * 64, CK_ID, WSP(bf16_t, WS_WMLA) + (size_t)l * 1024 * 512, nullptr, 512, nullptr, nullptr, scr, lane); continue; }
            r -= I_MLA;
            if (r < I_FN) { const int nb = 16, kb = r / nb, n_ = r % nb;
                conv_item(AIN(I_WFN) + (size_t)l * 256 * 1024, 1024, 1024, kb * 64, n_ * 64, CK_ID, WSP(bf16_t, WS_WFN) + (size_t)l * 1024 * 256, nullptr, 256, nullptr, nullptr, scr, lane); continue; }
            r -= I_FN;
            { const int nb = 16, kb = r / nb, n_ = r % nb;
                conv_item(AIN(I_WOUT) + (size_t)l * 1024 * 1024, 1024, 1024, kb * 64, n_ * 64, CK_ID, WSP(bf16_t, WS_WOUT) + (size_t)l * 1024 * 1024, nullptr, 1024, nullptr, nullptr, scr, lane); }
        }
    }
    __syncthreads();
    LAS float* scv = (LAS float*)(F.lds);
    LAS float* ctab = (LAS float*)(F.lds + 16384);
    for (int i = tid; i < 3 * DM; i += NTHR) { const int g = i >> 10, k = i & 1023; const float c = (g == 0) ? AIN(I_CCTX)[k] : AIN(I_C)[(g - 1) * DM + k]; scv[i] = siluf_(c); }
    for (int i = tid; i < 2048; i += NTHR) ctab[i] = cospif((float)i * (1.0f / 1024.0f));
    __syncthreads();
    for (int it = gw; it < 2 * 4 * 16 * 4; it += NGW) {
        const int mq = it & 3, kc = (it >> 2) & 15, g = (it >> 6) & 3, l = it >> 8; const int k = kc * 64 + lane;
        const float* src = AIN(I_WIN) + (size_t)l * DM * INC + (size_t)k * INC + 1184 + g * 64;
        float x[64];
#pragma unroll
        for (int j = 0; j < 16; ++j) { const f32x4 v = *(const f32x4*)(src + 4 * j); x[4 * j] = v[0]; x[4 * j + 1] = v[1]; x[4 * j + 2] = v[2]; x[4 * j + 3] = v[3]; }
        bf16_t* dst = WSP(bf16_t, WS_W2T) + (size_t)l * N2 * DM;
        for (int mm = 0; mm < 16; ++mm) { const int m = mq * 16 + mm; float sc_ = 0.f, ss_ = 0.f;
#pragma unroll
            for (int j = 0; j < 64; ++j) { const int ph = (j * m) & 63; sc_ += x[j] * ctab[ph * 32]; ss_ += x[j] * ctab[((ph + 48) & 63) * 32]; }
            dst[(size_t)(768 + g * 64 + m) * DM + k] = (bf16_t)f2bf(sc_); dst[(size_t)(1024 + g * 64 + m) * DM + k] = (bf16_t)f2bf(ss_); }
    }
    for (int it = gw; it < 2 * 16 * 36; it += NGW) {
        const int cc = it % 36, kc = (it / 36) & 15, l = it / (36 * 16);
        const float* wp = AIN(I_WADA) + (size_t)l * DM * NADA + (size_t)(kc * 64) * NADA + cc * 256 + lane * 4;
        f32x4 a0 = {0, 0, 0, 0}, a1 = a0, a2 = a0;
#pragma unroll 8
        for (int k = 0; k < 64; ++k) { const f32x4 w = *(const f32x4*)(wp + (size_t)k * NADA); const int kk = kc * 64 + k; a0 += w * scv[kk]; a1 += w * scv[1024 + kk]; a2 += w * scv[2048 + kk]; }
        float* op = WSP(float, WS_ADAP) + ((size_t)(kc * 2 + l) * 3) * NADA + cc * 256 + lane * 4;
        *(f32x4*)op = a0; *(f32x4*)(op + NADA) = a1; *(f32x4*)(op + 2 * NADA) = a2;
    }
    for (int it = gw; it < 2 * 288; it += NGW) {
        const int l = it / 288, r0 = (it % 288) * 8;
        const float* W1 = AIN(I_FW1) + l * 17 * 64; const float* W2 = AIN(I_FW2) + l * 64 * 64;
        float w1c[17], w2c[64];
#pragma unroll
        for (int i = 0; i < 17; ++i) w1c[i] = W1[i * 64 + lane];
#pragma unroll
        for (int k = 0; k < 64; ++k) w2c[k] = W2[k * 64 + lane];
        const float b1 = AIN(I_FB1)[l * 64 + lane], b2 = AIN(I_FB2)[l * 64 + lane];
        for (int rr = 0; rr < 8; ++rr) { const int row = r0 + rr; const int L = row < 256 ? 256 : 2048, t = row < 256 ? row : row - 256;
            float feat = 0.f;
            { const float tn = (float)t / (float)(L - 1), w = 6.283185307179586f * (float)t / (float)L;
              const int bi = (lane >= 9) ? lane - 9 : lane - 1; const float band = 1e-4f + (float)bi * ((7.0f - 1e-4f) / 7.0f); const float ang = w * band;
              feat = (lane == 0) ? tn : ((lane <= 8) ? cosf(ang) : -sinf(ang)); }
            float h1 = b1;
#pragma unroll
            for (int i = 0; i < 17; ++i) h1 += __builtin_bit_cast(float, __builtin_amdgcn_readlane(__builtin_bit_cast(int, feat), i)) * w1c[i];
            h1 = sinf(h1);
            float h2 = b2;
#pragma unroll
            for (int k = 0; k < 64; ++k) h2 += __builtin_bit_cast(float, __builtin_amdgcn_readlane(__builtin_bit_cast(int, h1), k)) * w2c[k];
            h2 = sinf(h2);
            WSP(float, WS_H2)[((size_t)l * 2304 + row) * 64 + lane] = h2; }
    }
    if (F.bid == 0) { const int pos = tid >> 3, i = tid & 7; const float inv = exp2f(-(float)i * (13.287712379549449f / 8.0f)); float s, c; sincosf((float)pos * inv, &s, &c);
        WSP(float, WS_ROPE)[(pos * 8 + i) * 2] = c; WSP(float, WS_ROPE)[(pos * 8 + i) * 2 + 1] = s; }
    for (int it = gt; it < 2048 * 512 + 256 * 64; it += NGT) {
        const bool isl = it < 2048 * 512; const int L = isl ? 2048 : 256, j = isl ? it : it - 2048 * 512, per = 2 * L / 8, k = j / per, t8 = (j % per) * 8, sh = isl ? 0 : 3;
        float v[8];
#pragma unroll
        for (int e = 0; e < 8; ++e) { const int tt = t8 + e, isS = tt >= L, t = tt - isS * L; const int ph = (k * t) & (L - 1);
            v[e] = isS ? -ctab[(((ph - L / 4) & (L - 1)) << sh)] : ctab[ph << sh]; }
        u32x4 o; o.x = pk2(v[0], v[1]); o.y = pk2(v[2], v[3]); o.z = pk2(v[4], v[5]); o.w = pk2(v[6], v[7]);
        *(u32x4*)((isl ? WSP(bf16_t, WS_DFTL) : WSP(bf16_t, WS_DFTC)) + (size_t)k * 2 * L + t8) = o;
    }
    for (int it = gt; it < 2 * 1024 * 32; it += NGT) { const int c8 = (it & 31) * 8, row = (it >> 5) & 1023, l = it >> 15; const int b = row >> 9, j = row & 511;
        u32x4 o = {0, 0, 0, 0};
        if (c8 < 128) { const float* sp = AIN(I_CCKV) + ((size_t)((b * 2 + l) * 512 + j)) * 128 + c8; const f32x4 x = *(const f32x4*)sp, y = *(const f32x4*)(sp + 4);
            o.x = pk2(x[0], x[1]); o.y = pk2(x[2], x[3]); o.z = pk2(y[0], y[1]); o.w = pk2(y[2], y[3]); }
        *(u32x4*)(WSP(bf16_t, WS_CKVB) + ((size_t)l * 1024 + row) * 256 + c8) = o; }
    for (int it = gt; it < 2 * 96 * 128; it += NGT) { const int c8 = (it & 127) * 8, r = (it >> 7) % 96, l = it / (96 * 128);
        *(u32x4*)(WSP(bf16_t, WS_W1T) + ((size_t)l * N1 + 416 + r) * DM + c8) = (u32x4){0, 0, 0, 0}; }
    for (int it = gt; it < 2 * 2 * 1024 * 16; it += NGT) { const int c8 = 128 + (it & 15) * 8, r = (it >> 4) & 1023, l = (it >> 14) & 1, wsel = it >> 15;
        *(u32x4*)((wsel ? WSP(bf16_t, WS_WKVR) : WSP(bf16_t, WS_WKVB)) + ((size_t)l * 1024 + r) * 256 + c8) = (u32x4){0, 0, 0, 0}; }
    __syncthreads();
}

__device__ __forceinline__ void norm_phase(Frame& F, const Args& A, int l, int which, bool first, bool from_partials) {
    TLW();
    LAS float* gm = (LAS float*)(F.lds);
    LAS float* sv = (LAS float*)(F.lds + 12288);
    for (int i = tid; i < 3 * DM; i += NTHR) { const int g = i >> 10, c = i & 1023; float s, sc;
        if (from_partials) { s = AIN(I_BADA)[l * NADA + (3 * which) * DM + c]; sc = AIN(I_BADA)[l * NADA + (3 * which + 1) * DM + c];
            for (int kc = 0; kc < 16; ++kc) { const float* pp = WSP(float, WS_ADAP) + ((size_t)(kc * 2 + l) * 3 + g) * NADA; s += pp[(3 * which) * DM + c]; sc += pp[(3 * which + 1) * DM + c]; } }
        else { const float* ad = WSP(float, WS_ADA) + ((size_t)l * 3 + g) * NADA; s = ad[(3 * which) * DM + c]; sc = ad[(3 * which + 1) * DM + c]; }
        gm[i] = AIN(I_NORMG)[(l * 3 + which) * DM + c] * (1.0f + sc); sv[i] = s; }
    __syncthreads();
    const int gw = F.bid * NWAVES + wave, NGW = F.G * NWAVES;
    for (int r = gw; r < MTOK; r += NGW) {
        const float* src = first ? (r < NCTX ? AIN(I_XP) + (size_t)r * DM : AIN(I_XS) + (size_t)(r - NCTX) * DM) : WSP(float, WS_H) + (size_t)r * DM;
        const int g = r < NCTX ? 0 : 1 + ((r - NCTX) >> 11);
        f32x4 v[4]; float s = 0.f;
#pragma unroll
        for (int j = 0; j < 4; ++j) { v[j] = *(const f32x4*)(src + 4 * lane + 256 * j); s += (v[j][0] * v[j][0] + v[j][1] * v[j][1]) + (v[j][2] * v[j][2] + v[j][3] * v[j][3]); }
        const float rstd = 1.0f / sqrtf(wave_sum(s) * (1.0f / DM) + EPSV);
        bf16_t* np = WSP(bf16_t, WS_N) + (size_t)r * DM;
#pragma unroll
        for (int j = 0; j < 4; ++j) { const int c = 4 * lane + 256 * j; const f32x4 gg = *(const LAS f32x4*)(gm + g * DM + c), ss = *(const LAS f32x4*)(sv + g * DM + c);
            const f32x4 y = v[j] * rstd * gg + ss; u32x2 w; w.x = cvtpk(y[0], y[1]); w.y = cvtpk(y[2], y[3]); *(u32x2*)(np + c) = w;
            if (first) *(f32x4*)(WSP(float, WS_H) + (size_t)r * DM + c) = v[j]; }
    }
    __syncthreads();
}
__device__ __forceinline__ void final_norm_phase(Frame& F, const Args& A) {
    TLW();
    const int gw = F.bid * NWAVES + wave, NGW = F.G * NWAVES;
    for (int r = gw; r < MTOK; r += NGW) {
        const float* src = WSP(float, WS_H) + (size_t)r * DM;
        f32x4 v[4]; float s = 0.f;
#pragma unroll
        for (int j = 0; j < 4; ++j) { v[j] = *(const f32x4*)(src + 4 * lane + 256 * j); s += (v[j][0] * v[j][0] + v[j][1] * v[j][1]) + (v[j][2] * v[j][2] + v[j][3] * v[j][3]); }
        const float rstd = 1.0f / sqrtf(wave_sum(s) * (1.0f / DM) + EPSV);
#pragma unroll
        for (int j = 0; j < 4; ++j) { const int c = 4 * lane + 256 * j; const f32x4 gg = *(const f32x4*)(AIN(I_FING) + c); *(f32x4*)(A.out + (size_t)r * DM + c) = v[j] * rstd * gg; }
    }
}

__device__ __forceinline__ void p0b_phase(Frame& F, const Args& A) {
    TLW();
    const int gt = F.bid * NTHR + tid, NGT = F.G * NTHR, gw = F.bid * NWAVES + wave, NGW = F.G * NWAVES;
    for (int it = gt; it < 2 * 3 * NADA; it += NGT) { const int c = it % NADA, g = (it / NADA) % 3, l = it / (3 * NADA); float s = AIN(I_BADA)[l * NADA + c];
        for (int kc = 0; kc < 16; ++kc) s += WSP(float, WS_ADAP)[((size_t)(kc * 2 + l) * 3 + g) * NADA + c];
        WSP(float, WS_ADA)[((size_t)l * 3 + g) * NADA + c] = s; }
    LAS float* tl = (LAS float*)(F.lds + wave * 16384);
    for (int it = gw; it < 2 * 36 * 16; it += NGW) {
        const int cc = it & 15, rc = (it >> 4) % 36, l = it / (36 * 16); const int L = rc < 4 ? 256 : 2048, t0 = rc < 4 ? rc * 64 : rc * 64 - 256;
        const float* W3 = AIN(I_FW3) + (size_t)l * 64 * 1024 + cc * 64 + lane;
        float w[64];
#pragma unroll
        for (int k = 0; k < 64; ++k) w[k] = W3[k * 1024];
        const float* hp = WSP(float, WS_H2) + ((size_t)l * 2304 + rc * 64) * 64;
#pragma unroll 2
        for (int tt = 0; tt < 64; ++tt) { float s = 0.f;
#pragma unroll
            for (int k = 0; k < 64; ++k) s += hp[tt * 64 + k] * w[k];
            tl[tt * 64 + (lane ^ tt)] = s; }
        asm volatile("s_waitcnt lgkmcnt(0)" ::: "memory");
        const int t = t0 + lane; const float tn = (float)t / (float)(L - 1);
        float* fb = WSP(float, WS_FILT) + (size_t)l * FILT_LAYER + (rc < 4 ? (size_t)512 * 4096 : 0);
        for (int ci = 0; ci < 64; ++ci) { const int col = cc * 64 + ci, ch = col & 255, oc = col & 511, dir = col >> 9;
            const float delta = -3.0701134573253944f + (float)ch * ((-15.350567286626972f + 3.0701134573253944f) / 255.0f);
            const float s = tl[lane * 64 + (ci ^ lane)] * expf(-tn * fabsf(delta));
            float* fr = fb + (size_t)oc * (2 * L);
            if (dir == 0) fr[L + t] = s; else if (t > 0) fr[L - t] = s; else fr[0] = 0.f; }
        asm volatile("s_waitcnt lgkmcnt(0)" ::: "memory");
    }
}

constexpr int HY_HCS = 8176;
constexpr int HY_HC = 0, HY_HV = 8 * HY_HCS, HY_HZ = HY_HV + 16320, HY_X1 = HY_HZ + 16320, HY_X2 = HY_X1 + 8192, HY_ST = HY_X2 + 8192, HY_TB = HY_ST + 32768, HY_END = HY_TB + 8192;
static_assert(HY_END <= MISC_OFF, "hyena LDS map");
struct HyPre { u32x4 raw[3]; float xm[3], xp[3]; f32x4 ta, tb; };
__device__ __forceinline__ void hyena_unit(Frame& F, const Args& A, int l, int unit) {
    TLW();
    const bool lat = unit < 64; const int c0 = (lat ? unit : unit - 64) * 4;
    const int L = lat ? 2048 : 256, tokbase = lat ? NCTX : 0, NQ = lat ? 512 : 64;
    LAS unsigned char* lds = F.lds;
    volatile LAS float* red = (volatile LAS float*)(lds + MISC_OFF + 64);
    const bf16_t* hyt = WSP(bf16_t, WS_HYT);
    const float* filt = WSP(float, WS_FILT) + (size_t)l * FILT_LAYER + (lat ? 0 : (size_t)512 * 4096);
    const int ntap = 2 * L;
    for (int i = tid; i < (2 * 16320) / 16; i += NTHR) *(LAS u32x4*)(lds + HY_HV + i * 16) = (u32x4){0, 0, 0, 0};
    const int rho = wave, rp = lane & 15, g4 = lane >> 4;
    LAS unsigned char* HCw = lds + HY_HC + wave * HY_HCS - 16;
    const int idx8 = tid * 8, pos8 = idx8 & (L - 1), b8 = idx8 / L;
    u32x4 raw0, raw1, raw2; float xm0, xm1, xm2, xp0, xp1, xp2; f32x4 ta, tb;
#define HY_LOADHY(cc) do { const bf16_t* h0_ = hyt + (size_t)(512 + (cc)) * MTOK + tokbase + idx8; const bf16_t* h1_ = hyt + (size_t)(cc) * MTOK + tokbase + idx8; const bf16_t* h2_ = hyt + (size_t)(256 + (cc)) * MTOK + tokbase + idx8; \
        raw0 = *(const u32x4*)h0_; raw1 = *(const u32x4*)h1_; raw2 = *(const u32x4*)h2_; \
        xm0 = pos8 > 0 ? bf2f(h0_[-1]) : 0.f; xm1 = pos8 > 0 ? bf2f(h1_[-1]) : 0.f; xm2 = pos8 > 0 ? bf2f(h2_[-1]) : 0.f; \
        xp0 = (pos8 + 8 < L) ? bf2f(h0_[8]) : 0.f; xp1 = (pos8 + 8 < L) ? bf2f(h1_[8]) : 0.f; xp2 = (pos8 + 8 < L) ? bf2f(h2_[8]) : 0.f; } while (0)
#define HY_LOADTAPS(oo, cc) do { if (idx8 < ntap) { const float* fp_ = filt + (size_t)((oo) * 256 + (cc)) * ntap + idx8; ta = *(const f32x4*)fp_; tb = *(const f32x4*)(fp_ + 4); } else { ta = (f32x4){0.f, 0.f, 0.f, 0.f}; tb = ta; } } while (0)
#define HY_PUTTAPS(oo) do { const float as_ = (fabsf(ta[0]) + fabsf(ta[1])) + (fabsf(ta[2]) + fabsf(ta[3])) + (fabsf(tb[0]) + fabsf(tb[1])) + (fabsf(tb[2]) + fabsf(tb[3])); \
        const float ws_ = wave_sum(as_); if (lane == 0) red[(oo) * 8 + wave] = ws_; \
        if (idx8 < ntap) *(LAS u32x4*)(lds + HY_TB + idx8 * 2) = pack8(ta, tb); } while (0)
#define HY_CONV(raw, xm_, xp_, chn, dstoff, isimg) do { const float* cw_ = AIN(I_HCW) + (size_t)l * 3 * 768 + (chn); const float w0_ = cw_[0], w1_ = cw_[768], w2_ = cw_[1536], bb_ = AIN(I_HCB)[l * 768 + (chn)]; \
        float x_[10]; x_[0] = xm_; x_[1] = bflo(raw.x); x_[2] = bfhi(raw.x); x_[3] = bflo(raw.y); x_[4] = bfhi(raw.y); x_[5] = bflo(raw.z); x_[6] = bfhi(raw.z); x_[7] = bflo(raw.w); x_[8] = bfhi(raw.w); x_[9] = xp_; \
        float u_[8]; _Pragma("unroll") for (int e = 0; e < 8; ++e) u_[e] = x_[e] * w0_ + x_[e + 1] * w1_ + x_[e + 2] * w2_ + bb_; \
        u32x4 o_; o_.x = cvtpk(u_[0], u_[1]); o_.y = cvtpk(u_[2], u_[3]); o_.z = cvtpk(u_[4], u_[5]); o_.w = cvtpk(u_[6], u_[7]); \
        if (isimg) { const int J_ = pos8 >> 7, slot_ = lat ? b8 * 30 + 7 + J_ : b8 * 2 + J_; *(LAS u32x4*)(lds + (dstoff) + slot_ * 272 + (pos8 & 127) * 2) = o_; } \
        else *(LAS u32x4*)(lds + (dstoff) + idx8 * 2) = o_; } while (0)
    HY_LOADHY(c0); HY_LOADTAPS(0, c0);
    __syncthreads();
#pragma unroll 1
    for (int ci = 0; ci < 4; ++ci) {
        const int c = c0 + ci;
        HY_CONV(raw0, xm0, xp0, 512 + c, HY_HV, true); HY_CONV(raw1, xm1, xp1, c, HY_X1, false); HY_CONV(raw2, xm2, xp2, 256 + c, HY_X2, false);
        HY_PUTTAPS(0);
        __syncthreads();
#pragma unroll 1
        for (int ord = 0; ord < 2; ++ord) {
            for (int qi = lane; qi < NQ; qi += 64) { if (qi == 0) continue; const int base = 8 * (qi - NQ / 2) + rho + L; unsigned short tp[8];
#pragma unroll
                for (int j = 0; j < 8; ++j) { const int ti = base - j; tp[j] = (ti >= 0 && ti < ntap) ? *(const LAS bf16_t*)(lds + HY_TB + ti * 2) : (unsigned short)0; }
                u32x4 o; o.x = tp[0] | ((unsigned)tp[1] << 16); o.y = tp[2] | ((unsigned)tp[3] << 16); o.z = tp[4] | ((unsigned)tp[5] << 16); o.w = tp[6] | ((unsigned)tp[7] << 16);
                *(LAS u32x4*)(HCw + qi * 16) = o; }
            float nsum = 0.f;
#pragma unroll
            for (int w = 0; w < 8; ++w) nsum += red[ord * 8 + w];
            const float inv = 1.0f / (nsum + EPSV);
            if (ord == 0) HY_LOADTAPS(1, c);
            else if (ci < 3) { HY_LOADHY(c + 1); HY_LOADTAPS(0, c + 1); }
            asm volatile("s_waitcnt lgkmcnt(0)" ::: "memory");
            const LAS unsigned char* Ub = lds + (ord == 0 ? HY_HV : HY_HZ) + 16 * g4;
            const int slot0 = lat ? (rp & 1) * 30 + 7 + (rp >> 1) : rp * 2, slot1 = lat ? slot0 + 8 : slot0 + 1;
            const int dmin = lat ? -15 : -1, dmax = lat ? 15 : 1, hi0 = lat ? 7 : 0, lo1 = lat ? -7 : 0;
            f32x4 acc0 = {0.f, 0.f, 0.f, 0.f}, acc1 = {0.f, 0.f, 0.f, 0.f};
            const LAS unsigned char* ap = HCw + (NQ / 2 + rp - g4 + 16 * dmin) * 16;
            const LAS unsigned char* bp0 = Ub + (slot0 - dmin) * 272; const LAS unsigned char* bp1 = Ub + (slot1 - dmin) * 272;
#pragma unroll 1
            for (int d = dmin; d <= dmax; ++d, ap += 256, bp0 -= 272, bp1 -= 272) {
                const bool u0 = d <= hi0, u1 = d >= lo1;
#pragma unroll
                for (int s = 0; s < 4; ++s) {
                    const bf16x8 af = *(const LAS bf16x8*)(ap - 64 * s);
                    if (u0) { const bf16x8 bf = *(const LAS bf16x8*)(bp0 + 64 * s); acc0 = __builtin_amdgcn_mfma_f32_16x16x32_bf16(af, bf, acc0, 0, 0, 0); }
                    if (u1) { const bf16x8 bf = *(const LAS bf16x8*)(bp1 + 64 * s); acc1 = __builtin_amdgcn_mfma_f32_16x16x32_bf16(af, bf, acc1, 0, 0, 0); }
                }
            }
            const float sk = AIN(I_SKIP)[(l * 2 + ord) * 256 + c];
#pragma unroll
            for (int t = 0; t < 2; ++t)
#pragma unroll
                for (int reg = 0; reg < 4; ++reg) {
                    const int a = 32 * g4 + 8 * reg + rho;
                    const int I = lat ? 8 * t + (rp >> 1) : t, b = lat ? (rp & 1) : rp;
                    const int idx = lat ? b * 2048 + 128 * I + a : b * 256 + 128 * I + a, slot = lat ? b * 30 + 7 + I : b * 2 + I;
                    const int la = slot * 272 + a * 2;
                    const float y = (t == 0 ? acc0[reg] : acc1[reg]) * inv;
                    if (ord == 0) { const float v = bf2f(*(const LAS bf16_t*)(lds + HY_HV + la)), x = bf2f(*(const LAS bf16_t*)(lds + HY_X1 + idx * 2));
                        *(LAS bf16_t*)(lds + HY_HZ + la) = (bf16_t)f2bf(x * (y + sk * v)); }
                    else { const float v = bf2f(*(const LAS bf16_t*)(lds + HY_HZ + la)), x = bf2f(*(const LAS bf16_t*)(lds + HY_X2 + idx * 2));
                        *(LAS bf16_t*)(lds + HY_ST + (idx * 4 + ci) * 2) = (bf16_t)f2bf(x * (y + sk * v)); }
                }
            __syncthreads();
            if (ord == 0) { HY_PUTTAPS(1); __syncthreads(); }
        }
    }
    for (int i = tid; i < 4096; i += NTHR) *(u32x2*)(WSP(bf16_t, WS_Z) + (size_t)(tokbase + i) * 256 + c0) = *(const LAS u32x2*)(lds + HY_ST + i * 8);
    __syncthreads();
#undef HY_LOADHY
#undef HY_LOADTAPS
#undef HY_PUTTAPS
#undef HY_CONV
}

constexpr int ST_PER_LAYER = 21, N_STEPS = 3 + 2 * ST_PER_LAYER;
#ifndef MK_ONE_LAUNCH
#define MK_ONE_LAUNCH 1
#endif
#ifndef PHSEL
#define PHSEL -1
#endif
#define PSEL(k) (PHSEL < 0 || PHSEL == (k))
#ifndef PROBE_REP
#define PROBE_REP 0
#endif
__host__ __device__ constexpr bool bar_after(int st) {
    if (st < 3) return st != 1;
    const int s = (st - 3) % ST_PER_LAYER;
    return !(s == 3 || s == 5 || s == 6 || s == 7 || s == 9 || s == 10 || s == 11 || s == 13 || s == 14);
}

template <class Epi> __device__ __forceinline__ void run_gemm(Frame& F, const bf16_t* Ap, int lda, const bf16_t* Bp, int ldb, int M, int N, int K, int cshift, const Epi& E) {
    pg8::Gemm g{Ap, Bp, M, N, K, lda, ldb}; pg8::StaticOrder S; S.init(M, N, F.G, (F.bid + F.G - cshift) % F.G);
    pg8::gemm_phase<Epi, pg8::StaticOrder, true, true>(F.lds, g, S, E);
}

__global__ void __launch_bounds__(NTHR, 2) mk_fwd(Args args) {
    extern __shared__ __attribute__((aligned(16))) unsigned char lds[];
    Frame F;
    F.lds = (LAS unsigned char*)lds; F.ldsg = (char*)lds;
    F.G = gridDim.x; F.bid = blockIdx.x;
    volatile LAS unsigned* MISC = (volatile LAS unsigned*)(F.lds + MISC_OFF);
    if (threadIdx.x < 64) ((LAS unsigned*)(F.lds + MISC_OFF))[threadIdx.x] = 0u;
    __syncthreads();
    const int lo = args.ph_lo, hi = args.ph_hi;
    XcdBarrier bar; bar.bar = (unsigned*)(args.ws + WS_CTL) + CW_BAR; bar.x = 0; bar.st = nullptr;
    if (args.use_bar) bar = xcd_barrier_post((unsigned*)(args.ws + WS_CTL) + CW_BAR, MISC + 8);
    const Args& A = args;

#pragma unroll 1
    for (int st = lo; st < hi; ++st) {
        { size_t z_ = 0; asm volatile("" : "+s"(z_)); F.ws = args.ws + z_; }
        int nrep = 1;
        if (PROBE_REP) { const int s_ = st < 3 ? -1 : (st - 3) % ST_PER_LAYER;
            if ((PROBE_REP & 1) && (s_ == 0 || s_ == 18)) nrep = 2;
            if ((PROBE_REP & 2) && (s_ == 1 || s_ == 19)) nrep = 2;
            if ((PROBE_REP & 4) && (s_ == 3 || s_ == 4)) nrep = 2;
            if ((PROBE_REP & 8) && s_ == 11) nrep = 2;
            if ((PROBE_REP & 16) && s_ == 12) nrep = 2;
            if ((PROBE_REP & 32) && (s_ == 9 || s_ == 10)) nrep = 2;
            if ((PROBE_REP & 64) && st == 0) nrep = 2;
            if ((PROBE_REP & 128) && (st == 2 || s_ == 2 || s_ == 17 || s_ == 20)) nrep = 2;
            if ((PROBE_REP & 512) && (s_ >= 5 && s_ <= 8)) nrep = 2;
            if ((PROBE_REP & 1024) && s_ == 16) nrep = 2;
            if ((PROBE_REP & 2048) && st == 1) nrep = 2;
            if ((PROBE_REP & 4096) && (s_ == 13 || s_ == 14 || s_ == 15)) nrep = 2; }
#pragma unroll 1
        for (int rep = 0; rep < nrep; ++rep) {
        const float gsm = (rep + 1 < nrep) ? 0.0f : 1.0f;
        if (st == 0) { if (PSEL(100)) p0_phase(F, A); }
        else if (st == 1) { if (PSEL(101)) p0b_phase(F, A); }
        else if (st == 2) { if (PSEL(102)) norm_phase(F, A, 0, 0, true, true); }
        else {
            const int l = (st - 3) / ST_PER_LAYER, s = (st - 3) % ST_PER_LAYER;
            const float* ada = WSP(float, WS_ADA) + (size_t)l * 3 * NADA;
            if ((s == 0 || s == 18) && PSEL(0)) {
                const int f = s == 0 ? 0 : 1;
                EpiSwiglu E{WSP(bf16_t, WS_ACT)};
                run_gemm(F, WSP(bf16_t, WS_N), DM, WSP(bf16_t, WS_WUP) + (size_t)(l * 2 + f) * NUP * DM, DM, MTOK, NUP, DM, 0, E);
            } else if ((s == 1 || s == 19) && PSEL(1)) {
                const int f = s == 1 ? 0 : 1;
                EpiResid E{WSP(float, WS_H), ada + (f == 0 ? 2 : 8) * DM, 0.5f * gsm};
                run_gemm(F, WSP(bf16_t, WS_ACT), DFF, WSP(bf16_t, WS_WDN) + (size_t)(l * 2 + f) * DM * DFF, DFF, MTOK, DM, DFF, 0, E);
            } else if (s == 2 && PSEL(2)) norm_phase(F, A, l, 1, false, false);
            else if (s == 3 && PSEL(3)) {
                EpiProj1 E1{WSP(bf16_t, WS_P1), WSP(float, WS_SSQ), WSP(float, WS_SSKV), WSP(float, WS_CKVRAW), WSP(float, WS_KRRAW)};
                run_gemm(F, WSP(bf16_t, WS_N), DM, WSP(bf16_t, WS_W1T) + (size_t)l * N1 * DM, DM, MTOK, N1, DM, 0, E1);
            } else if (s == 4 && PSEL(4)) {
                EpiT E2{WSP(bf16_t, WS_HYT), WSP(bf16_t, WS_XCTL), WSP(bf16_t, WS_XCTC)};
                run_gemm(F, WSP(bf16_t, WS_W2T) + (size_t)l * N2 * DM, DM, WSP(bf16_t, WS_N), DM, N2, MTOK, DM, 192, E2);
            } else if (s == 5 && PSEL(5)) {
                EpiQ EQ{WSP(bf16_t, WS_Q), WSP(float, WS_SSQ), WSP(float, WS_ROPE)};
                run_gemm(F, WSP(bf16_t, WS_P1), N1, WSP(bf16_t, WS_WQB) + (size_t)l * 768 * 256, 256, MTOK, 768, 256, 0, EQ);
            } else if (s == 6 && PSEL(6)) {
                EpiKV<false> EK{WSP(bf16_t, WS_KV), WSP(float, WS_SSKV)};
                run_gemm(F, WSP(bf16_t, WS_P1) + 256, N1, WSP(bf16_t, WS_WKVB) + (size_t)l * 1024 * 256, 256, MTOK, 1024, 256, 96, EK);
            } else if (s == 7 && PSEL(7)) {
                EpiKV<true> EC{WSP(bf16_t, WS_KV), nullptr};
                run_gemm(F, WSP(bf16_t, WS_CKVB) + (size_t)l * 1024 * 256, 256, WSP(bf16_t, WS_WKVR) + (size_t)l * 1024 * 256, 256, 1024, 1024, 256, 224, EC);
            } else if (s == 8 && PSEL(8)) {
                TLW(); const int gt = F.bid * NTHR + tid, NGT = F.G * NTHR;
                for (int it = gt; it < NCTX * 32; it += NGT) { const int r = it >> 5, c4 = (it & 31) * 4;
                    const f32x4 ss = *(const f32x4*)(WSP(float, WS_SSKV) + r * 4); const float rstd = 1.0f / sqrtf(((ss[0] + ss[1]) + (ss[2] + ss[3])) * (1.0f / 128.0f) + EPSV);
                    const f32x4 x = *(const f32x4*)(WSP(float, WS_CKVRAW) + (size_t)r * 128 + c4), g = *(const f32x4*)(AIN(I_KVNG) + l * 128 + c4);
                    *(f32x4*)(A.out + (size_t)MTOK * DM + ((size_t)((r >> 8) * 2 + l) * 256 + (r & 255)) * 128 + c4) = x * rstd * g; }
                for (int it = gt; it < MTOK * 4; it += NGT) { const int row = it >> 2, q = it & 3, part = q >> 1, ib = 4 * (q & 1);
                    const float* kp = WSP(float, WS_KRRAW) + (size_t)row * 32 + 8 * q; const f32x4 va = *(const f32x4*)kp, vb = *(const f32x4*)(kp + 4);
                    float v[8] = {va[0], va[1], va[2], va[3], vb[0], vb[1], vb[2], vb[3]};
                    if (row < NCTX) { float* op = A.out + (size_t)MTOK * DM + (size_t)16 * 2 * 256 * 128 + (size_t)((row >> 8) * 2 * 256 + l * 256 + (row & 255)) * 32 + part * 16 + ib;
#pragma unroll
                        for (int e = 0; e < 8; ++e) op[(e & 1) * 8 + (e >> 1)] = v[e];
                    } else { const int t = (row - NCTX) & 2047, pos = part == 0 ? (t >> 6) : (t & 63); const float* rt = WSP(float, WS_ROPE) + (pos * 8 + ib) * 2;
#pragma unroll
                        for (int e = 0; e < 8; e += 2) { const float cs = rt[e], sn = rt[e + 1], x1 = v[e], x2 = v[e + 1]; v[e] = x1 * cs - x2 * sn; v[e + 1] = x2 * cs + x1 * sn; } }
                    u32x4 w; w.x = cvtpk(v[0], v[1]); w.y = cvtpk(v[2], v[3]); w.z = cvtpk(v[4], v[5]); w.w = cvtpk(v[6], v[7]);
                    *(u32x4*)(WSP(bf16_t, WS_KR) + (size_t)kvrow_of(row) * 32 + 8 * q) = w; }
                for (int it = gt; it < 2 * 512 * 32; it += NGT) { const int pp = it & 31, j = (it >> 5) & 511, b = it >> 14; const int part = pp >> 4, w = pp & 15, i = w >> 1, half = w & 1, p = part * 16 + half * 8 + i;
                    WSP(bf16_t, WS_KR)[(size_t)(NCTX + b * 2560 + 2048 + j) * 32 + pp] = (bf16_t)f2bf(AIN(I_CKR)[((size_t)(b * 2 + l) * 512 + j) * 32 + p]); }
            } else if (s == 9 && PSEL(9)) {
                EpiFn EL{WSP(bf16_t, WS_FN), 1, 0.00276213586400995f};
                run_gemm(F, WSP(bf16_t, WS_DFTL), 4096, WSP(bf16_t, WS_XCTL), 4096, 2048, 512, 4096, 192, EL);
            } else if (s == 10 && PSEL(10)) {
                EpiFn EC{WSP(bf16_t, WS_FN), 0, 0.0078125f};
                run_gemm(F, WSP(bf16_t, WS_DFTC), 512, WSP(bf16_t, WS_XCTC), 512, 256, 4096, 512, 208, EC);
            } else if (s == 11 && PSEL(11)) {
                for (int u = F.bid; u < 256; u += F.G) {
                    const bf16_t *Qb, *KVh, *KRr; bf16_t* Ob; int seq;
                    if (u < 128) { const int b = u >> 6, h = (u >> 3) & 7, qb = u & 7; const int r0 = NCTX + b * 2048 + qb * 256, k0 = NCTX + b * 2560;
                        Qb = WSP(bf16_t, WS_Q) + (size_t)r0 * 768 + h * 96; KVh = WSP(bf16_t, WS_KV) + (size_t)k0 * 1024 + h * 128; KRr = WSP(bf16_t, WS_KR) + (size_t)k0 * 32; Ob = WSP(bf16_t, WS_O) + (size_t)r0 * 512 + h * 64; seq = 2560; }
                    else { const int v = u - 128, b = v >> 3, h = v & 7; const int r0 = b * 256;
                        Qb = WSP(bf16_t, WS_Q) + (size_t)r0 * 768 + h * 96; KVh = WSP(bf16_t, WS_KV) + (size_t)r0 * 1024 + h * 128; KRr = WSP(bf16_t, WS_KR) + (size_t)r0 * 32; Ob = WSP(bf16_t, WS_O) + (size_t)r0 * 512 + h * 64; seq = 256; }
                    att::attn_unit(Qb, KVh, KRr, Ob, seq, F.ldsg);
                }
            } else if (s == 12 && PSEL(12)) {
                for (int u = (F.bid + 128) % F.G; u < 128; u += F.G) hyena_unit(F, A, l, u);
            } else if (s == 13 && PSEL(13)) {
                EpiGate<0> E0{WSP(float, WS_Y), WSP(bf16_t, WS_N), WSP(bf16_t, WS_P1) + 512, 1.0f};
                run_gemm(F, WSP(bf16_t, WS_Z), 256, WSP(bf16_t, WS_WHY) + (size_t)l * 1024 * 256, 256, MTOK, DM, 256, 0, E0);
            } else if (s == 14 && PSEL(14)) {
                EpiGate<1> E1{WSP(float, WS_Y), WSP(bf16_t, WS_N), WSP(bf16_t, WS_P1) + 512 + 1024, gsm};
                run_gemm(F, WSP(bf16_t, WS_O), 512, WSP(bf16_t, WS_WMLA) + (size_t)l * 1024 * 512, 512, MTOK, DM, 512, 0, E1);
            } else if (s == 15 && PSEL(15)) {
                EpiGate<2> E2{WSP(float, WS_Y), WSP(bf16_t, WS_N), WSP(bf16_t, WS_P1) + 512 + 2048, 1.0f};
                run_gemm(F, WSP(bf16_t, WS_FN), 256, WSP(bf16_t, WS_WFN) + (size_t)l * 1024 * 256, 256, MTOK, DM, 256, 0, E2);
            } else if (s == 16 && PSEL(16)) {
                EpiResid E{WSP(float, WS_H), ada + 5 * DM, 1.0f * gsm};
                run_gemm(F, WSP(bf16_t, WS_N), DM, WSP(bf16_t, WS_WOUT) + (size_t)l * DM * DM, DM, MTOK, DM, DM, 0, E);
            } else if (s == 17 && PSEL(17)) norm_phase(F, A, l, 2, false, false);
            else if (s == 20 && PSEL(20)) { if (l == 0) norm_phase(F, A, 1, 0, false, false); else final_norm_phase(F, A); }
        }
        if (rep + 1 < nrep) { asm volatile("s_waitcnt vmcnt(0)" ::: "memory"); __syncthreads(); }
        }
        if (st + 1 < hi) { if (bar_after(st)) { xcd_barrier(bar); if (PROBE_REP & 256) xcd_barrier(bar); } else { asm volatile("s_waitcnt vmcnt(0)" ::: "memory"); __syncthreads(); } }
    }
}

extern "C" void kernel_launch(void* const* d_in, const int* in_sizes, int n_in, void* d_out, int out_size, void* d_ws, size_t ws_size, hipStream_t stream) {
    static int grid = 0;
    if (grid == 0) {
        if (n_in != 29 || ws_size < WS_END) { fprintf(stderr, "kernel_launch: n_in %d ws %zu (need %zu)\n", n_in, ws_size, (size_t)WS_END); grid = -1; return; }
        int dev = 0, cus = 0;
        if (hipGetDevice(&dev) != hipSuccess || hipDeviceGetAttribute(&cus, hipDeviceAttributeMultiprocessorCount, dev) != hipSuccess) { grid = -1; return; }
        if (hipFuncSetAttribute((const void*)mk_fwd, hipFuncAttributeMaxDynamicSharedMemorySize, LDS_BYTES) != hipSuccess) { fprintf(stderr, "kernel_launch: hipFuncSetAttribute failed\n"); grid = -1; return; }
        grid = cus;
    }
    if (grid < 0) return;
    (void)hipMemsetAsync((char*)d_ws + WS_CTL, 0, CTL_BYTES, stream);
    Args a{};
    for (int i = 0; i < 29; ++i) a.in[i] = (const float*)d_in[i];
    a.out = (float*)d_out; a.ws = (unsigned char*)d_ws;
#if MK_ONE_LAUNCH
    a.ph_lo = 0; a.ph_hi = N_STEPS; a.use_bar = 1;
    hipLaunchKernelGGL(mk_fwd, dim3(grid), dim3(NTHR), LDS_BYTES, stream, a);
#else
    a.use_bar = 0;
    for (int s0 = 0; s0 < N_STEPS;) { int s1 = s0; while (!bar_after(s1)) ++s1; a.ph_lo = s0; a.ph_hi = s1 + 1; hipLaunchKernelGGL(mk_fwd, dim3(grid), dim3(NTHR), LDS_BYTES, stream, a); s0 = s1 + 1; }
#endif
}
```

```cpp
#include <hip/hip_runtime.h>
#include <cstdio>
#include <cstdint>
namespace pg8 {
#define PG8_LAS __attribute__((address_space(3)))
typedef unsigned short bf16_t;
typedef short bf16x8 __attribute__((ext_vector_type(8)));
typedef float f32x4 __attribute__((ext_vector_type(4)));
typedef unsigned u32x4 __attribute__((ext_vector_type(4)));
constexpr int BM = 256, BK = 64, HALF = 128, HTB = HALF * BK * 2  , STAGE_BYTES = 8 * HTB, NXCD = 8, WGM = 8;

__host__ __device__ __forceinline__ int lds_byte(int r, int c) { const int st = (r >> 4) * 2 + (c >> 5), rr = r & 15, cc = c & 31, ob = rr * 64 + cc * 2; return st * 1024 + (ob ^ (((ob >> 9) & 1) << 5)); }
__host__ __device__ __forceinline__ void stage_rc(int b, int& R, int& C) { const int st = b / 1024, sb = b % 1024, swz = sb ^ (((sb >> 9) & 1) << 5); R = (st >> 1) * 16 + swz / 64; C = (st & 1) * 32 + (swz % 64) / 2; }
__host__ __device__ __forceinline__ int perm32(int rho) { const int n = rho >> 4, i = rho & 15; return 8 * (i >> 2) + 4 * n + (i & 3); }

struct Unit { int pm, pn; };
struct Gemm { const bf16_t* A; const bf16_t* Bt; int M, N, K, lda, ldb; };

struct StaticOrder {
    int nM, nN, nwg, G, c;
    __host__ __device__ void init(int M, int N, int G_, int c_) { nM = M / BM; nN = N / BM; nwg = nM * nN; G = G_; c = c_; }
    __host__ __device__ bool next(int i, Unit& u) const {
        const long L = (long)i * G + c; if (L >= nwg) return false;
        int wgid = (int)L; { const int q = nwg / NXCD, r = nwg % NXCD, xcd = wgid % NXCD, off = wgid / NXCD; wgid = (xcd < r ? xcd * (q + 1) : r * (q + 1) + (xcd - r) * q) + off; }
        const int nig = WGM * nN, gid = wgid / nig, fm = gid * WGM, gsz = (nM - fm) < WGM ? (nM - fm) : WGM;
        u.pm = fm + ((wgid % nig) % gsz); u.pn = (wgid % nig) / gsz; return true;
    }
    __device__ __forceinline__ void a_ready(const Unit&) const {}
    __device__ __forceinline__ void done(const Unit&) const {}
};


__device__ __forceinline__ f32x4 zero4_() { float a, b, c, d; asm volatile("v_mov_b32 %0, 0\n\tv_mov_b32 %1, 0\n\tv_mov_b32 %2, 0\n\tv_mov_b32 %3, 0" : "=v"(a), "=v"(b), "=v"(c), "=v"(d)); return (f32x4){a, b, c, d}; }
template <class Epi, class Sched, bool ALIGN_EPI = false, bool SP2 = false>
__device__ __forceinline__ void gemm_phase(PG8_LAS unsigned char* lds, const Gemm g, const Sched& S, const Epi& E) {
    int tid_ = threadIdx.x; asm volatile("" : "+v"(tid_));
    const int tid = tid_, wid = __builtin_amdgcn_readfirstlane(tid >> 6), lane = tid & 63, wr = wid >> 2, wc = wid & 3, fr = lane & 15, fq = lane >> 4;
    const int K = g.K, nt = K / BK;
    unsigned voffA[2], voffB[2];
#pragma unroll
    for (int i = 0; i < 2; ++i) { int R, C; stage_rc(tid * 16 + i * 8192, R, C); const int Rb = Epi::PERM ? ((R & ~31) + perm32(R & 31)) : R;
        voffA[i] = (unsigned)(R * g.lda + C) * 2u; voffB[i] = (unsigned)(Rb * g.ldb + C) * 2u; }
    const size_t kstep = (size_t)(BK * 2);
    const size_t hstepA = (size_t)HALF * g.lda * 2, hstepB = (size_t)HALF * g.ldb * 2;
    const size_t tstepA = 2 * hstepA, tstepB = 2 * hstepB;
    const unsigned ldsw = (unsigned)wid * 1024u;
    const int aoff = lds_byte(wr * 64 + fr, fq * 8), boff = lds_byte(wc * 32 + fr, fq * 8);
#define PG8_SA(b, h) (((b) * 2 + (h)) * HTB)
#define PG8_SB(b, h) ((4 + (b) * 2 + (h)) * HTB)
#define PG8_STAGE(bufoff, gbase, voff) do { _Pragma("unroll") for (int _i = 0; _i < 2; ++_i) \
        __builtin_amdgcn_global_load_lds((const unsigned*)((const char*)(gbase) + (voff)[_i]), (PG8_LAS unsigned*)(lds + (bufoff) + ldsw + _i * 8192), 16, 0, 0); } while (0)
#define PG8_LDA(dst, b, h) do { _Pragma("unroll") for (int m = 0; m < 4; ++m) _Pragma("unroll") for (int k = 0; k < 2; ++k) dst[m][k] = *(const PG8_LAS bf16x8*)(lds + PG8_SA(b, h) + aoff + m * 2048 + k * 1024); } while (0)
#define PG8_LDB(dst, b, h) do { _Pragma("unroll") for (int n = 0; n < 2; ++n) _Pragma("unroll") for (int k = 0; k < 2; ++k) dst[n][k] = *(const PG8_LAS bf16x8*)(lds + PG8_SB(b, h) + boff + n * 2048 + k * 1024); } while (0)
#define PG8_MMA(ai, bj, At, Bt) do { __builtin_amdgcn_s_setprio(1); _Pragma("unroll") for (int m = 0; m < 4; ++m) _Pragma("unroll") for (int n = 0; n < 2; ++n) _Pragma("unroll") for (int k = 0; k < 2; ++k) \
        acc[ai][bj][m][n] = __builtin_amdgcn_mfma_f32_16x16x32_bf16(Bt[n][k], At[m][k], acc[ai][bj][m][n], 0, 0, 0); __builtin_amdgcn_s_setprio(0); } while (0)
#define PG8_WAIT_V(n) asm volatile("s_waitcnt vmcnt(" #n ")" ::: "memory")
#define PG8_WAIT_L(n) asm volatile("s_waitcnt lgkmcnt(" #n ")" ::: "memory")
#define PG8_BAR __builtin_amdgcn_s_barrier()
#define PG8_SCHED __builtin_amdgcn_sched_barrier(0)
    Unit cur, nxt; int ui = 0;
    if (!S.next(0, cur)) return;
    f32x4 acc[2][2][4][2];
#pragma unroll
    for (int a = 0; a < 2; ++a)
#pragma unroll
        for (int b = 0; b < 2; ++b)
#pragma unroll
            for (int m = 0; m < 4; ++m)
#pragma unroll
                for (int n = 0; n < 2; ++n) acc[a][b][m][n] = zero4_();
    bf16x8 At[4][2], B0[2][2], B1[2][2];
    const char* cA = (const char*)g.A + (size_t)cur.pm * tstepA; const char* cB = (const char*)g.Bt + (size_t)cur.pn * tstepB;
    S.a_ready(cur);
    if constexpr (SP2) {
        PG8_STAGE(PG8_SB(0, 0), cB, voffB); PG8_STAGE(PG8_SB(0, 1), cB + hstepB, voffB); PG8_STAGE(PG8_SA(0, 0), cA, voffA); PG8_STAGE(PG8_SA(0, 1), cA + hstepA, voffA);
        if (wr == 1) PG8_BAR;
        PG8_WAIT_V(2); PG8_BAR;
        PG8_STAGE(PG8_SB(1, 0), cB + kstep, voffB); PG8_STAGE(PG8_SA(1, 0), cA + kstep, voffA); PG8_STAGE(PG8_SB(1, 1), cB + hstepB + kstep, voffB);
        PG8_WAIT_V(6); PG8_BAR;
    } else {
        PG8_STAGE(PG8_SB(0, 0), cB, voffB); PG8_STAGE(PG8_SA(0, 0), cA, voffA); PG8_STAGE(PG8_SB(0, 1), cB + hstepB, voffB); PG8_STAGE(PG8_SA(0, 1), cA + hstepA, voffA);
        if (wr == 1) PG8_BAR;
        PG8_WAIT_V(4); PG8_BAR;
        PG8_STAGE(PG8_SB(1, 0), cB + kstep, voffB); PG8_STAGE(PG8_SA(1, 0), cA + kstep, voffA); PG8_STAGE(PG8_SB(1, 1), cB + hstepB + kstep, voffB);
        PG8_WAIT_V(6); PG8_BAR;
    }
#pragma unroll 1
    for (;;) {
        const bool has_next = S.next(ui + 1, nxt);
        const char* nA = has_next ? (const char*)g.A + (size_t)nxt.pm * tstepA : cA; const char* nB = has_next ? (const char*)g.Bt + (size_t)nxt.pn * tstepB : cB;
#pragma unroll 1
        for (int t = 0; t < nt; t += 2) {
            const bool last = (t == nt - 2);
            const char* a1 = cA + (size_t)(t + 1) * kstep;
            const char* a2 = last ? nA : cA + (size_t)(t + 2) * kstep; const char* b2 = last ? nB : cB + (size_t)(t + 2) * kstep;
            const char* a3 = a2 + kstep; const char* b3 = b2 + kstep;
            if (last && has_next) S.a_ready(nxt);
            if constexpr (SP2) {
            PG8_LDB(B0, 0, 0); PG8_LDB(B1, 0, 1); PG8_SCHED; PG8_LDA(At, 0, 0); PG8_STAGE(PG8_SA(1, 1), a1 + hstepA, voffA);
            PG8_WAIT_V(8); PG8_WAIT_L(0); PG8_BAR; PG8_MMA(0, 0, At, B0); PG8_MMA(0, 1, At, B1); PG8_BAR; PG8_SCHED;
            PG8_LDA(At, 0, 1); PG8_STAGE(PG8_SB(0, 0), b2, voffB); PG8_STAGE(PG8_SB(0, 1), b2 + hstepB, voffB); PG8_STAGE(PG8_SA(0, 0), a2, voffA);
            PG8_WAIT_V(8); PG8_WAIT_L(0); PG8_BAR; PG8_MMA(1, 0, At, B0); PG8_MMA(1, 1, At, B1); PG8_BAR; PG8_SCHED;
            PG8_LDB(B0, 1, 0); PG8_LDB(B1, 1, 1); PG8_SCHED; PG8_LDA(At, 1, 0); PG8_STAGE(PG8_SA(0, 1), a2 + hstepA, voffA);
            PG8_WAIT_V(8); PG8_WAIT_L(0); PG8_BAR; PG8_MMA(0, 0, At, B0); PG8_MMA(0, 1, At, B1); PG8_BAR; PG8_SCHED;
            PG8_LDA(At, 1, 1); PG8_STAGE(PG8_SB(1, 0), b3, voffB); PG8_STAGE(PG8_SB(1, 1), b3 + hstepB, voffB); PG8_STAGE(PG8_SA(1, 0), a3, voffA);
            PG8_WAIT_V(8); PG8_WAIT_L(0); PG8_BAR; PG8_MMA(1, 0, At, B0); PG8_MMA(1, 1, At, B1); PG8_BAR; PG8_SCHED;
            } else {
            PG8_LDB(B0, 0, 0); PG8_SCHED; PG8_LDA(At, 0, 0); PG8_STAGE(PG8_SA(1, 1), a1 + hstepA, voffA);
            PG8_WAIT_L(8); PG8_BAR; PG8_WAIT_L(0); PG8_MMA(0, 0, At, B0); PG8_BAR; PG8_SCHED;
            PG8_LDB(B1, 0, 1); PG8_STAGE(PG8_SB(0, 0), b2, voffB);
            PG8_BAR; PG8_WAIT_L(0); PG8_MMA(0, 1, At, B1); PG8_BAR;
            PG8_LDA(At, 0, 1); PG8_STAGE(PG8_SA(0, 0), a2, voffA);
            PG8_BAR; PG8_WAIT_L(0); PG8_MMA(1, 0, At, B0); PG8_BAR; PG8_SCHED;
            PG8_STAGE(PG8_SB(0, 1), b2 + hstepB, voffB);
            PG8_WAIT_V(6); PG8_BAR; PG8_MMA(1, 1, At, B1); PG8_BAR;
            PG8_LDB(B0, 1, 0); PG8_SCHED; PG8_LDA(At, 1, 0); PG8_STAGE(PG8_SA(0, 1), a2 + hstepA, voffA);
            PG8_WAIT_L(8); PG8_BAR; PG8_WAIT_L(0); PG8_MMA(0, 0, At, B0); PG8_BAR; PG8_SCHED;
            PG8_LDB(B1, 1, 1); PG8_STAGE(PG8_SB(1, 0), b3, voffB);
            PG8_BAR; PG8_WAIT_L(0); PG8_MMA(0, 1, At, B1); PG8_BAR;
            PG8_LDA(At, 1, 1); PG8_STAGE(PG8_SA(1, 0), a3, voffA);
            PG8_BAR; PG8_WAIT_L(0); PG8_MMA(1, 0, At, B0); PG8_BAR; PG8_SCHED;
            PG8_STAGE(PG8_SB(1, 1), b3 + hstepB, voffB);
            PG8_WAIT_V(6); PG8_BAR; PG8_MMA(1, 1, At, B1); PG8_BAR;
            }
        }
        if constexpr (ALIGN_EPI) { if (wr == 0) PG8_BAR; }
        if constexpr (!Epi::AFTER_DRAIN) { E(acc, cur, wr, wc, fr, fq); S.done(cur); }
        if (!has_next) break;
#pragma unroll
        for (int a = 0; a < 2; ++a)
#pragma unroll
            for (int b = 0; b < 2; ++b)
#pragma unroll
                for (int m = 0; m < 4; ++m)
#pragma unroll
                    for (int n = 0; n < 2; ++n) acc[a][b][m][n] = zero4_();
        cur = nxt; cA = nA; cB = nB; ++ui;
        if constexpr (ALIGN_EPI) { if (wr == 1) PG8_BAR; }
    }
    PG8_WAIT_V(0);
    if constexpr (!ALIGN_EPI) { if (wr == 0) PG8_BAR; }
    PG8_BAR;
    if constexpr (Epi::AFTER_DRAIN) { E.fused(acc, cur, wr, wc, fr, fq, lds, wid, lane); S.done(cur); }
#undef PG8_SA
#undef PG8_SB
#undef PG8_STAGE
#undef PG8_LDA
#undef PG8_LDB
#undef PG8_MMA
#undef PG8_WAIT_V
#undef PG8_WAIT_L
#undef PG8_BAR
#undef PG8_SCHED
}
}

#define GAS __attribute__((address_space(1)))
#define LAS __attribute__((address_space(3)))
typedef unsigned short bf16_t;
typedef float f32x4 __attribute__((ext_vector_type(4)));
typedef float f32x8 __attribute__((ext_vector_type(8)));
typedef float f32x16 __attribute__((ext_vector_type(16)));
typedef short bf16x8 __attribute__((ext_vector_type(8)));
typedef short s16x4 __attribute__((ext_vector_type(4)));
typedef unsigned u32x4 __attribute__((ext_vector_type(4)));
typedef unsigned u32x2 __attribute__((ext_vector_type(2)));

constexpr int DM = 1024, MTOK = 8192, NCTX = 4096, LCTX = 256, LLAT = 2048;
constexpr int DFF = 2816, NUP = 5632, INC = 4512;
constexpr int N1 = 3584;
constexpr int N2 = 1280;
constexpr int KVROWS = 9216;
constexpr int NADA = 9216;
constexpr float EPSV = 1e-6f;
constexpr int NWAVES = 8, NTHR = 512;

constexpr size_t al256(size_t x) { return (x + 255) & ~(size_t)255; }
constexpr size_t WS_CTL = 0, CTL_BYTES = 1u << 20;
constexpr size_t WS_ADAP = WS_CTL + CTL_BYTES;
constexpr size_t WS_ADA  = WS_ADAP + al256((size_t)16 * 2 * 3 * NADA * 4);
constexpr size_t WS_SSQ  = WS_ADA + al256((size_t)2 * 3 * NADA * 4);
constexpr size_t WS_SSKV = WS_SSQ + al256((size_t)MTOK * 4 * 4);
constexpr size_t WS_ROPE = WS_SSKV + al256((size_t)MTOK * 4 * 4);
constexpr size_t WS_H2   = WS_ROPE + al256(64 * 8 * 2 * 4);
constexpr size_t WS_FILT = WS_H2 + al256((size_t)2 * 2304 * 64 * 4);
constexpr size_t FILT_LAYER = (size_t)512 * 4096 + (size_t)512 * 512;
constexpr size_t WS_CKVRAW = WS_FILT + al256(2 * FILT_LAYER * 4);
constexpr size_t WS_KRRAW = WS_CKVRAW + al256((size_t)NCTX * 128 * 4);
constexpr size_t WS_CKVB = WS_KRRAW + al256((size_t)MTOK * 32 * 4);
constexpr size_t WS_WUP  = WS_CKVB + al256((size_t)2 * 1024 * 256 * 2);
constexpr size_t WS_WDN  = WS_WUP + al256((size_t)4 * NUP * DM * 2);
constexpr size_t WS_W1T  = WS_WDN + al256((size_t)4 * DM * DFF * 2);
constexpr size_t WS_W2T  = WS_W1T + al256((size_t)2 * N1 * DM * 2);
constexpr size_t WS_WQB  = WS_W2T + al256((size_t)2 * N2 * DM * 2);
constexpr size_t WS_WKVB = WS_WQB + al256((size_t)2 * 768 * 256 * 2);
constexpr size_t WS_WKVR = WS_WKVB + al256((size_t)2 * 1024 * 256 * 2);
constexpr size_t WS_WHY  = WS_WKVR + al256((size_t)2 * 1024 * 256 * 2);
constexpr size_t WS_WMLA = WS_WHY + al256((size_t)2 * 1024 * 256 * 2);
constexpr size_t WS_WFN  = WS_WMLA + al256((size_t)2 * 1024 * 512 * 2);
constexpr size_t WS_WOUT = WS_WFN + al256((size_t)2 * 1024 * 256 * 2);
constexpr size_t WS_DFTL = WS_WOUT + al256((size_t)2 * 1024 * 1024 * 2);
constexpr size_t WS_DFTC = WS_DFTL + al256((size_t)2048 * 4096 * 2);
constexpr size_t WS_H    = WS_DFTC + al256((size_t)256 * 512 * 2);
constexpr size_t WS_N    = WS_H + al256((size_t)MTOK * DM * 4);
constexpr size_t WS_KV   = WS_N + al256((size_t)MTOK * DM * 2);
constexpr size_t WS_KR   = WS_KV + al256((size_t)KVROWS * 1024 * 2);
constexpr size_t WS_R1   = WS_KR + al256((size_t)KVROWS * 32 * 2);
constexpr size_t WS_ACT  = WS_R1;
constexpr size_t WS_P1   = WS_R1;
constexpr size_t WS_HYT  = WS_P1 + al256((size_t)MTOK * N1 * 2);
constexpr size_t WS_XCTL = WS_HYT + al256((size_t)768 * MTOK * 2);
constexpr size_t WS_XCTC = WS_XCTL + al256((size_t)512 * 4096 * 2);
constexpr size_t WS_Q    = WS_XCTC + al256((size_t)4096 * 512 * 2);
constexpr size_t WS_O    = WS_Q + al256((size_t)MTOK * 768 * 2);
constexpr size_t WS_Z    = WS_O + al256((size_t)MTOK * 512 * 2);
constexpr size_t WS_FN   = WS_Z + al256((size_t)MTOK * 256 * 2);
constexpr size_t WS_Y    = WS_FN + al256((size_t)MTOK * 256 * 2);
constexpr size_t WS_END  = WS_Y + al256((size_t)MTOK * DM * 4);
static_assert(WS_ACT + (size_t)MTOK * DFF * 2 <= WS_END, "ws map");

constexpr int CW_BAR = 4096, CW_Q = 8192;

constexpr int RING_BYTES = 131072;
constexpr int MISC_OFF = 163840 - 512;
constexpr int LDS_BYTES = 163840;

__device__ __forceinline__ unsigned f2bf(float f) { unsigned u = __builtin_bit_cast(unsigned, f); return (u + 0x7fffu + ((u >> 16) & 1u)) >> 16; }
__device__ __forceinline__ unsigned pk2(float lo, float hi) { return f2bf(lo) | (f2bf(hi) << 16); }
__device__ __forceinline__ float bf2f(unsigned short b) { return __builtin_bit_cast(float, (unsigned)b << 16); }
__device__ __forceinline__ float bflo(unsigned w) { return __builtin_bit_cast(float, w << 16); }
__device__ __forceinline__ float bfhi(unsigned w) { return __builtin_bit_cast(float, w & 0xffff0000u); }
__device__ __forceinline__ unsigned cvtpk(float lo, float hi) { unsigned r; asm volatile("v_cvt_pk_bf16_f32 %0, %1, %2" : "=v"(r) : "v"(lo), "v"(hi)); return r; }
__device__ __forceinline__ u32x4 pack8(f32x4 a, f32x4 b) { u32x4 w; w.x = cvtpk(a[0], a[1]); w.y = cvtpk(a[2], a[3]); w.z = cvtpk(b[0], b[1]); w.w = cvtpk(b[2], b[3]); return w; }
__device__ __forceinline__ float wave_sum(float v) {
#pragma unroll
    for (int o = 1; o < 64; o <<= 1) v += __shfl_xor(v, o);
    return v;
}
__device__ __forceinline__ float sigmoidf_(float x) { return 1.0f / (1.0f + __expf(-x)); }
__device__ __forceinline__ float siluf_(float x) { return x / (1.0f + __expf(-x)); }
__device__ __forceinline__ int grp_of_pm(int pm) { return pm < 16 ? 0 : (pm < 24 ? 1 : 2); }
__device__ __forceinline__ int kvrow_of(int r) { return r < NCTX ? r : NCTX + ((r - NCTX) >> 11) * 2560 + ((r - NCTX) & 2047); }

#define XB_TMO      128
#define XB_XCNT(j)  (256  + 64 * (j))
#define XB_XSUB(j)  (1280 + 64 * (j))
#define XB_XGEN(j)  (2304 + 64 * (j))
#define XB_TOP      3328
#define XB_TOPGEN   3392
#define XCD_BAR_WORDS 3456
#define XB_SPIN_CAP (1u << 20)
__device__ __forceinline__ unsigned xb_ld(unsigned* p)              { return __hip_atomic_load(p, __ATOMIC_RELAXED, __HIP_MEMORY_SCOPE_AGENT); }
__device__ __forceinline__ unsigned xb_add(unsigned* p, unsigned v) { return __hip_atomic_fetch_add(p, v, __ATOMIC_RELAXED, __HIP_MEMORY_SCOPE_AGENT); }
__device__ __forceinline__ unsigned xb_xcc_id() { return (unsigned)__builtin_amdgcn_s_getreg((3 << 11) | 20) & 0xFu; }
#define XB_SPIN(cond, bar) do { unsigned _sp = 0; while (cond) { __builtin_amdgcn_s_sleep(1); \
    if ((++_sp & 255u) == 0u) { if (xb_ld(&(bar)[XB_TMO])) break; if (_sp > XB_SPIN_CAP) { atomicAdd(&(bar)[XB_TMO], 1u); break; } } } } while (0)
struct XcdBarrier { unsigned* bar; unsigned x; volatile LAS unsigned* st; };
__device__ __forceinline__ XcdBarrier xcd_barrier_post(unsigned* bar, volatile LAS unsigned* st) {
    XcdBarrier b; b.bar = bar; b.x = xb_xcc_id(); b.st = st;
    if (threadIdx.x == 0) (void)xb_add(&bar[XB_XCNT(b.x)], 1u);
    return b;
}
__device__ __forceinline__ void xcd_barrier_complete(unsigned* bar, unsigned x, unsigned& nloc, unsigned& nx) {
    const unsigned G = gridDim.x * gridDim.y * gridDim.z;
    unsigned sum, cnt, mine, sp = 0u;
    for (;;) {
        sum = 0u; cnt = 0u; mine = 0u;
#pragma unroll 1
        for (unsigned j = 0; j < 16; ++j) { const unsigned c = xb_ld(&bar[XB_XCNT(j)]); sum += c; cnt += (c > 0u) ? 1u : 0u; mine = (j == x) ? c : mine; }
        if (sum == G) break;
        __builtin_amdgcn_s_sleep(1);
        if ((++sp & 255u) == 0u) { if (xb_ld(&bar[XB_TMO])) break; if (sp > XB_SPIN_CAP) { atomicAdd(&bar[XB_TMO], 1u); break; } }
    }
    nloc = mine > 0u ? mine : 1u; nx = cnt > 0u ? cnt : 1u;
}
__device__ __forceinline__ void xcd_barrier(const XcdBarrier& b) {
    asm volatile("s_waitcnt vmcnt(0)" ::: "memory");
    __syncthreads();
    if (threadIdx.x == 0) {
        size_t z_ = 0; asm volatile("" : "+s"(z_));
        unsigned* bar = b.bar + z_;
        __builtin_amdgcn_s_waitcnt(0);
        unsigned nloc = b.st[0], nx = b.st[1];
        if (nloc == 0u) { xcd_barrier_complete(bar, b.x, nloc, nx); b.st[0] = nloc; b.st[1] = nx; }
        const unsigned old = xb_add(&bar[XB_XSUB(b.x)], 1u);
        const unsigned gen = old / nloc;
        if (old + 1u == (gen + 1u) * nloc) {
            __builtin_amdgcn_fence(__ATOMIC_RELEASE, "agent");
            asm volatile("s_waitcnt vmcnt(0)" ::: "memory");
            const unsigned og = xb_add(&bar[XB_TOP], 1u);
            const unsigned tg = og / nx;
            if (og + 1u == (tg + 1u) * nx) xb_add(&bar[XB_TOPGEN], 1u);
            else XB_SPIN(xb_ld(&bar[XB_TOPGEN]) == tg, bar);
            __builtin_amdgcn_fence(__ATOMIC_ACQUIRE, "agent");
            xb_add(&bar[XB_XGEN(b.x)], 1u);
            asm volatile("s_waitcnt vmcnt(0)" ::: "memory");
        } else {
            XB_SPIN(xb_ld(&bar[XB_XGEN(b.x)]) == gen, bar);
            __builtin_amdgcn_fence(__ATOMIC_ACQUIRE, "agent");
            asm volatile("s_waitcnt vmcnt(0)" ::: "memory");
        }
    }
    __syncthreads();
}

using pg8::Unit;
typedef const f32x4 (&AccT)[2][2][4][2];

struct EpiSwiglu {
    static constexpr bool PERM = false, AFTER_DRAIN = false;
    bf16_t* ACT;
    __device__ __forceinline__ void operator()(AccT acc, const Unit& u, int wr, int wc, int fr, int fq) const {
        int z_ = 0; asm volatile("" : "+s"(z_));
        const int row0 = u.pm * 256 + wr * 64 + fr + z_, f0 = u.pn * 128 + wc * 16 + 4 * fq;
#pragma unroll
        for (int ai = 0; ai < 2; ++ai)
#pragma unroll
            for (int m = 0; m < 4; ++m) { bf16_t* rp = ACT + (size_t)(row0 + ai * 128 + m * 16) * DFF + f0;
#pragma unroll
                for (int bj = 0; bj < 2; ++bj) { const f32x4 g = acc[ai][bj][m][0], x = acc[ai][bj][m][1];
                    u32x2 w; w.x = cvtpk(siluf_(g[0]) * x[0], siluf_(g[1]) * x[1]); w.y = cvtpk(siluf_(g[2]) * x[2], siluf_(g[3]) * x[3]);
                    *(u32x2*)(rp + 64 * bj) = w; } }
    }
};
struct EpiResid {
    static constexpr bool PERM = true, AFTER_DRAIN = false;
    float* H; const float* gate; float gs;
    __device__ __forceinline__ void operator()(AccT acc, const Unit& u, int wr, int wc, int fr, int fq) const {
        int z_ = 0; asm volatile("" : "+s"(z_));
        const int row0 = u.pm * 256 + wr * 64 + fr + z_, col0 = u.pn * 256 + wc * 32 + 8 * fq;
        const float* gp = gate + grp_of_pm(u.pm) * NADA + col0;
        f32x4 gv[2][2];
#pragma unroll
        for (int bj = 0; bj < 2; ++bj) { gv[bj][0] = *(const f32x4*)(gp + bj * 128) * gs; gv[bj][1] = *(const f32x4*)(gp + bj * 128 + 4) * gs; }
#pragma unroll
        for (int ai = 0; ai < 2; ++ai)
#pragma unroll
            for (int m = 0; m < 4; ++m) { float* rp = H + (size_t)(row0 + ai * 128 + m * 16) * DM + col0;
#pragma unroll
                for (int bj = 0; bj < 2; ++bj) {
                    f32x4 h0 = *(const f32x4*)(rp + bj * 128), h1 = *(const f32x4*)(rp + bj * 128 + 4);
                    h0 += gv[bj][0] * acc[ai][bj][m][0]; h1 += gv[bj][1] * acc[ai][bj][m][1];
                    *(f32x4*)(rp + bj * 128) = h0; *(f32x4*)(rp + bj * 128 + 4) = h1; }
                if (m & 1) asm volatile("" ::: "memory"); }
    }
};
struct EpiProj1 {
    static constexpr bool PERM = true, AFTER_DRAIN = false;
    bf16_t* P1; float* SSQ; float* SSKV; float* CKVRAW; float* KRRAW;
    __device__ __forceinline__ void operator()(AccT acc, const Unit& u, int wr, int wc, int fr, int fq) const {
        int z_ = 0; asm volatile("" : "+s"(z_));
        fq += z_; wc += z_;
        const int row0 = u.pm * 256 + wr * 64 + fr + z_, col0 = u.pn * 256 + wc * 32 + 8 * fq;
        if (u.pn >= 2) {
#pragma unroll
            for (int ai = 0; ai < 2; ++ai)
#pragma unroll
                for (int m = 0; m < 4; ++m) { bf16_t* rp = P1 + (size_t)(row0 + ai * 128 + m * 16) * N1 + col0;
#pragma unroll
                    for (int bj = 0; bj < 2; ++bj) { f32x4 a = acc[ai][bj][m][0], b = acc[ai][bj][m][1];
#pragma unroll
                        for (int j = 0; j < 4; ++j) { a[j] = sigmoidf_(a[j]); b[j] = sigmoidf_(b[j]); }
                        *(u32x4*)(rp + bj * 128) = pack8(a, b); } }
        } else {
            const bool isq = (u.pn == 0);
#pragma unroll
            for (int ai = 0; ai < 2; ++ai)
#pragma unroll
                for (int m = 0; m < 4; ++m) { const int row = row0 + ai * 128 + m * 16; bf16_t* rp = P1 + (size_t)row * N1 + col0;
                    const f32x4 a0 = acc[ai][0][m][0], b0 = acc[ai][0][m][1], a1 = acc[ai][1][m][0], b1 = acc[ai][1][m][1];
                    *(u32x4*)(rp) = pack8(a0, b0); *(u32x4*)(rp + 128) = pack8(a1, b1);
                    float s = (a0[0] * a0[0] + a0[1] * a0[1]) + (a0[2] * a0[2] + a0[3] * a0[3]) + (b0[0] * b0[0] + b0[1] * b0[1]) + (b0[2] * b0[2] + b0[3] * b0[3]);
                    if (isq) s += (a1[0] * a1[0] + a1[1] * a1[1]) + (a1[2] * a1[2] + a1[3] * a1[3]) + (b1[0] * b1[0] + b1[1] * b1[1]) + (b1[2] * b1[2] + b1[3] * b1[3]);
                    s += __shfl_xor(s, 16); s += __shfl_xor(s, 32);
                    if (fq == 0) (isq ? SSQ : SSKV)[row * 4 + wc] = s;
                    if (!isq) {
                        if (row < NCTX) { float* cp = CKVRAW + (size_t)row * 128 + wc * 32 + 8 * fq; *(f32x4*)cp = a0; *(f32x4*)(cp + 4) = b0; }
                        if (wc == 0) { float* kp = KRRAW + (size_t)row * 32 + 8 * fq; *(f32x4*)kp = a1; *(f32x4*)(kp + 4) = b1; }
                    }
                    asm volatile("" ::: "memory"); }
        }
    }
};
struct EpiQ {
    static constexpr bool PERM = true, AFTER_DRAIN = false;
    bf16_t* Q; const float* SSQ; const float* rope;
    __device__ __forceinline__ void operator()(AccT acc, const Unit& u, int wr, int wc, int fr, int fq) const {
        int z_ = 0; asm volatile("" : "+s"(z_));
        const int row0 = u.pm * 256 + wr * 64 + fr + z_, col0 = u.pn * 256 + wc * 32 + 8 * fq;
#pragma unroll
        for (int ai = 0; ai < 2; ++ai)
#pragma unroll
            for (int m = 0; m < 4; ++m) { const int row = row0 + ai * 128 + m * 16;
                const f32x4 ss = *(const f32x4*)(SSQ + row * 4); const float rstd = __builtin_amdgcn_rsqf(((ss[0] + ss[1]) + (ss[2] + ss[3])) * (1.0f / 256.0f) + EPSV);
#pragma unroll
                for (int bj = 0; bj < 2; ++bj) { const int c = col0 + bj * 128, within = c % 96;
                    f32x4 a = acc[ai][bj][m][0] * rstd, b = acc[ai][bj][m][1] * rstd;
                    if (within >= 64 && row >= NCTX) { const int pp = within - 64, part = pp >> 4, ib = (pp & 15) >> 1; const int t = (row - NCTX) & 2047, pos = part == 0 ? (t >> 6) : (t & 63);
                        const float* rt = rope + (pos * 8 + ib) * 2; const f32x4 r0 = *(const f32x4*)rt, r1 = *(const f32x4*)(rt + 4);
                        f32x4 a2, b2; a2[0] = a[0] * r0[0] - a[1] * r0[1]; a2[1] = a[1] * r0[0] + a[0] * r0[1]; a2[2] = a[2] * r0[2] - a[3] * r0[3]; a2[3] = a[3] * r0[2] + a[2] * r0[3];
                        b2[0] = b[0] * r1[0] - b[1] * r1[1]; b2[1] = b[1] * r1[0] + b[0] * r1[1]; b2[2] = b[2] * r1[2] - b[3] * r1[3]; b2[3] = b[3] * r1[2] + b[2] * r1[3]; a = a2; b = b2; }
                    *(u32x4*)(Q + (size_t)row * 768 + c) = pack8(a, b); }
                asm volatile("" ::: "memory"); }
    }
};
template <bool CACHED> struct EpiKV {
    static constexpr bool PERM = true, AFTER_DRAIN = false;
    bf16_t* KV; const float* SS;
    __device__ __forceinline__ void operator()(AccT acc, const Unit& u, int wr, int wc, int fr, int fq) const {
        int z_ = 0; asm volatile("" : "+s"(z_));
        const int row0 = u.pm * 256 + wr * 64 + fr + z_, col0 = u.pn * 256 + wc * 32 + 8 * fq;
#pragma unroll
        for (int ai = 0; ai < 2; ++ai)
#pragma unroll
            for (int m = 0; m < 4; ++m) { const int row = row0 + ai * 128 + m * 16; float rstd = 1.0f; int drow;
                if (CACHED) drow = NCTX + (row >> 9) * 2560 + 2048 + (row & 511);
                else { drow = kvrow_of(row); const f32x4 ss = *(const f32x4*)(SS + row * 4); rstd = __builtin_amdgcn_rsqf(((ss[0] + ss[1]) + (ss[2] + ss[3])) * (1.0f / 128.0f) + EPSV); }
#pragma unroll
                for (int bj = 0; bj < 2; ++bj) *(u32x4*)(KV + (size_t)drow * 1024 + col0 + bj * 128) = pack8(acc[ai][bj][m][0] * rstd, acc[ai][bj][m][1] * rstd);
                asm volatile("" ::: "memory"); }
    }
};
struct EpiT {
    static constexpr bool PERM = true, AFTER_DRAIN = false;
    bf16_t* HYT; bf16_t* XCTL; bf16_t* XCTC;
    __device__ __forceinline__ void operator()(AccT acc, const Unit& u, int wr, int wc, int fr, int fq) const {
        int z_ = 0; asm volatile("" : "+s"(z_));
        const int row0 = u.pm * 256 + wr * 64 + fr + z_, tok0 = u.pn * 256 + wc * 32 + 8 * fq;
#pragma unroll
        for (int ai = 0; ai < 2; ++ai)
#pragma unroll
            for (int m = 0; m < 4; ++m) { const int n = row0 + ai * 128 + m * 16;
#pragma unroll
                for (int bj = 0; bj < 2; ++bj) { const int tok = tok0 + bj * 128; bf16_t* dp;
                    if (u.pm < 3) dp = HYT + (size_t)n * MTOK + tok;
                    else { const int isS = u.pm - 3, col = n - 768 - 256 * isS;
                        if (tok < NCTX) dp = XCTC + ((size_t)((tok >> 8) * 256 + col)) * 512 + isS * 256 + (tok & 255);
                        else dp = XCTL + ((size_t)(((tok - NCTX) >> 11) * 256 + col)) * 4096 + isS * 2048 + ((tok - NCTX) & 2047); }
                    *(u32x4*)dp = pack8(acc[ai][bj][m][0], acc[ai][bj][m][1]); } }
    }
};
struct EpiFn {
    static constexpr bool PERM = true, AFTER_DRAIN = false;
    bf16_t* FN; int lat; float scale;
    __device__ __forceinline__ void operator()(AccT acc, const Unit& u, int wr, int wc, int fr, int fq) const {
        int z_ = 0; asm volatile("" : "+s"(z_));
        const int rb = lat ? (NCTX + u.pn * 2048 + u.pm * 256) : (u.pn * 256);
        const int row0 = rb + wr * 64 + fr + z_, col0 = wc * 32 + 8 * fq;
#pragma unroll
        for (int ai = 0; ai < 2; ++ai)
#pragma unroll
            for (int m = 0; m < 4; ++m) { bf16_t* rp = FN + (size_t)(row0 + ai * 128 + m * 16) * 256 + col0;
#pragma unroll
                for (int bj = 0; bj < 2; ++bj) *(u32x4*)(rp + bj * 128) = pack8(acc[ai][bj][m][0] * scale, acc[ai][bj][m][1] * scale); }
    }
};
template <int MODE> struct EpiGate {
    static constexpr bool PERM = true, AFTER_DRAIN = false;
    float* Y; bf16_t* YB; const bf16_t* G; float gsc;
    __device__ __forceinline__ void operator()(AccT acc, const Unit& u, int wr, int wc, int fr, int fq) const {
        int z_ = 0; asm volatile("" : "+s"(z_));
        const int row0 = u.pm * 256 + wr * 64 + fr + z_, col0 = u.pn * 256 + wc * 32 + 8 * fq;
#pragma unroll
        for (int ai = 0; ai < 2; ++ai)
#pragma unroll
            for (int m = 0; m < 4; ++m) { const int row = row0 + ai * 128 + m * 16;
#pragma unroll
                for (int bj = 0; bj < 2; ++bj) { const int c = col0 + bj * 128;
                    const u32x4 gw = *(const u32x4*)(G + (size_t)row * N1 + c);
                    f32x4 g0, g1; g0[0] = bflo(gw.x); g0[1] = bfhi(gw.x); g0[2] = bflo(gw.y); g0[3] = bfhi(gw.y); g1[0] = bflo(gw.z); g1[1] = bfhi(gw.z); g1[2] = bflo(gw.w); g1[3] = bfhi(gw.w);
                    f32x4 a = g0 * acc[ai][bj][m][0] * gsc, b = g1 * acc[ai][bj][m][1] * gsc;
                    float* yp = Y + (size_t)row * DM + c;
                    if (MODE >= 1) { a += *(const f32x4*)yp; b += *(const f32x4*)(yp + 4); }
                    if (MODE <= 1) { *(f32x4*)yp = a; *(f32x4*)(yp + 4) = b; }
                    else *(u32x4*)(YB + (size_t)row * DM + c) = pack8(a, b); }
                asm volatile("" ::: "memory"); }
    }
};

namespace att {
constexpr int KVBLK = 64;
constexpr float SCALE = 0.10206207261596575f;
constexpr float THR = 8.f;
constexpr int SHM_V = KVBLK * 128 * 2, SHM_K = KVBLK * 128 * 2, SHM_ATTN = 2 * SHM_V + 2 * SHM_K + NWAVES * 64 * 4;
#define KSWZ(row, colB) ((row) * 256 + ((colB) ^ (((row) & 7) << 4)))
#define SBAR() __builtin_amdgcn_sched_barrier(0)
__device__ __forceinline__ int crow(int r, int hi) { return (r & 3) + 8 * (r >> 2) + 4 * hi; }
__device__ __forceinline__ void partialSM(f32x16& p0, f32x16& p1, float& m_reg, float& mn, float& alpha) {
  constexpr float C = SCALE * 1.4426950408889634f;
  float pmax = p0[0];
#pragma unroll
  for (int r = 1; r < 16; ++r) pmax = fmaxf(pmax, p0[r]);
#pragma unroll
  for (int r = 0; r < 16; ++r) pmax = fmaxf(pmax, p1[r]);
  { auto rr = __builtin_amdgcn_permlane32_swap(__float_as_uint(pmax), __float_as_uint(pmax), false, false);
    pmax = fmaxf(__uint_as_float(rr[0]), __uint_as_float(rr[1])); }
  if (__builtin_expect(__all(pmax - m_reg <= THR / SCALE), 1)) { mn = m_reg; alpha = 1.f; }
  else { mn = fmaxf(m_reg, pmax); alpha = __builtin_amdgcn_exp2f((m_reg - mn) * C); m_reg = mn; }
  float mnC = -mn * C;
#pragma unroll
  for (int r = 0; r < 16; ++r) p0[r] = fmaf(p0[r], C, mnC);
#pragma unroll
  for (int r = 0; r < 16; ++r) p1[r] = fmaf(p1[r], C, mnC);
#pragma unroll
  for (int r = 0; r < 16; ++r) p0[r] = __builtin_amdgcn_exp2f(p0[r]);
}
__device__ __forceinline__ void finishSM(f32x16& p0, f32x16& p1, float alpha, float& l_reg, bf16x8& pa0, bf16x8& pa1, bf16x8& pa2, bf16x8& pa3) {
#pragma unroll
  for (int r = 0; r < 16; ++r) p1[r] = __builtin_amdgcn_exp2f(p1[r]);
  float ps = 0;
#pragma unroll
  for (int r = 0; r < 16; ++r) ps += p0[r];
#pragma unroll
  for (int r = 0; r < 16; ++r) ps += p1[r];
  { auto rr = __builtin_amdgcn_permlane32_swap(__float_as_uint(ps), __float_as_uint(ps), false, false);
    ps = __uint_as_float(rr[0]) + __uint_as_float(rr[1]); }
  l_reg = l_reg * alpha + ps;
#define PK4(P, BASE, OUT) do { unsigned a0 = cvtpk(P[BASE + 0], P[BASE + 1]), a1 = cvtpk(P[BASE + 2], P[BASE + 3]);   \
    unsigned b0 = cvtpk(P[BASE + 4], P[BASE + 5]), b1 = cvtpk(P[BASE + 6], P[BASE + 7]);                              \
    auto r0 = __builtin_amdgcn_permlane32_swap(a0, b0, false, false); auto r1 = __builtin_amdgcn_permlane32_swap(a1, b1, false, false); \
    u32x4 w = {r0[0], r1[0], r0[1], r1[1]}; OUT = *reinterpret_cast<bf16x8*>(&w); } while (0)
  PK4(p0, 0, pa0); PK4(p0, 8, pa1); PK4(p1, 0, pa2); PK4(p1, 8, pa3);
#undef PK4
}
__device__ __forceinline__ void qkt(f32x16& p0, f32x16& p1, const char* Ks, const bf16x8* qr, int r32, int hi) {
  p0 = f32x16{}; p1 = f32x16{};
#pragma unroll
  for (int d0 = 0; d0 < 6; ++d0) { int cb = (d0 * 16 + hi * 8) * 2;
    bf16x8 b0 = *reinterpret_cast<const bf16x8*>(Ks + KSWZ(r32, cb));
    bf16x8 b1 = *reinterpret_cast<const bf16x8*>(Ks + KSWZ(32 + r32, cb));
    p0 = __builtin_amdgcn_mfma_f32_32x32x16_bf16(b0, qr[d0], p0, 0, 0, 0);
    p1 = __builtin_amdgcn_mfma_f32_32x32x16_bf16(b1, qr[d0], p1, 0, 0, 0); }
}
__device__ __forceinline__ int v_st(int k, int c) { const int kk = (k & ~0xC) | ((k & 4) << 1) | ((k & 8) >> 1); return ((kk >> 3) * 4 + (c >> 5)) * 512 + ((kk & 7) * 32 + (c & 31)) * 2; }
__device__ __forceinline__ int v_rd_base(int lane) { return ((lane & 3) << 3) | (((lane >> 2) & 3) << 6) | (((lane >> 4) & 1) << 5) | (((lane >> 5) & 1) << 8); }
constexpr int v_rd_off(int d0, int ks, int half) { return d0 * 512 + ks * 4096 + half * 2048; }
template <int OFF> __device__ __forceinline__ s16x4 tr_read(int vb) {
  s16x4 r; asm volatile("ds_read_b64_tr_b16 %0, %1 offset:%2" : "=&v"(r) : "v"(vb), "i"(OFF) : "memory"); return r;
}
template <int D0> __device__ __forceinline__ void pv_one(f32x16& od, int vb, bf16x8 pa0, bf16x8 pa1, bf16x8 pa2, bf16x8 pa3) {
  const s16x4 l0 = tr_read<v_rd_off(D0, 0, 0)>(vb), h0 = tr_read<v_rd_off(D0, 0, 1)>(vb), l1 = tr_read<v_rd_off(D0, 1, 0)>(vb), h1 = tr_read<v_rd_off(D0, 1, 1)>(vb);
  const s16x4 l2 = tr_read<v_rd_off(D0, 2, 0)>(vb), h2 = tr_read<v_rd_off(D0, 2, 1)>(vb), l3 = tr_read<v_rd_off(D0, 3, 0)>(vb), h3 = tr_read<v_rd_off(D0, 3, 1)>(vb);
  asm volatile("s_waitcnt lgkmcnt(0)" ::: "memory"); SBAR();
#define PK(L, H) (bf16x8){L[0], L[1], L[2], L[3], H[0], H[1], H[2], H[3]}
  od = __builtin_amdgcn_mfma_f32_32x32x16_bf16(pa0, PK(l0, h0), od, 0, 0, 0);
  od = __builtin_amdgcn_mfma_f32_32x32x16_bf16(pa1, PK(l1, h1), od, 0, 0, 0);
  od = __builtin_amdgcn_mfma_f32_32x32x16_bf16(pa2, PK(l2, h2), od, 0, 0, 0);
  od = __builtin_amdgcn_mfma_f32_32x32x16_bf16(pa3, PK(l3, h3), od, 0, 0, 0);
#undef PK
}
__device__ __forceinline__ void pv_d0(f32x16* o, int vb, bf16x8 pa0, bf16x8 pa1, bf16x8 pa2, bf16x8 pa3) {
  pv_one<0>(o[0], vb, pa0, pa1, pa2, pa3); pv_one<1>(o[1], vb, pa0, pa1, pa2, pa3);
}
__device__ __forceinline__ void attn_unit(const bf16_t* __restrict__ Qb, const bf16_t* __restrict__ KVh, const bf16_t* __restrict__ KRr, bf16_t* __restrict__ Ob, int seq, char* lds) {
  int tid_ = threadIdx.x; asm volatile("" : "+v"(tid_));
  const int tid = tid_, wid = tid >> 6, lane = tid & 63, r32 = lane & 31, hi = lane >> 5;
  char* V_lds = lds; char* K_lds = lds + 2 * SHM_V;
  float* ws = (float*)(lds + 2 * SHM_V + 2 * SHM_K) + wid * 64; float* li_l = ws; float* al_l = ws + 32;
  float m_reg = -1e30f, l_reg = 0; f32x16 o[2] = {}; bf16x8 qr[6];
  const bf16_t* Qw = Qb + (long)(wid * 32 + r32) * 768 + hi * 8;
#pragma unroll
  for (int d0 = 0; d0 < 6; ++d0) qr[d0] = *reinterpret_cast<const bf16x8*>(Qw + d0 * 16);
  const int sr = tid >> 4, sc = (tid & 15) * 8, vst0 = v_st(sr, sc & 63), vst1 = v_st(32 + sr, sc & 63);
  const bool kn = sc < 64, krp = (sc >= 64 && sc < 96);
  const int vb0 = (int)(uintptr_t)V_lds + v_rd_base(lane);
  struct { bf16x8 vs0, vs1, ks0, ks1; } sr_[2];
#define SLOAD(i, k0) do { if (kn) { sr_[i].vs0 = *reinterpret_cast<const bf16x8*>(&KVh[(long)((k0) + sr) * 1024 + 64 + sc]); sr_[i].vs1 = *reinterpret_cast<const bf16x8*>(&KVh[(long)((k0) + 32 + sr) * 1024 + 64 + sc]); \
      sr_[i].ks0 = *reinterpret_cast<const bf16x8*>(&KVh[(long)((k0) + sr) * 1024 + sc]); sr_[i].ks1 = *reinterpret_cast<const bf16x8*>(&KVh[(long)((k0) + 32 + sr) * 1024 + sc]); } \
    else if (krp) { sr_[i].ks0 = *reinterpret_cast<const bf16x8*>(&KRr[(long)((k0) + sr) * 32 + sc - 64]); sr_[i].ks1 = *reinterpret_cast<const bf16x8*>(&KRr[(long)((k0) + 32 + sr) * 32 + sc - 64]); } } while (0)
#define SWRITE(b, i) do { if (kn) { *(bf16x8*)(V_lds + (b) * SHM_V + vst0) = sr_[i].vs0; *(bf16x8*)(V_lds + (b) * SHM_V + vst1) = sr_[i].vs1; } \
    if (kn || krp) { int kc = sc * 2; *(bf16x8*)(K_lds + (b) * SHM_K + KSWZ(sr, kc)) = sr_[i].ks0; *(bf16x8*)(K_lds + (b) * SHM_K + KSWZ(32 + sr, kc)) = sr_[i].ks1; } } while (0)
#define RESC(a) do { if (__any((a) < 1.f)) { if (hi == 0) al_l[r32] = (a); asm volatile("s_waitcnt lgkmcnt(0)" ::: "memory"); \
    _Pragma("unroll") for (int d = 0; d < 2; ++d) _Pragma("unroll") for (int r = 0; r < 16; ++r) o[d][r] *= al_l[crow(r, hi)]; } } while (0)
  f32x16 pA0, pA1, pB0, pB1; float mnA, mnB, alA, alB; bf16x8 pa0, pa1, pa2, pa3; const int NT = seq / KVBLK;
  SLOAD(0, 0); SWRITE(0, 0); __syncthreads();
  qkt(pA0, pA1, K_lds, qr, r32, hi); partialSM(pA0, pA1, m_reg, mnA, alA);
  SLOAD(1, KVBLK); if (2 < NT) SLOAD(0, 2 * KVBLK);
  SWRITE(1, 1); __syncthreads();
  for (int j = 1; j + 1 < NT; j += 2) {
    SBAR(); qkt(pB0, pB1, K_lds + SHM_K, qr, r32, hi);
    finishSM(pA0, pA1, alA, l_reg, pa0, pa1, pa2, pa3); SBAR();
    SLOAD(1, (j + 2) * KVBLK); SBAR();
    pv_d0(o, vb0, pa0, pa1, pa2, pa3); partialSM(pB0, pB1, m_reg, mnB, alB);
    __syncthreads(); SWRITE(0, 0);
    RESC(alB); __syncthreads();
    SBAR(); qkt(pA0, pA1, K_lds, qr, r32, hi);
    finishSM(pB0, pB1, alB, l_reg, pa0, pa1, pa2, pa3); SBAR();
    if (j + 3 < NT) SLOAD(0, (j + 3) * KVBLK); SBAR();
    pv_d0(o, vb0 + SHM_V, pa0, pa1, pa2, pa3); partialSM(pA0, pA1, m_reg, mnA, alA);
    __syncthreads(); SWRITE(1, 1);
    RESC(alA); __syncthreads();
  }
  SBAR(); qkt(pB0, pB1, K_lds + SHM_K, qr, r32, hi);
  finishSM(pA0, pA1, alA, l_reg, pa0, pa1, pa2, pa3); SBAR();
  pv_d0(o, vb0, pa0, pa1, pa2, pa3); partialSM(pB0, pB1, m_reg, mnB, alB);
  __syncthreads(); RESC(alB);
  finishSM(pB0, pB1, alB, l_reg, pa0, pa1, pa2, pa3); SBAR();
  pv_d0(o, vb0 + SHM_V, pa0, pa1, pa2, pa3);
  if (hi == 0) li_l[r32] = l_reg; asm volatile("s_waitcnt lgkmcnt(0)" ::: "memory");
  float rli[16];
#pragma unroll
  for (int r = 0; r < 16; ++r) rli[r] = __builtin_amdgcn_rcpf(li_l[crow(r, hi)]);
  bf16_t* Ow = Ob + (long)(wid * 32) * 512;
#pragma unroll
  for (int r = 0; r < 16; ++r) { int orow = crow(r, hi);
#pragma unroll
    for (int d0 = 0; d0 < 2; ++d0) Ow[(long)orow * 512 + d0 * 32 + r32] = (bf16_t)f2bf(o[d0][r] * rli[r]); }
  __syncthreads();
#undef SLOAD
#undef SWRITE
#undef RESC
}
#undef KSWZ
#undef SBAR
}

struct Args { const float* in[29]; float* out; unsigned char* ws; int ph_lo, ph_hi, use_bar, pad; };
enum { I_XP = 0, I_XS, I_CCKV, I_CKR, I_C, I_CCTX, I_WADA, I_BADA, I_NORMG, I_WUP, I_WDN, I_WIN, I_HCW, I_HCB, I_FW1, I_FB1, I_FW2, I_FB2, I_FW3, I_SKIP,
       I_WHY, I_QNG, I_WQB, I_KVNG, I_WKVB, I_WMLA, I_WFN, I_WOUT, I_FING };

struct Frame {
    LAS unsigned char* lds; char* ldsg;
    int G, bid;
    unsigned char* ws;
};
#define WSP(T, off) ((T*)(F.ws + (off)))
#define TLW() int tid_ = threadIdx.x; asm volatile("" : "+v"(tid_)); const int tid = tid_, lane = tid & 63, wave = __builtin_amdgcn_readfirstlane(tid >> 6); (void)lane; (void)wave
__device__ __forceinline__ const float* argin(int i) { size_t off = (size_t)i * 8; asm volatile("" : "+s"(off)); const __attribute__((address_space(4))) char* k = (const __attribute__((address_space(4))) char*)__builtin_amdgcn_kernarg_segment_ptr(); return (const float*)(*(const GAS float* const __attribute__((address_space(4)))*)(k + off)); }
#define AIN(i) argin(i)

enum { CK_ID = 0, CK_UP, CK_IN, CK_QB };
__device__ __forceinline__ bf16_t* conv_dst(int kind, bf16_t* d0, bf16_t* d1, int ldd, int n) {
    if (kind == CK_ID) return d0 + (size_t)n * ldd;
    if (kind == CK_UP) { const int isU = n >= DFF, f = n - DFF * isU; const int R = (f >> 7) * 256 + ((f >> 6) & 1) * 128 + ((f >> 4) & 3) * 32 + 16 * isU + (f & 15); return d0 + (size_t)R * ldd; }
    if (kind == CK_IN) {
        if (n < 768) return d1 + (size_t)n * ldd;
        if (n < 1024) return d0 + (size_t)(n - 768) * ldd;
        if (n < 1152) return d0 + (size_t)(256 + n - 1024) * ldd;
        if (n < 1184) { const int p = n - 1152, part = p >> 4, w = p & 15, half = w >> 3, i = w & 7; return d0 + (size_t)(384 + part * 16 + 2 * i + half) * ldd; }
        if (n < 1440) return nullptr;
        return d0 + (size_t)(512 + n - 1440) * ldd;
    }
    { const int h = n / 96, w96 = n - h * 96; int d = w96;
      if (w96 >= 64) { const int p = w96 - 64, part = p >> 4, w = p & 15, half = w >> 3, i = w & 7; d = 64 + part * 16 + 2 * i + half; }
      return d0 + (size_t)(h * 96 + d) * ldd; }
}
__device__ __forceinline__ void conv_item(const float* W, int ldw, int ncols, int k0, int n0, int kind, bf16_t* d0, bf16_t* d1, int ldd, const float* kscale, bf16_t* dextra, LAS float* scr, int lane) {
    const int lr = lane >> 4, lc = (lane & 15) * 4;
    const bool cok = (n0 + lc) < ncols;
    f32x4 v[16];
#pragma unroll
    for (int i = 0; i < 16; ++i) v[i] = cok ? *(const f32x4*)(W + (size_t)(k0 + i * 4 + lr) * ldw + n0 + lc) : (f32x4){0.f, 0.f, 0.f, 0.f};
#pragma unroll
    for (int i = 0; i < 16; ++i) *(LAS f32x4*)(scr + (i * 4 + lr) * 68 + lc) = v[i];
    asm volatile("s_waitcnt lgkmcnt(0)" ::: "memory");
    const int n = n0 + lane;
    bf16_t* dp = (n < ncols) ? conv_dst(kind, d0, d1, ldd, n) : nullptr;
#pragma unroll
    for (int c = 0; c < 8; ++c) {
        float x[8];
#pragma unroll
        for (int e2 = 0; e2 < 8; ++e2) x[e2] = scr[(8 * c + e2) * 68 + lane];
        if (dp) {
            if (dextra) { u32x4 r; r.x = cvtpk(x[0], x[1]); r.y = cvtpk(x[2], x[3]); r.z = cvtpk(x[4], x[5]); r.w = cvtpk(x[6], x[7]); *(u32x4*)(dextra + (size_t)n * ldd + k0 + 8 * c) = r; }
            if (kscale) {
#pragma unroll
                for (int e2 = 0; e2 < 8; ++e2) x[e2] *= kscale[k0 + 8 * c + e2]; }
            u32x4 o; o.x = cvtpk(x[0], x[1]); o.y = cvtpk(x[2], x[3]); o.z = cvtpk(x[4], x[5]); o.w = cvtpk(x[6], x[7]);
            *(u32x4*)(dp + k0 + 8 * c) = o; }
    }
    asm volatile("s_waitcnt lgkmcnt(0)" ::: "memory");
}

__device__ __forceinline__ void p0_phase(Frame& F, const Args& A) {
    TLW();
    LAS float* scr = (LAS float*)(F.lds + wave * 17408);
    const int gw = F.bid * NWAVES + wave, NGW = F.G * NWAVES;
    const int gt = F.bid * NTHR + tid, NGT = F.G * NTHR;
    {
        constexpr int I_UP = 16 * 88, I_DN = 44 * 16, I_IN = 16 * 71, I_QB = 4 * 12, I_KVB = 2 * 16, I_HY = 4 * 16, I_MLA = 8 * 16, I_FN = 4 * 16, I_OUT = 16 * 16;
        constexpr int PER_L = 2 * I_UP + 2 * I_DN + I_IN + I_QB + I_KVB + I_HY + I_MLA + I_FN + I_OUT;
        for (int it = gw; it < 2 * PER_L; it += NGW) {
            const int l = it / PER_L; int r = it - l * PER_L;
            if (r < 2 * I_UP) { const int f = r / I_UP; r -= f * I_UP; const int nb = 88, kb = r / nb, n_ = r % nb;
                conv_item(AIN(I_WUP) + (size_t)(l * 2 + f) * DM * NUP, NUP, NUP, kb * 64, n_ * 64, CK_UP, WSP(bf16_t, WS_WUP) + (size_t)(l * 2 + f) * NUP * DM, nullptr, DM, nullptr, nullptr, scr, lane); continue; }
            r -= 2 * I_UP;
            if (r < 2 * I_DN) { const int f = r / I_DN; r -= f * I_DN; const int nb = 16, kb = r / nb, n_ = r % nb;
                conv_item(AIN(I_WDN) + (size_t)(l * 2 + f) * DFF * DM, DM, DM, kb * 64, n_ * 64, CK_ID, WSP(bf16_t, WS_WDN) + (size_t)(l * 2 + f) * DM * DFF, nullptr, DFF, nullptr, nullptr, scr, lane); continue; }
            r -= 2 * I_DN;
            if (r < I_IN) { const int nb = 71, kb = r / nb, n_ = r % nb;
                conv_item(AIN(I_WIN) + (size_t)l * DM * INC, INC, INC, kb * 64, n_ * 64, CK_IN, WSP(bf16_t, WS_W1T) + (size_t)l * N1 * DM, WSP(bf16_t, WS_W2T) + (size_t)l * N2 * DM, DM, nullptr, nullptr, scr, lane); continue; }
            r -= I_IN;
            if (r < I_QB) { const int nb = 12, kb = r / nb, n_ = r % nb;
                conv_item(AIN(I_WQB) + (size_t)l * 256 * 768, 768, 768, kb * 64, n_ * 64, CK_QB, WSP(bf16_t, WS_WQB) + (size_t)l * 768 * 256, nullptr, 256, AIN(I_QNG) + l * 256, nullptr, scr, lane); continue; }
            r -= I_QB;
            if (r < I_KVB) { const int nb = 16, kb = r / nb, n_ = r % nb;
                conv_item(AIN(I_WKVB) + (size_t)l * 128 * 1024, 1024, 1024, kb * 64, n_ * 64, CK_ID, WSP(bf16_t, WS_WKVB) + (size_t)l * 1024 * 256, nullptr, 256, AIN(I_KVNG) + l * 128, WSP(bf16_t, WS_WKVR) + (size_t)l * 1024 * 256, scr, lane); continue; }
            r -= I_KVB;
            if (r < I_HY) { const int nb = 16, kb = r / nb, n_ = r % nb;
                conv_item(AIN(I_WHY) + (size_t)l * 256 * 1024, 1024, 1024, kb * 64, n_ * 64, CK_ID, WSP(bf16_t, WS_WHY) + (size_t)l * 1024 * 256, nullptr, 256, nullptr, nullptr, scr, lane); continue; }
            r -= I_HY;
            if (r < I_MLA) { const int nb = 16, kb = r / nb, n_ = r % nb;
                conv_item(AIN(I_WMLA) + (size_t)l * 512 * 1024, 1024, 1024, kb * 64, n_ * 64, CK_ID, WSP(bf16_t, WS_WMLA) + (size_t)l * 1024 * 512, nullptr, 512, nullptr, nullptr, scr, lane); continue; }
            r -= I_MLA;
            if (r < I_FN) { const int nb = 16, kb = r / nb, n_ = r % nb;
                conv_item(AIN(I_WFN) + (size_t)l * 256 * 1024, 1024, 1024, kb * 64, n_ * 64, CK_ID, WSP(bf16_t, WS_WFN) + (size_t)l * 1024 * 256, nullptr, 256, nullptr, nullptr, scr, lane); continue; }
            r -= I_FN;
            { const int nb = 16, kb = r / nb, n_ = r % nb;
                conv_item(AIN(I_WOUT) + (size_t)l * 1024 * 1024, 1024, 1024, kb * 64, n_ * 64, CK_ID, WSP(bf16_t, WS_WOUT) + (size_t)l * 1024 * 1024, nullptr, 1024, nullptr, nullptr, scr, lane); }
        }
    }
    __syncthreads();
    LAS float* scv = (LAS float*)(F.lds);
    LAS float* ctab = (LAS float*)(F.lds + 16384);
    for (int i = tid; i < 3 * DM; i += NTHR) { const int g = i >> 10, k = i & 1023; const float c = (g == 0) ? AIN(I_CCTX)[k] : AIN(I_C)[(g - 1) * DM + k]; scv[i] = siluf_(c); }
    for (int i = tid; i < 2048; i += NTHR) ctab[i] = cospif((float)i * (1.0f / 1024.0f));
    __syncthreads();
    for (int it = gw; it < 2 * 4 * 16 * 4; it += NGW) {
        const int mq = it & 3, kc = (it >> 2) & 15, g = (it >> 6) & 3, l = it >> 8; const int k = kc * 64 + lane;
        const float* src = AIN(I_WIN) + (size_t)l * DM * INC + (size_t)k * INC + 1184 + g * 64;
        float x[64];
#pragma unroll
        for (int j = 0; j < 16; ++j) { const f32x4 v = *(const f32x4*)(src + 4 * j); x[4 * j] = v[0]; x[4 * j + 1] = v[1]; x[4 * j + 2] = v[2]; x[4 * j + 3] = v[3]; }
        bf16_t* dst = WSP(bf16_t, WS_W2T) + (size_t)l * N2 * DM;
        for (int mm = 0; mm < 16; ++mm) { const int m = mq * 16 + mm; float sc_ = 0.f, ss_ = 0.f;
#pragma unroll
            for (int j = 0; j < 64; ++j) { const int ph = (j * m) & 63; sc_ += x[j] * ctab[ph * 32]; ss_ += x[j] * ctab[((ph + 48) & 63) * 32]; }
            dst[(size_t)(768 + g * 64 + m) * DM + k] = (bf16_t)f2bf(sc_); dst[(size_t)(1024 + g * 64 + m) * DM + k] = (bf16_t)f2bf(ss_); }
    }
    for (int it = gw; it < 2 * 16 * 36; it += NGW) {
        const int cc = it % 36, kc = (it / 36) & 15, l = it / (36 * 16);
        const float* wp = AIN(I_WADA) + (size_t)l * DM * NADA + (size_t)(kc * 64) * NADA + cc * 256 + lane * 4;
        f32x4 a0 = {0, 0, 0, 0}, a1 = a0, a2 = a0;
#pragma unroll 8
        for (int k = 0; k < 64; ++k) { const f32x4 w = *(const f32x4*)(wp + (size_t)k * NADA); const int kk = kc * 64 + k; a0 += w * scv[kk]; a1 += w * scv[1024 + kk]; a2 += w * scv[2048 + kk]; }
        float* op = WSP(float, WS_ADAP) + ((size_t)(kc * 2 + l) * 3) * NADA + cc * 256 + lane * 4;
        *(f32x4*)op = a0; *(f32x4*)(op + NADA) = a1; *(f32x4*)(op + 2 * NADA) = a2;
    }
    for (int it = gw; it < 2 * 288; it += NGW) {
        const int l = it / 288, r0 = (it % 288) * 8;
        const float* W1 = AIN(I_FW1) + l * 17 * 64; const float* W2 = AIN(I_FW2) + l * 64 * 64;
        float w1c[17], w2c[64];
#pragma unroll
        for (int i = 0; i < 17; ++i) w1c[i] = W1[i * 64 + lane];
#pragma unroll
        for (int k = 0; k < 64; ++k) w2c[k] = W2[k * 64 + lane];
        const float b1 = AIN(I_FB1)[l * 64 + lane], b2 = AIN(I_FB2)[l * 64 + lane];
        for (int rr = 0; rr < 8; ++rr) { const int row = r0 + rr; const int L = row < 256 ? 256 : 2048, t = row < 256 ? row : row - 256;
            float feat = 0.f;
            { const float tn = (float)t / (float)(L - 1), w = 6.283185307179586f * (float)t / (float)L;
              const int bi = (lane >= 9) ? lane - 9 : lane - 1; const float band = 1e-4f + (float)bi * ((7.0f - 1e-4f) / 7.0f); const float ang = w * band;
              feat = (lane == 0) ? tn : ((lane <= 8) ? cosf(ang) : -sinf(ang)); }
            float h1 = b1;
#pragma unroll
            for (int i = 0; i < 17; ++i) h1 += __builtin_bit_cast(float, __builtin_amdgcn_readlane(__builtin_bit_cast(int, feat), i)) * w1c[i];
            h1 = sinf(h1);
            float h2 = b2;
#pragma unroll
            for (int k = 0; k < 64; ++k) h2 += __builtin_bit_cast(float, __builtin_amdgcn_readlane(__builtin_bit_cast(int, h1), k)) * w2c[k];
            h2 = sinf(h2);
            WSP(float, WS_H2)[((size_t)l * 2304 + row) * 64 + lane] = h2; }
    }
    if (F.bid == 0) { const int pos = tid >> 3, i = tid & 7; const float inv = exp2f(-(float)i * (13.287712379549449f / 8.0f)); float s, c; sincosf((float)pos * inv, &s, &c);
        WSP(float, WS_ROPE)[(pos * 8 + i) * 2] = c; WSP(float, WS_ROPE)[(pos * 8 + i) * 2 + 1] = s; }
    for (int it = gt; it < 2048 * 512 + 256 * 64; it += NGT) {
        const bool isl = it < 2048 * 512; const int L = isl ? 2048 : 256, j = isl ? it : it - 2048 * 512, per = 2 * L / 8, k = j / per, t8 = (j % per) * 8, sh = isl ? 0 : 3;
        float v[8];
#pragma unroll
        for (int e = 0; e < 8; ++e) { const int tt = t8 + e, isS = tt >= L, t = tt - isS * L; const int ph = (k * t) & (L - 1);
            v[e] = isS ? -ctab[(((ph - L / 4) & (L - 1)) << sh)] : ctab[ph << sh]; }
        u32x4 o; o.x = pk2(v[0], v[1]); o.y = pk2(v[2], v[3]); o.z = pk2(v[4], v[5]); o.w = pk2(v[6], v[7]);
        *(u32x4*)((isl ? WSP(bf16_t, WS_DFTL) : WSP(bf16_t, WS_DFTC)) + (size_t)k * 2 * L + t8) = o;
    }
    for (int it = gt; it < 2 * 1024 * 32; it += NGT) { const int c8 = (it & 31) * 8, row = (it >> 5) & 1023, l = it >> 15; const int b = row >> 9, j = row & 511;
        u32x4 o = {0, 0, 0, 0};
        if (c8 < 128) { const float* sp = AIN(I_CCKV) + ((size_t)((b * 2 + l) * 512 + j)) * 128 + c8; const f32x4 x = *(const f32x4*)sp, y = *(const f32x4*)(sp + 4);
            o.x = pk2(x[0], x[1]); o.y = pk2(x[2], x[3]); o.z = pk2(y[0], y[1]); o.w = pk2(y[2], y[3]); }
        *(u32x4*)(WSP(bf16_t, WS_CKVB) + ((size_t)l * 1024 + row) * 256 + c8) = o; }
    for (int it = gt; it < 2 * 96 * 128; it += NGT) { const int c8 = (it & 127) * 8, r = (it >> 7) % 96, l = it / (96 * 128);
        *(u32x4*)(WSP(bf16_t, WS_W1T) + ((size_t)l * N1 + 416 + r) * DM + c8) = (u32x4){0, 0, 0, 0}; }
    for (int it = gt; it < 2 * 2 * 1024 * 16; it += NGT) { const int c8 = 128 + (it & 15) * 8, r = (it >> 4) & 1023, l = (it >> 14) & 1, wsel = it >> 15;
        *(u32x4*)((wsel ? WSP(bf16_t, WS_WKVR) : WSP(bf16_t, WS_WKVB)) + ((size_t)l * 1024 + r) * 256 + c8) = (u32x4){0, 0, 0, 0}; }
    __syncthreads();
}

__device__ __forceinline__ void norm_phase(Frame& F, const Args& A, int l, int which, bool first, bool from_partials) {
    TLW();
    LAS float* gm = (LAS float*)(F.lds);
    LAS float* sv = (LAS float*)(F.lds + 12288);
    for (int i = tid; i < 3 * DM; i += NTHR) { const int g = i >> 10, c = i & 1023; float s, sc;
        if (from_partials) { s = AIN(I_BADA)[l * NADA + (3 * which) * DM + c]; sc = AIN(I_BADA)[l * NADA + (3 * which + 1) * DM + c];
            for (int kc = 0; kc < 16; ++kc) { const float* pp = WSP(float, WS_ADAP) + ((size_t)(kc * 2 + l) * 3 + g) * NADA; s += pp[(3 * which) * DM + c]; sc += pp[(3 * which + 1) * DM + c]; } }
        else { const float* ad = WSP(float, WS_ADA) + ((size_t)l * 3 + g) * NADA; s = ad[(3 * which) * DM + c]; sc = ad[(3 * which + 1) * DM + c]; }
        gm[i] = AIN(I_NORMG)[(l * 3 + which) * DM + c] * (1.0f + sc); sv[i] = s; }
    __syncthreads();
    const int gw = F.bid * NWAVES + wave, NGW = F.G * NWAVES;
    for (int r = gw; r < MTOK; r += NGW) {
        const float* src = first ? (r < NCTX ? AIN(I_XP) + (size_t)r * DM : AIN(I_XS) + (size_t)(r - NCTX) * DM) : WSP(float, WS_H) + (size_t)r * DM;
        const int g = r < NCTX ? 0 : 1 + ((r - NCTX) >> 11);
        f32x4 v[4]; float s = 0.f;
#pragma unroll
        for (int j = 0; j < 4; ++j) { v[j] = *(const f32x4*)(src + 4 * lane + 256 * j); s += (v[j][0] * v[j][0] + v[j][1] * v[j][1]) + (v[j][2] * v[j][2] + v[j][3] * v[j][3]); }
        const float rstd = 1.0f / sqrtf(wave_sum(s) * (1.0f / DM) + EPSV);
        bf16_t* np = WSP(bf16_t, WS_N) + (size_t)r * DM;
#pragma unroll
        for (int j = 0; j < 4; ++j) { const int c = 4 * lane + 256 * j; const f32x4 gg = *(const LAS f32x4*)(gm + g * DM + c), ss = *(const LAS f32x4*)(sv + g * DM + c);
            const f32x4 y = v[j] * rstd * gg + ss; u32x2 w; w.x = cvtpk(y[0], y[1]); w.y = cvtpk(y[2], y[3]); *(u32x2*)(np + c) = w;
            if (first) *(f32x4*)(WSP(float, WS_H) + (size_t)r * DM + c) = v[j]; }
    }
    __syncthreads();
}
__device__ __forceinline__ void final_norm_phase(Frame& F, const Args& A) {
    TLW();
    const int gw = F.bid * NWAVES + wave, NGW = F.G * NWAVES;
    for (int r = gw; r < MTOK; r += NGW) {
        const float* src = WSP(float, WS_H) + (size_t)r * DM;
        f32x4 v[4]; float s = 0.f;
#pragma unroll
        for (int j = 0; j < 4; ++j) { v[j] = *(const f32x4*)(src + 4 * lane + 256 * j); s += (v[j][0] * v[j][0] + v[j][1] * v[j][1]) + (v[j][2] * v[j][2] + v[j][3] * v[j][3]); }
        const float rstd = 1.0f / sqrtf(wave_sum(s) * (1.0f / DM) + EPSV);
#pragma unroll
        for (int j = 0; j < 4; ++j) { const int c = 4 * lane + 256 * j; const f32x4 gg = *(const f32x4*)(AIN(I_FING) + c); *(f32x4*)(A.out + (size_t)r * DM + c) = v[j] * rstd * gg; }
    }
}

__device__ __forceinline__ void p0b_phase(Frame& F, const Args& A) {
    TLW();
    const int gt = F.bid * NTHR + tid, NGT = F.G * NTHR, gw = F.bid * NWAVES + wave, NGW = F.G * NWAVES;
    for (int it = gt; it < 2 * 3 * NADA; it += NGT) { const int c = it % NADA, g = (it / NADA) % 3, l = it / (3 * NADA); float s = AIN(I_BADA)[l * NADA + c];
        for (int kc = 0; kc < 16; ++kc) s += WSP(float, WS_ADAP)[((size_t)(kc * 2 + l) * 3 + g) * NADA + c];
        WSP(float, WS_ADA)[((size_t)l * 3 + g) * NADA + c] = s; }
    LAS float* tl = (LAS float*)(F.lds + wave * 16384);
    for (int it = gw; it < 2 * 36 * 16; it += NGW) {
        const int cc = it & 15, rc = (it >> 4) % 36, l = it / (36 * 16); const int L = rc < 4 ? 256 : 2048, t0 = rc < 4 ? rc * 64 : rc * 64 - 256;
        const float* W3 = AIN(I_FW3) + (size_t)l * 64 * 1024 + cc * 64 + lane;
        float w[64];
#pragma unroll
        for (int k = 0; k < 64; ++k) w[k] = W3[k * 1024];
        const float* hp = WSP(float, WS_H2) + ((size_t)l * 2304 + rc * 64) * 64;
#pragma unroll 2
        for (int tt = 0; tt < 64; ++tt) { float s = 0.f;
#pragma unroll
            for (int k = 0; k < 64; ++k) s += hp[tt * 64 + k] * w[k];
            tl[tt * 64 + (lane ^ tt)] = s; }
        asm volatile("s_waitcnt lgkmcnt(0)" ::: "memory");
        const int t = t0 + lane; const float tn = (float)t / (float)(L - 1);
        float* fb = WSP(float, WS_FILT) + (size_t)l * FILT_LAYER + (rc < 4 ? (size_t)512 * 4096 : 0);
        for (int ci = 0; ci < 64; ++ci) { const int col = cc * 64 + ci, ch = col & 255, oc = col & 511, dir = col >> 9;
            const float delta = -3.0701134573253944f + (float)ch * ((-15.350567286626972f + 3.0701134573253944f) / 255.0f);
            const float s = tl[lane * 64 + (ci ^ lane)] * expf(-tn * fabsf(delta));
            float* fr = fb + (size_t)oc * (2 * L);
            if (dir == 0) fr[L + t] = s; else if (t > 0) fr[L - t] = s; else fr[0] = 0.f; }
        asm volatile("s_waitcnt lgkmcnt(0)" ::: "memory");
    }
}

#ifndef HYP
#define HYP 0
#endif
constexpr int HY_HCS = 8176;
constexpr int HY_IMG = 17472;
constexpr int HY_HC = 0, HY_HV = 8 * HY_HCS, HY_HZ = HY_HV + HY_IMG, HY_X1 = HY_HZ + HY_IMG, HY_X2 = HY_X1 + 8192, HY_ST = HY_X2 + 8192, HY_TB = HY_ST + 32768, HY_END = HY_TB + 8192;
static_assert(HY_END <= MISC_OFF, "hyena LDS map");
struct HyPre { u32x4 raw[3]; float xm[3], xp[3]; f32x4 ta, tb; };
__device__ __forceinline__ void hyena_unit(Frame& F, const Args& A, int l, int unit, int nrun = 4) {
    TLW();
    const bool lat = unit < 64; const int nch = 4, c0 = (lat ? unit : unit - 64) * 4;
    const int L = lat ? 2048 : 256, tokbase = lat ? NCTX : 0, NQ = lat ? 512 : 64;
    LAS unsigned char* lds = F.lds;
    volatile LAS float* red = (volatile LAS float*)(lds + MISC_OFF + 64);
    const bf16_t* hyt = WSP(bf16_t, WS_HYT);
    const float* filt = WSP(float, WS_FILT) + (size_t)l * FILT_LAYER + (lat ? 0 : (size_t)512 * 4096);
    const int ntap = 2 * L;
    for (int i = tid; i < (2 * HY_IMG) / 16; i += NTHR) *(LAS u32x4*)(lds + HY_HV + i * 16) = (u32x4){0, 0, 0, 0};
    LAS float* cwl = (LAS float*)(lds + MISC_OFF + 128);
    if (tid < 48) { const int e = tid & 3, ws_ = (tid >> 2) % 3, cc_ = (tid / 12) < nch ? tid / 12 : 0, chn = (ws_ == 0 ? 512 : (ws_ == 1 ? 0 : 256)) + c0 + cc_;
        cwl[tid] = e < 3 ? AIN(I_HCW)[(size_t)l * 3 * 768 + e * 768 + chn] : AIN(I_HCB)[l * 768 + chn]; }
    else if (tid < 56) { const int o_ = tid & 1, cc_ = ((tid - 48) >> 1) < nch ? (tid - 48) >> 1 : 0; cwl[tid] = AIN(I_SKIP)[(l * 2 + o_) * 256 + c0 + cc_]; }
    const int rho = wave, rp = lane & 15, g4 = lane >> 4;
    LAS unsigned char* HCw = lds + HY_HC + wave * HY_HCS - 16;
    const int idx8 = tid * 8, pos8 = idx8 & (L - 1), b8 = idx8 / L;
    const int eoffm = pos8 > 0 ? -1 : 0, eoffp = (pos8 + 8 < L) ? 8 : 0;
    const float emm = pos8 > 0 ? 1.f : 0.f, epm = (pos8 + 8 < L) ? 1.f : 0.f;
    const bool tapok = idx8 < ntap; const int tapoff = tapok ? idx8 : 0; const float tapm = tapok ? 1.f : 0.f;
    u32x4 raw0, raw1, raw2; unsigned short xm0, xm1, xm2, xp0, xp1, xp2; f32x4 ta, tb;
#define HY_LOADHY(cc) do { const bf16_t* h0_ = hyt + (size_t)(512 + (cc)) * MTOK + tokbase + idx8; const bf16_t* h1_ = hyt + (size_t)(cc) * MTOK + tokbase + idx8; const bf16_t* h2_ = hyt + (size_t)(256 + (cc)) * MTOK + tokbase + idx8; \
        raw0 = *(const u32x4*)h0_; raw1 = *(const u32x4*)h1_; raw2 = *(const u32x4*)h2_; \
        xm0 = h0_[eoffm]; xm1 = h1_[eoffm]; xm2 = h2_[eoffm]; xp0 = h0_[eoffp]; xp1 = h1_[eoffp]; xp2 = h2_[eoffp]; } while (0)
#define HY_LOADTAPS(oo, cc) do { const float* fp_ = filt + (size_t)((oo) * 256 + (cc)) * ntap + tapoff; ta = *(const f32x4*)fp_; tb = *(const f32x4*)(fp_ + 4); } while (0)
#define HY_PUTTAPS(oo, TA, TB) do { TA = TA * tapm; TB = TB * tapm; const float as_ = (fabsf(TA[0]) + fabsf(TA[1])) + (fabsf(TA[2]) + fabsf(TA[3])) + (fabsf(TB[0]) + fabsf(TB[1])) + (fabsf(TB[2]) + fabsf(TB[3])); \
        const float ws_ = wave_sum(as_); if (lane == 0) red[(oo) * 8 + wave] = ws_; \
        if (tapok) *(LAS u32x4*)(lds + HY_TB + idx8 * 2) = pack8(TA, TB); } while (0)
#define HY_CONV(raw, xm_, xp_, wsel, dstoff, isimg) do { const f32x4 cw4_ = *(const LAS f32x4*)(cwl + (ci * 3 + (wsel)) * 4); const float w0_ = cw4_[0], w1_ = cw4_[1], w2_ = cw4_[2], bb_ = cw4_[3]; \
        float x_[10]; x_[0] = bf2f(xm_) * emm; x_[1] = bflo(raw.x); x_[2] = bfhi(raw.x); x_[3] = bflo(raw.y); x_[4] = bfhi(raw.y); x_[5] = bflo(raw.z); x_[6] = bfhi(raw.z); x_[7] = bflo(raw.w); x_[8] = bfhi(raw.w); x_[9] = bf2f(xp_) * epm; \
        float u_[8]; _Pragma("unroll") for (int e = 0; e < 8; ++e) u_[e] = x_[e] * w0_ + x_[e + 1] * w1_ + x_[e + 2] * w2_ + bb_; \
        u32x4 o_; o_.x = cvtpk(u_[0], u_[1]); o_.y = cvtpk(u_[2], u_[3]); o_.z = cvtpk(u_[4], u_[5]); o_.w = cvtpk(u_[6], u_[7]); \
        if (isimg) { const int J_ = pos8 >> 7, bo_ = lat ? b8 * 8832 + (7 + J_) * 288 : (b8 * 2 + J_) * 272; *(LAS u32x4*)(lds + (dstoff) + bo_ + (pos8 & 127) * 2) = o_; } \
        else *(LAS u32x4*)(lds + (dstoff) + idx8 * 2) = o_; } while (0)
    f32x4 tc, td;
#define HY_BAR() asm volatile("s_waitcnt lgkmcnt(0)\n\ts_barrier" ::: "memory")
    HY_LOADHY(c0); HY_LOADTAPS(0, c0);
    { const float* fp_ = filt + (size_t)(256 + c0) * ntap + tapoff; tc = *(const f32x4*)fp_; td = *(const f32x4*)(fp_ + 4); }
    __syncthreads();
#pragma unroll 1
    for (int ci = 0; ci < nrun; ++ci) {
        const int c = c0 + ci, cn = (ci + 1 < nch) ? c + 1 : c;
#pragma unroll 1
        for (int rc_ = 0; rc_ < ((HYP & 8) ? 2 : 1); ++rc_) {
        HY_CONV(raw0, xm0, xp0, 0, HY_HV, true); HY_CONV(raw1, xm1, xp1, 1, HY_X1, false); HY_CONV(raw2, xm2, xp2, 2, HY_X2, false);
        HY_PUTTAPS(0, ta, tb); }
        HY_LOADHY(cn); HY_LOADTAPS(0, cn);
        HY_BAR();
#pragma unroll 1
        for (int ord = 0; ord < 2; ++ord) {
            for (int rb_ = 0; rb_ < ((HYP & 2) ? 2 : 1); ++rb_)
            for (int qi = lane; qi < NQ; qi += 64) { if (qi == 0) continue; const int h0 = 8 * (qi - NQ / 2) + rho + L - 7;
                const LAS unsigned* tw = (const LAS unsigned*)(lds + HY_TB) + (h0 >> 1);
                unsigned w0 = tw[0], w1 = tw[1], w2 = tw[2], w3 = tw[3], w4 = tw[4];
                if (h0 & 1) { w0 = __builtin_amdgcn_alignbit(w1, w0, 16); w1 = __builtin_amdgcn_alignbit(w2, w1, 16); w2 = __builtin_amdgcn_alignbit(w3, w2, 16); w3 = __builtin_amdgcn_alignbit(w4, w3, 16); }
                u32x4 o; o.x = __builtin_amdgcn_alignbit(w3, w3, 16); o.y = __builtin_amdgcn_alignbit(w2, w2, 16); o.z = __builtin_amdgcn_alignbit(w1, w1, 16); o.w = __builtin_amdgcn_alignbit(w0, w0, 16);
                *(LAS u32x4*)(HCw + qi * 16) = o; }
            float nsum = 0.f;
#pragma unroll
            for (int w = 0; w < 8; ++w) nsum += red[ord * 8 + w];
            const float inv = 1.0f / (nsum + EPSV);
            asm volatile("s_waitcnt lgkmcnt(0)" ::: "memory");
            const LAS unsigned char* Ub = lds + (ord == 0 ? HY_HV : HY_HZ) + 16 * g4;
            const int blkS = lat ? 288 : 272, lo0 = lat ? (rp & 1) * 8832 + (7 + (rp >> 1)) * 288 : rp * 2 * 272, lo1_ = lo0 + (lat ? 8 * 288 : 272);
            const int dmin = lat ? -15 : -1, dmax = lat ? 15 : 1, hi0 = lat ? 7 : 0, lo1 = lat ? -7 : 0;
            f32x4 acc0, acc1, acc0b, acc1b;
#pragma unroll 1
            for (int rm_ = 0; rm_ < ((HYP & 1) ? 2 : 1); ++rm_) {
            acc0 = (f32x4){0.f, 0.f, 0.f, 0.f}; acc1 = acc0; acc0b = acc0; acc1b = acc0;
            const LAS unsigned char* ap = HCw + (NQ / 2 + rp - g4 + 16 * dmin) * 16;
            const LAS unsigned char* bp0 = Ub + lo0 - dmin * blkS; const LAS unsigned char* bp1 = Ub + lo1_ - dmin * blkS;
#define HY_LD(p, o) (*(const LAS bf16x8*)((p) + (o)))
#define HY_MM(a, b, c) c = __builtin_amdgcn_mfma_f32_16x16x32_bf16(a, b, c, 0, 0, 0)
#define HY_BODY(U0, U1) do { const bf16x8 a0_ = HY_LD(ap, 0), a1_ = HY_LD(ap, -64), a2_ = HY_LD(ap, -128), a3_ = HY_LD(ap, -192); \
        bf16x8 p0_, p1_, p2_, p3_, q0_, q1_, q2_, q3_; \
        if (U0) { p0_ = HY_LD(bp0, 0); p1_ = HY_LD(bp0, 64); p2_ = HY_LD(bp0, 128); p3_ = HY_LD(bp0, 192); } \
        if (U1) { q0_ = HY_LD(bp1, 0); q1_ = HY_LD(bp1, 64); q2_ = HY_LD(bp1, 128); q3_ = HY_LD(bp1, 192); } \
        if (U0) { HY_MM(a0_, p0_, acc0); HY_MM(a1_, p1_, acc0b); } if (U1) { HY_MM(a0_, q0_, acc1); HY_MM(a1_, q1_, acc1b); } \
        if (U0) { HY_MM(a2_, p2_, acc0); HY_MM(a3_, p3_, acc0b); } if (U1) { HY_MM(a2_, q2_, acc1); HY_MM(a3_, q3_, acc1b); } \
        ap += 256; bp0 -= blkS; bp1 -= blkS; } while (0)
            if (lat) {
                const LAS unsigned char* apb = ap - 192;
                const LAS unsigned char* bpb = Ub + lo0 - 7 * 288;
#pragma unroll
                for (int sp = 0; sp < 2; ++sp) {
                    bf16x8 rb[8][2];
#pragma unroll
                    for (int c8 = 0; c8 < 4; ++c8)
#pragma unroll
                        for (int k = 0; k < 8; ++k) { const int d = -15 + 8 * c8 + k;
                            if (d <= 15) {
                                const bf16x8 a0_ = HY_LD(apb, 256 * (d + 15) + 64 * (3 - 2 * sp)), a1_ = HY_LD(apb, 256 * (d + 15) + 64 * (2 - 2 * sp));
                                if (d >= -7) { HY_MM(a0_, rb[k][0], acc1); HY_MM(a1_, rb[k][1], acc1b); }
                                if (d <= 7) { rb[k][0] = HY_LD(bpb, 288 * (7 - d) + 128 * sp); rb[k][1] = HY_LD(bpb, 288 * (7 - d) + 128 * sp + 64);
                                    HY_MM(a0_, rb[k][0], acc0); HY_MM(a1_, rb[k][1], acc0b); }
                            } }
                }
            } else { int d = dmin;
#pragma unroll 1
              for (; d < lo1; ++d) HY_BODY(true, false);
#pragma unroll 1
              for (; d <= hi0; ++d) HY_BODY(true, true);
#pragma unroll 1
              for (; d <= dmax; ++d) HY_BODY(false, true); }
#undef HY_LD
#undef HY_MM
#undef HY_BODY
            if (HYP & 1) asm volatile("" : "+v"(acc0), "+v"(acc1), "+v"(acc0b), "+v"(acc1b));
            }
            acc0 += acc0b; acc1 += acc1b;
            const float sk = cwl[48 + ci * 2 + ord];
            const LAS unsigned char* Uimg = lds + (ord == 0 ? HY_HV : HY_HZ); const LAS unsigned char* Xc = lds + (ord == 0 ? HY_X1 : HY_X2);
            int la_[8], ix_[8]; unsigned short uv_[8], xv_[8];
#pragma unroll 1
            for (int re_ = 0; re_ < ((HYP & 4) ? 2 : 1); ++re_) {
#pragma unroll
            for (int t = 0; t < 2; ++t)
#pragma unroll
                for (int reg = 0; reg < 4; ++reg) { const int a = 32 * g4 + 8 * reg + rho; const int I = lat ? 8 * t + (rp >> 1) : t, b = lat ? (rp & 1) : rp;
                    ix_[t * 4 + reg] = lat ? b * 2048 + 128 * I + a : b * 256 + 128 * I + a; la_[t * 4 + reg] = (lat ? b * 8832 + (7 + I) * 288 : (b * 2 + I) * 272) + a * 2; }
#pragma unroll
            for (int k = 0; k < 8; ++k) { uv_[k] = *(const LAS bf16_t*)(Uimg + la_[k]); xv_[k] = *(const LAS bf16_t*)(Xc + ix_[k] * 2); }
#pragma unroll
            for (int k = 0; k < 8; ++k) { const float y = (k < 4 ? acc0[k & 3] : acc1[k & 3]) * inv; const float z = bf2f(xv_[k]) * (y + sk * bf2f(uv_[k]));
                if (ord == 0) *(LAS bf16_t*)(lds + HY_HZ + la_[k]) = (bf16_t)f2bf(z); else *(LAS bf16_t*)(lds + HY_ST + (ix_[k] * nch + ci) * 2) = (bf16_t)f2bf(z); }
            }
            HY_BAR();
            if (ord == 0) { HY_PUTTAPS(1, tc, td);
                { const float* fp_ = filt + (size_t)(256 + cn) * ntap + tapoff; tc = *(const f32x4*)fp_; td = *(const f32x4*)(fp_ + 4); }
                HY_BAR(); }
        }
    }
    for (int i = tid; i < 4096; i += NTHR) *(u32x2*)(WSP(bf16_t, WS_Z) + (size_t)(tokbase + i) * 256 + c0) = *(const LAS u32x2*)(lds + HY_ST + i * 8);
    __syncthreads();
#undef HY_LOADHY
#undef HY_LOADTAPS
#undef HY_PUTTAPS
#undef HY_CONV
}

constexpr int ST_PER_LAYER = 21, N_STEPS = 3 + 2 * ST_PER_LAYER;
#ifndef MK_ONE_LAUNCH
#define MK_ONE_LAUNCH 1
#endif
#ifndef PHSEL
#define PHSEL -1
#endif
#define PSEL(k) (PHSEL < 0 || PHSEL == (k))
#ifndef PROBE_REP
#define PROBE_REP 0
#endif
__host__ __device__ constexpr bool bar_after(int st) {
    if (st < 3) return st != 1;
    const int s = (st - 3) % ST_PER_LAYER;
    return !(s == 3 || s == 5 || s == 6 || s == 7 || s == 9 || s == 10 || s == 11 || s == 13 || s == 14);
}

template <class Epi> __device__ __forceinline__ void run_gemm(Frame& F, const bf16_t* Ap, int lda, const bf16_t* Bp, int ldb, int M, int N, int K, int cshift, const Epi& E) {
    pg8::Gemm g{Ap, Bp, M, N, K, lda, ldb}; pg8::StaticOrder S; S.init(M, N, F.G, (F.bid + F.G - cshift) % F.G);
    pg8::gemm_phase<Epi, pg8::StaticOrder, true, true>(F.lds, g, S, E);
}

__global__ void __launch_bounds__(NTHR, 2) mk_fwd(Args args) {
    extern __shared__ __attribute__((aligned(16))) unsigned char lds[];
    Frame F;
    F.lds = (LAS unsigned char*)lds; F.ldsg = (char*)lds;
    F.G = gridDim.x; F.bid = blockIdx.x;
    volatile LAS unsigned* MISC = (volatile LAS unsigned*)(F.lds + MISC_OFF);
    if (threadIdx.x < 64) ((LAS unsigned*)(F.lds + MISC_OFF))[threadIdx.x] = 0u;
    __syncthreads();
    const int lo = args.ph_lo, hi = args.ph_hi;
    XcdBarrier bar; bar.bar = (unsigned*)(args.ws + WS_CTL) + CW_BAR; bar.x = 0; bar.st = nullptr;
    if (args.use_bar) bar = xcd_barrier_post((unsigned*)(args.ws + WS_CTL) + CW_BAR, MISC + 8);
    const Args& A = args;

#pragma unroll 1
    for (int st = lo; st < hi; ++st) {
        { size_t z_ = 0; asm volatile("" : "+s"(z_)); F.ws = args.ws + z_; }
        int nrep = 1;
        if (PROBE_REP) { const int s_ = st < 3 ? -1 : (st - 3) % ST_PER_LAYER;
            if ((PROBE_REP & 1) && (s_ == 0 || s_ == 18)) nrep = 2;
            if ((PROBE_REP & 2) && (s_ == 1 || s_ == 19)) nrep = 2;
            if ((PROBE_REP & 4) && (s_ == 3 || s_ == 4)) nrep = 2;
            if ((PROBE_REP & 8) && s_ == 11) nrep = 2;
            if ((PROBE_REP & 16) && s_ == 12) nrep = 2;
            if ((PROBE_REP & 32) && (s_ == 9 || s_ == 10)) nrep = 2;
            if ((PROBE_REP & 64) && st == 0) nrep = 2;
            if ((PROBE_REP & 128) && (st == 2 || s_ == 2 || s_ == 17 || s_ == 20)) nrep = 2;
            if ((PROBE_REP & 512) && (s_ >= 5 && s_ <= 8)) nrep = 2;
            if ((PROBE_REP & 1024) && s_ == 16) nrep = 2;
            if ((PROBE_REP & 2048) && st == 1) nrep = 2;
            if ((PROBE_REP & 4096) && (s_ == 13 || s_ == 14 || s_ == 15)) nrep = 2; }
#pragma unroll 1
        for (int rep = 0; rep < nrep; ++rep) {
        const float gsm = (rep + 1 < nrep) ? 0.0f : 1.0f;
        if (st == 0) { if (PSEL(100)) p0_phase(F, A); }
        else if (st == 1) { if (PSEL(101)) p0b_phase(F, A); }
        else if (st == 2) { if (PSEL(102)) norm_phase(F, A, 0, 0, true, true); }
        else {
            const int l = (st - 3) / ST_PER_LAYER, s = (st - 3) % ST_PER_LAYER;
            const float* ada = WSP(float, WS_ADA) + (size_t)l * 3 * NADA;
            if ((s == 0 || s == 18) && PSEL(0)) {
                const int f = s == 0 ? 0 : 1;
                EpiSwiglu E{WSP(bf16_t, WS_ACT)};
                run_gemm(F, WSP(bf16_t, WS_N), DM, WSP(bf16_t, WS_WUP) + (size_t)(l * 2 + f) * NUP * DM, DM, MTOK, NUP, DM, 0, E);
            } else if ((s == 1 || s == 19) && PSEL(1)) {
                const int f = s == 1 ? 0 : 1;
                EpiResid E{WSP(float, WS_H), ada + (f == 0 ? 2 : 8) * DM, 0.5f * gsm};
                run_gemm(F, WSP(bf16_t, WS_ACT), DFF, WSP(bf16_t, WS_WDN) + (size_t)(l * 2 + f) * DM * DFF, DFF, MTOK, DM, DFF, 0, E);
            } else if (s == 2 && PSEL(2)) norm_phase(F, A, l, 1, false, false);
            else if (s == 3 && PSEL(3)) {
                EpiProj1 E1{WSP(bf16_t, WS_P1), WSP(float, WS_SSQ), WSP(float, WS_SSKV), WSP(float, WS_CKVRAW), WSP(float, WS_KRRAW)};
                run_gemm(F, WSP(bf16_t, WS_N), DM, WSP(bf16_t, WS_W1T) + (size_t)l * N1 * DM, DM, MTOK, N1, DM, 0, E1);
            } else if (s == 4 && PSEL(4)) {
                EpiT E2{WSP(bf16_t, WS_HYT), WSP(bf16_t, WS_XCTL), WSP(bf16_t, WS_XCTC)};
                run_gemm(F, WSP(bf16_t, WS_W2T) + (size_t)l * N2 * DM, DM, WSP(bf16_t, WS_N), DM, N2, MTOK, DM, 192, E2);
            } else if (s == 5 && PSEL(5)) {
                EpiQ EQ{WSP(bf16_t, WS_Q), WSP(float, WS_SSQ), WSP(float, WS_ROPE)};
                run_gemm(F, WSP(bf16_t, WS_P1), N1, WSP(bf16_t, WS_WQB) + (size_t)l * 768 * 256, 256, MTOK, 768, 256, 0, EQ);
            } else if (s == 6 && PSEL(6)) {
                EpiKV<false> EK{WSP(bf16_t, WS_KV), WSP(float, WS_SSKV)};
                run_gemm(F, WSP(bf16_t, WS_P1) + 256, N1, WSP(bf16_t, WS_WKVB) + (size_t)l * 1024 * 256, 256, MTOK, 1024, 256, 96, EK);
            } else if (s == 7 && PSEL(7)) {
                EpiKV<true> EC{WSP(bf16_t, WS_KV), nullptr};
                run_gemm(F, WSP(bf16_t, WS_CKVB) + (size_t)l * 1024 * 256, 256, WSP(bf16_t, WS_WKVR) + (size_t)l * 1024 * 256, 256, 1024, 1024, 256, 224, EC);
            } else if (s == 8 && PSEL(8)) {
                TLW(); const int gt = F.bid * NTHR + tid, NGT = F.G * NTHR;
                for (int it = gt; it < NCTX * 32; it += NGT) { const int r = it >> 5, c4 = (it & 31) * 4;
                    const f32x4 ss = *(const f32x4*)(WSP(float, WS_SSKV) + r * 4); const float rstd = 1.0f / sqrtf(((ss[0] + ss[1]) + (ss[2] + ss[3])) * (1.0f / 128.0f) + EPSV);
                    const f32x4 x = *(const f32x4*)(WSP(float, WS_CKVRAW) + (size_t)r * 128 + c4), g = *(const f32x4*)(AIN(I_KVNG) + l * 128 + c4);
                    *(f32x4*)(A.out + (size_t)MTOK * DM + ((size_t)((r >> 8) * 2 + l) * 256 + (r & 255)) * 128 + c4) = x * rstd * g; }
                for (int it = gt; it < MTOK * 4; it += NGT) { const int row = it >> 2, q = it & 3, part = q >> 1, ib = 4 * (q & 1);
                    const float* kp = WSP(float, WS_KRRAW) + (size_t)row * 32 + 8 * q; const f32x4 va = *(const f32x4*)kp, vb = *(const f32x4*)(kp + 4);
                    float v[8] = {va[0], va[1], va[2], va[3], vb[0], vb[1], vb[2], vb[3]};
                    if (row < NCTX) { float* op = A.out + (size_t)MTOK * DM + (size_t)16 * 2 * 256 * 128 + (size_t)((row >> 8) * 2 * 256 + l * 256 + (row & 255)) * 32 + part * 16 + ib;
#pragma unroll
                        for (int e = 0; e < 8; ++e) op[(e & 1) * 8 + (e >> 1)] = v[e];
                    } else { const int t = (row - NCTX) & 2047, pos = part == 0 ? (t >> 6) : (t & 63); const float* rt = WSP(float, WS_ROPE) + (pos * 8 + ib) * 2;
#pragma unroll
                        for (int e = 0; e < 8; e += 2) { const float cs = rt[e], sn = rt[e + 1], x1 = v[e], x2 = v[e + 1]; v[e] = x1 * cs - x2 * sn; v[e + 1] = x2 * cs + x1 * sn; } }
                    u32x4 w; w.x = cvtpk(v[0], v[1]); w.y = cvtpk(v[2], v[3]); w.z = cvtpk(v[4], v[5]); w.w = cvtpk(v[6], v[7]);
                    *(u32x4*)(WSP(bf16_t, WS_KR) + (size_t)kvrow_of(row) * 32 + 8 * q) = w; }
                for (int it = gt; it < 2 * 512 * 32; it += NGT) { const int pp = it & 31, j = (it >> 5) & 511, b = it >> 14; const int part = pp >> 4, w = pp & 15, i = w >> 1, half = w & 1, p = part * 16 + half * 8 + i;
                    WSP(bf16_t, WS_KR)[(size_t)(NCTX + b * 2560 + 2048 + j) * 32 + pp] = (bf16_t)f2bf(AIN(I_CKR)[((size_t)(b * 2 + l) * 512 + j) * 32 + p]); }
            } else if (s == 9 && PSEL(9)) {
                EpiFn EL{WSP(bf16_t, WS_FN), 1, 0.00276213586400995f};
                run_gemm(F, WSP(bf16_t, WS_DFTL), 4096, WSP(bf16_t, WS_XCTL), 4096, 2048, 512, 4096, 0, EL);
            } else if (s == 10 && PSEL(10)) {
                EpiFn EC{WSP(bf16_t, WS_FN), 0, 0.0078125f};
                run_gemm(F, WSP(bf16_t, WS_DFTC), 512, WSP(bf16_t, WS_XCTC), 512, 256, 4096, 512, 16, EC);
            } else if (s == 11 && PSEL(11)) {
                unsigned* qctr = WSP(unsigned, WS_CTL) + CW_Q + l * 64;
                volatile LAS unsigned* qs = (volatile LAS unsigned*)(F.lds + MISC_OFF + 16);
#pragma unroll 1
                for (;;) {
                    if (threadIdx.x == 0) qs[0] = __hip_atomic_fetch_add(qctr, 1u, __ATOMIC_RELAXED, __HIP_MEMORY_SCOPE_AGENT);
                    __syncthreads();
                    const int qu = (int)qs[0];
                    __syncthreads();
                    if (qu >= 384) break;
                    if (qu < 64 || (qu >= 192 && qu < 256)) { int nr_ = 4;
#pragma unroll 1
                        for (int rr_ = 0; rr_ < ((HYP & 16) ? 2 : 1); ++rr_) { hyena_unit(F, A, l, qu < 64 ? qu : qu - 128, nr_); nr_ = 0; } }
                    else { const int u = qu < 192 ? qu - 64 : qu - 128;
                        const bf16_t *Qb, *KVh, *KRr; bf16_t* Ob; int seq;
                        if (u < 128) { const int b = u >> 6, h = (u >> 3) & 7, qb = u & 7; const int r0 = NCTX + b * 2048 + qb * 256, k0 = NCTX + b * 2560;
                            Qb = WSP(bf16_t, WS_Q) + (size_t)r0 * 768 + h * 96; KVh = WSP(bf16_t, WS_KV) + (size_t)k0 * 1024 + h * 128; KRr = WSP(bf16_t, WS_KR) + (size_t)k0 * 32; Ob = WSP(bf16_t, WS_O) + (size_t)r0 * 512 + h * 64; seq = 2560; }
                        else { const int v = u - 128, b = v >> 3, h = v & 7; const int r0 = b * 256;
                            Qb = WSP(bf16_t, WS_Q) + (size_t)r0 * 768 + h * 96; KVh = WSP(bf16_t, WS_KV) + (size_t)r0 * 1024 + h * 128; KRr = WSP(bf16_t, WS_KR) + (size_t)r0 * 32; Ob = WSP(bf16_t, WS_O) + (size_t)r0 * 512 + h * 64; seq = 256; }
                        att::attn_unit(Qb, KVh, KRr, Ob, seq, F.ldsg); }
                }
            } else if (s == 13 && PSEL(13)) {
                EpiGate<0> E0{WSP(float, WS_Y), WSP(bf16_t, WS_N), WSP(bf16_t, WS_P1) + 512, 1.0f};
                run_gemm(F, WSP(bf16_t, WS_Z), 256, WSP(bf16_t, WS_WHY) + (size_t)l * 1024 * 256, 256, MTOK, DM, 256, 0, E0);
            } else if (s == 14 && PSEL(14)) {
                EpiGate<1> E1{WSP(float, WS_Y), WSP(bf16_t, WS_N), WSP(bf16_t, WS_P1) + 512 + 1024, gsm};
                run_gemm(F, WSP(bf16_t, WS_O), 512, WSP(bf16_t, WS_WMLA) + (size_t)l * 1024 * 512, 512, MTOK, DM, 512, 0, E1);
            } else if (s == 15 && PSEL(15)) {
                EpiGate<2> E2{WSP(float, WS_Y), WSP(bf16_t, WS_N), WSP(bf16_t, WS_P1) + 512 + 2048, 1.0f};
                run_gemm(F, WSP(bf16_t, WS_FN), 256, WSP(bf16_t, WS_WFN) + (size_t)l * 1024 * 256, 256, MTOK, DM, 256, 0, E2);
            } else if (s == 16 && PSEL(16)) {
                EpiResid E{WSP(float, WS_H), ada + 5 * DM, 1.0f * gsm};
                run_gemm(F, WSP(bf16_t, WS_N), DM, WSP(bf16_t, WS_WOUT) + (size_t)l * DM * DM, DM, MTOK, DM, DM, 0, E);
            } else if (s == 17 && PSEL(17)) norm_phase(F, A, l, 2, false, false);
            else if (s == 20 && PSEL(20)) { if (l == 0) norm_phase(F, A, 1, 0, false, false); else final_norm_phase(F, A); }
        }
        if (rep + 1 < nrep) { asm volatile("s_waitcnt vmcnt(0)" ::: "memory"); __syncthreads(); }
        }
        if (st + 1 < hi) { if (bar_after(st)) { xcd_barrier(bar); if (PROBE_REP & 256) xcd_barrier(bar); } else { asm volatile("s_waitcnt vmcnt(0)" ::: "memory"); __syncthreads(); } }
    }
}

extern "C" void kernel_launch(void* const* d_in, const int* in_sizes, int n_in, void* d_out, int out_size, void* d_ws, size_t ws_size, hipStream_t stream) {
    static int grid = 0;
    if (grid == 0) {
        if (n_in != 29 || ws_size < WS_END) { fprintf(stderr, "kernel_launch: n_in %d ws %zu (need %zu)\n", n_in, ws_size, (size_t)WS_END); grid = -1; return; }
        int dev = 0, cus = 0;
        if (hipGetDevice(&dev) != hipSuccess || hipDeviceGetAttribute(&cus, hipDeviceAttributeMultiprocessorCount, dev) != hipSuccess) { grid = -1; return; }
        if (hipFuncSetAttribute((const void*)mk_fwd, hipFuncAttributeMaxDynamicSharedMemorySize, LDS_BYTES) != hipSuccess) { fprintf(stderr, "kernel_launch: hipFuncSetAttribute failed\n"); grid = -1; return; }
        grid = cus;
    }
    if (grid < 0) return;
    (void)hipMemsetAsync((char*)d_ws + WS_CTL, 0, CTL_BYTES, stream);
    Args a{};
    for (int i = 0; i < 29; ++i) a.in[i] = (const float*)d_in[i];
    a.out = (float*)d_out; a.ws = (unsigned char*)d_ws;
#if MK_ONE_LAUNCH
    a.ph_lo = 0; a.ph_hi = N_STEPS; a.use_bar = 1;
    hipLaunchKernelGGL(mk_fwd, dim3(grid), dim3(NTHR), LDS_BYTES, stream, a);
#else
    a.use_bar = 0;
    for (int s0 = 0; s0 < N_STEPS;) { int s1 = s0; while (!bar_after(s1)) ++s1; a.ph_lo = s0; a.ph_hi = s1 + 1; hipLaunchKernelGGL(mk_fwd, dim3(grid), dim3(NTHR), LDS_BYTES, stream, a); s0 = s1 + 1; }
#endif
}
```

```cpp
#include <hip/hip_runtime.h>
#include <cstdio>
#include <cstdint>
namespace pg8 {
#define PG8_LAS __attribute__((address_space(3)))
typedef unsigned short bf16_t;
typedef short bf16x8 __attribute__((ext_vector_type(8)));
typedef float f32x4 __attribute__((ext_vector_type(4)));
typedef unsigned u32x4 __attribute__((ext_vector_type(4)));
constexpr int BM = 256, BK = 64, HALF = 128, HTB = HALF * BK * 2  , STAGE_BYTES = 8 * HTB, NXCD = 8, WGM = 8;

__host__ __device__ __forceinline__ int lds_byte(int r, int c) { const int st = (r >> 4) * 2 + (c >> 5), rr = r & 15, cc = c & 31, ob = rr * 64 + cc * 2; return st * 1024 + (ob ^ (((ob >> 9) & 1) << 5)); }
__host__ __device__ __forceinline__ void stage_rc(int b, int& R, int& C) { const int st = b / 1024, sb = b % 1024, swz = sb ^ (((sb >> 9) & 1) << 5); R = (st >> 1) * 16 + swz / 64; C = (st & 1) * 32 + (swz % 64) / 2; }
__host__ __device__ __forceinline__ int perm32(int rho) { const int n = rho >> 4, i = rho & 15; return 8 * (i >> 2) + 4 * n + (i & 3); }

struct Unit { int pm, pn; };
struct Gemm { const bf16_t* A; const bf16_t* Bt; int M, N, K, lda, ldb; };

struct StaticOrder {
    int nM, nN, nwg, G, c;
    __host__ __device__ void init(int M, int N, int G_, int c_, int bn = BM) { nM = M / BM; nN = N / bn; nwg = nM * nN; G = G_; c = c_; }
    __host__ __device__ bool next(int i, Unit& u) const {
        const long L = (long)i * G + c; if (L >= nwg) return false;
        int wgid = (int)L; { const int q = nwg / NXCD, r = nwg % NXCD, xcd = wgid % NXCD, off = wgid / NXCD; wgid = (xcd < r ? xcd * (q + 1) : r * (q + 1) + (xcd - r) * q) + off; }
        const int nig = WGM * nN, gid = wgid / nig, fm = gid * WGM, gsz = (nM - fm) < WGM ? (nM - fm) : WGM;
        u.pm = fm + ((wgid % nig) % gsz); u.pn = (wgid % nig) / gsz; return true;
    }
    __device__ __forceinline__ void a_ready(const Unit&) const {}
    __device__ __forceinline__ void done(const Unit&) const {}
};


__device__ __forceinline__ f32x4 zero4_() { float a, b, c, d; asm volatile("v_mov_b32 %0, 0\n\tv_mov_b32 %1, 0\n\tv_mov_b32 %2, 0\n\tv_mov_b32 %3, 0" : "=v"(a), "=v"(b), "=v"(c), "=v"(d)); return (f32x4){a, b, c, d}; }
template <class Epi, class Sched, bool ALIGN_EPI = false, bool SP2 = false>
__device__ __forceinline__ void gemm_phase(PG8_LAS unsigned char* lds, const Gemm g, const Sched& S, const Epi& E) {
    int tid_ = threadIdx.x; asm volatile("" : "+v"(tid_));
    const int tid = tid_, wid = __builtin_amdgcn_readfirstlane(tid >> 6), lane = tid & 63, wr = wid >> 2, wc = wid & 3, fr = lane & 15, fq = lane >> 4;
    constexpr bool HN = Epi::HALFN;
    static_assert(!HN || SP2, "HALFN needs the SP2 loop");
    const int K = g.K, nt = K / BK;
    unsigned voffA[2], voffB[2];
#pragma unroll
    for (int i = 0; i < 2; ++i) { int R, C; stage_rc(tid * 16 + i * 8192, R, C); const int Rb = Epi::PERM ? ((R & ~31) + perm32(R & 31)) : R;
        voffA[i] = (unsigned)(R * g.lda + C) * 2u; voffB[i] = (unsigned)(Rb * g.ldb + C) * 2u; }
    const size_t kstep = (size_t)(BK * 2);
    const size_t hstepA = (size_t)HALF * g.lda * 2, hstepB = (size_t)HALF * g.ldb * 2;
    const size_t tstepA = 2 * hstepA, tstepB = 2 * hstepB;
    const unsigned ldsw = (unsigned)wid * 1024u;
    const int aoff = lds_byte(wr * 64 + fr, fq * 8), boff = lds_byte(wc * 32 + fr, fq * 8);
#define PG8_SA(b, h) (((b) * 2 + (h)) * HTB)
#define PG8_SB(b, h) ((4 + (b) * 2 + (h)) * HTB)
#define PG8_STAGE(bufoff, gbase, voff) do { _Pragma("unroll") for (int _i = 0; _i < 2; ++_i) \
        __builtin_amdgcn_global_load_lds((const unsigned*)((const char*)(gbase) + (voff)[_i]), (PG8_LAS unsigned*)(lds + (bufoff) + ldsw + _i * 8192), 16, 0, 0); } while (0)
#define PG8_LDA(dst, b, h) do { _Pragma("unroll") for (int m = 0; m < 4; ++m) _Pragma("unroll") for (int k = 0; k < 2; ++k) dst[m][k] = *(const PG8_LAS bf16x8*)(lds + PG8_SA(b, h) + aoff + m * 2048 + k * 1024); } while (0)
#define PG8_LDB(dst, b, h) do { _Pragma("unroll") for (int n = 0; n < 2; ++n) _Pragma("unroll") for (int k = 0; k < 2; ++k) dst[n][k] = *(const PG8_LAS bf16x8*)(lds + PG8_SB(b, h) + boff + n * 2048 + k * 1024); } while (0)
#define PG8_MMA(ai, bj, At, Bt) do { __builtin_amdgcn_s_setprio(1); _Pragma("unroll") for (int m = 0; m < 4; ++m) _Pragma("unroll") for (int n = 0; n < 2; ++n) _Pragma("unroll") for (int k = 0; k < 2; ++k) \
        acc[ai][bj][m][n] = __builtin_amdgcn_mfma_f32_16x16x32_bf16(Bt[n][k], At[m][k], acc[ai][bj][m][n], 0, 0, 0); __builtin_amdgcn_s_setprio(0); } while (0)
#define PG8_WAIT_V(n) asm volatile("s_waitcnt vmcnt(" #n ")" ::: "memory")
#define PG8_WAIT_L(n) asm volatile("s_waitcnt lgkmcnt(" #n ")" ::: "memory")
#define PG8_BAR __builtin_amdgcn_s_barrier()
#define PG8_SCHED __builtin_amdgcn_sched_barrier(0)
    Unit cur, nxt; int ui = 0;
    if (!S.next(0, cur)) return;
    f32x4 acc[2][2][4][2];
#pragma unroll
    for (int a = 0; a < 2; ++a)
#pragma unroll
        for (int b = 0; b < (HN ? 1 : 2); ++b)
#pragma unroll
            for (int m = 0; m < 4; ++m)
#pragma unroll
                for (int n = 0; n < 2; ++n) acc[a][b][m][n] = zero4_();
    bf16x8 At[4][2], B0[2][2], B1[2][2];
    const char* cA = (const char*)g.A + (size_t)cur.pm * tstepA; const char* cB = (const char*)g.Bt + (size_t)cur.pn * (HN ? hstepB : tstepB);
    S.a_ready(cur);
    if constexpr (HN) {
        PG8_STAGE(PG8_SB(0, 0), cB, voffB); PG8_STAGE(PG8_SA(0, 0), cA, voffA); PG8_STAGE(PG8_SA(0, 1), cA + hstepA, voffA);
        if (wr == 1) PG8_BAR;
        PG8_WAIT_V(2); PG8_BAR;
        PG8_STAGE(PG8_SB(1, 0), cB + kstep, voffB); PG8_STAGE(PG8_SA(1, 0), cA + kstep, voffA);
        PG8_WAIT_V(4); PG8_BAR;
    } else if constexpr (SP2) {
        PG8_STAGE(PG8_SB(0, 0), cB, voffB); PG8_STAGE(PG8_SB(0, 1), cB + hstepB, voffB); PG8_STAGE(PG8_SA(0, 0), cA, voffA); PG8_STAGE(PG8_SA(0, 1), cA + hstepA, voffA);
        if (wr == 1) PG8_BAR;
        PG8_WAIT_V(2); PG8_BAR;
        PG8_STAGE(PG8_SB(1, 0), cB + kstep, voffB); PG8_STAGE(PG8_SA(1, 0), cA + kstep, voffA); PG8_STAGE(PG8_SB(1, 1), cB + hstepB + kstep, voffB);
        PG8_WAIT_V(6); PG8_BAR;
    } else {
        PG8_STAGE(PG8_SB(0, 0), cB, voffB); PG8_STAGE(PG8_SA(0, 0), cA, voffA); PG8_STAGE(PG8_SB(0, 1), cB + hstepB, voffB); PG8_STAGE(PG8_SA(0, 1), cA + hstepA, voffA);
        if (wr == 1) PG8_BAR;
        PG8_WAIT_V(4); PG8_BAR;
        PG8_STAGE(PG8_SB(1, 0), cB + kstep, voffB); PG8_STAGE(PG8_SA(1, 0), cA + kstep, voffA); PG8_STAGE(PG8_SB(1, 1), cB + hstepB + kstep, voffB);
        PG8_WAIT_V(6); PG8_BAR;
    }
#pragma unroll 1
    for (;;) {
        const bool has_next = S.next(ui + 1, nxt);
        const char* nA = has_next ? (const char*)g.A + (size_t)nxt.pm * tstepA : cA; const char* nB = has_next ? (const char*)g.Bt + (size_t)nxt.pn * (HN ? hstepB : tstepB) : cB;
#pragma unroll 1
        for (int t = 0; t < nt; t += 2) {
            const bool last = (t == nt - 2);
            const char* a1 = cA + (size_t)(t + 1) * kstep;
            const char* a2 = last ? nA : cA + (size_t)(t + 2) * kstep; const char* b2 = last ? nB : cB + (size_t)(t + 2) * kstep;
            const char* a3 = a2 + kstep; const char* b3 = b2 + kstep;
            if (last && has_next) S.a_ready(nxt);
            if constexpr (HN) {
            PG8_LDB(B0, 0, 0); PG8_SCHED; PG8_LDA(At, 0, 0); PG8_STAGE(PG8_SA(1, 1), a1 + hstepA, voffA);
            PG8_WAIT_V(6); PG8_WAIT_L(0); PG8_BAR; PG8_MMA(0, 0, At, B0); PG8_BAR; PG8_SCHED;
            PG8_LDA(At, 0, 1); PG8_STAGE(PG8_SB(0, 0), b2, voffB); PG8_STAGE(PG8_SA(0, 0), a2, voffA);
            PG8_WAIT_V(6); PG8_WAIT_L(0); PG8_BAR; PG8_MMA(1, 0, At, B0); PG8_BAR; PG8_SCHED;
            PG8_LDB(B0, 1, 0); PG8_SCHED; PG8_LDA(At, 1, 0); PG8_STAGE(PG8_SA(0, 1), a2 + hstepA, voffA);
            PG8_WAIT_V(6); PG8_WAIT_L(0); PG8_BAR; PG8_MMA(0, 0, At, B0); PG8_BAR; PG8_SCHED;
            PG8_LDA(At, 1, 1); PG8_STAGE(PG8_SB(1, 0), b3, voffB); PG8_STAGE(PG8_SA(1, 0), a3, voffA);
            PG8_WAIT_V(6); PG8_WAIT_L(0); PG8_BAR; PG8_MMA(1, 0, At, B0); PG8_BAR; PG8_SCHED;
            } else if constexpr (SP2) {
            PG8_LDB(B0, 0, 0); PG8_LDB(B1, 0, 1); PG8_SCHED; PG8_LDA(At, 0, 0); PG8_STAGE(PG8_SA(1, 1), a1 + hstepA, voffA);
            PG8_WAIT_V(8); PG8_WAIT_L(0); PG8_BAR; PG8_MMA(0, 0, At, B0); PG8_MMA(0, 1, At, B1); PG8_BAR; PG8_SCHED;
            PG8_LDA(At, 0, 1); PG8_STAGE(PG8_SB(0, 0), b2, voffB); PG8_STAGE(PG8_SB(0, 1), b2 + hstepB, voffB); PG8_STAGE(PG8_SA(0, 0), a2, voffA);
            PG8_WAIT_V(8); PG8_WAIT_L(0); PG8_BAR; PG8_MMA(1, 0, At, B0); PG8_MMA(1, 1, At, B1); PG8_BAR; PG8_SCHED;
            PG8_LDB(B0, 1, 0); PG8_LDB(B1, 1, 1); PG8_SCHED; PG8_LDA(At, 1, 0); PG8_STAGE(PG8_SA(0, 1), a2 + hstepA, voffA);
            PG8_WAIT_V(8); PG8_WAIT_L(0); PG8_BAR; PG8_MMA(0, 0, At, B0); PG8_MMA(0, 1, At, B1); PG8_BAR; PG8_SCHED;
            PG8_LDA(At, 1, 1); PG8_STAGE(PG8_SB(1, 0), b3, voffB); PG8_STAGE(PG8_SB(1, 1), b3 + hstepB, voffB); PG8_STAGE(PG8_SA(1, 0), a3, voffA);
            PG8_WAIT_V(8); PG8_WAIT_L(0); PG8_BAR; PG8_MMA(1, 0, At, B0); PG8_MMA(1, 1, At, B1); PG8_BAR; PG8_SCHED;
            } else {
            PG8_LDB(B0, 0, 0); PG8_SCHED; PG8_LDA(At, 0, 0); PG8_STAGE(PG8_SA(1, 1), a1 + hstepA, voffA);
            PG8_WAIT_L(8); PG8_BAR; PG8_WAIT_L(0); PG8_MMA(0, 0, At, B0); PG8_BAR; PG8_SCHED;
            PG8_LDB(B1, 0, 1); PG8_STAGE(PG8_SB(0, 0), b2, voffB);
            PG8_BAR; PG8_WAIT_L(0); PG8_MMA(0, 1, At, B1); PG8_BAR;
            PG8_LDA(At, 0, 1); PG8_STAGE(PG8_SA(0, 0), a2, voffA);
            PG8_BAR; PG8_WAIT_L(0); PG8_MMA(1, 0, At, B0); PG8_BAR; PG8_SCHED;
            PG8_STAGE(PG8_SB(0, 1), b2 + hstepB, voffB);
            PG8_WAIT_V(6); PG8_BAR; PG8_MMA(1, 1, At, B1); PG8_BAR;
            PG8_LDB(B0, 1, 0); PG8_SCHED; PG8_LDA(At, 1, 0); PG8_STAGE(PG8_SA(0, 1), a2 + hstepA, voffA);
            PG8_WAIT_L(8); PG8_BAR; PG8_WAIT_L(0); PG8_MMA(0, 0, At, B0); PG8_BAR; PG8_SCHED;
            PG8_LDB(B1, 1, 1); PG8_STAGE(PG8_SB(1, 0), b3, voffB);
            PG8_BAR; PG8_WAIT_L(0); PG8_MMA(0, 1, At, B1); PG8_BAR;
            PG8_LDA(At, 1, 1); PG8_STAGE(PG8_SA(1, 0), a3, voffA);
            PG8_BAR; PG8_WAIT_L(0); PG8_MMA(1, 0, At, B0); PG8_BAR; PG8_SCHED;
            PG8_STAGE(PG8_SB(1, 1), b3 + hstepB, voffB);
            PG8_WAIT_V(6); PG8_BAR; PG8_MMA(1, 1, At, B1); PG8_BAR;
            }
        }
        if constexpr (ALIGN_EPI) { if (wr == 0) PG8_BAR; }
        if constexpr (!Epi::AFTER_DRAIN) { E(acc, cur, wr, wc, fr, fq); S.done(cur); }
        if (!has_next) break;
#pragma unroll
        for (int a = 0; a < 2; ++a)
#pragma unroll
            for (int b = 0; b < (HN ? 1 : 2); ++b)
#pragma unroll
                for (int m = 0; m < 4; ++m)
#pragma unroll
                    for (int n = 0; n < 2; ++n) acc[a][b][m][n] = zero4_();
        cur = nxt; cA = nA; cB = nB; ++ui;
        if constexpr (ALIGN_EPI) { if (wr == 1) PG8_BAR; }
    }
    PG8_WAIT_V(0);
    if constexpr (!ALIGN_EPI) { if (wr == 0) PG8_BAR; }
    PG8_BAR;
    if constexpr (Epi::AFTER_DRAIN) { E.fused(acc, cur, wr, wc, fr, fq, lds, wid, lane); S.done(cur); }
#undef PG8_SA
#undef PG8_SB
#undef PG8_STAGE
#undef PG8_LDA
#undef PG8_LDB
#undef PG8_MMA
#undef PG8_WAIT_V
#undef PG8_WAIT_L
#undef PG8_BAR
#undef PG8_SCHED
}
}

#define GAS __attribute__((address_space(1)))
#define LAS __attribute__((address_space(3)))
typedef unsigned short bf16_t;
typedef float f32x4 __attribute__((ext_vector_type(4)));
typedef float f32x8 __attribute__((ext_vector_type(8)));
typedef float f32x16 __attribute__((ext_vector_type(16)));
typedef short bf16x8 __attribute__((ext_vector_type(8)));
typedef short s16x4 __attribute__((ext_vector_type(4)));
typedef unsigned u32x4 __attribute__((ext_vector_type(4)));
typedef unsigned u32x2 __attribute__((ext_vector_type(2)));

constexpr int DM = 1024, MTOK = 8192, NCTX = 4096, LCTX = 256, LLAT = 2048;
constexpr int DFF = 2816, NUP = 5632, INC = 4512;
constexpr int N1 = 3584;
constexpr int N2 = 1280;
constexpr int KVROWS = 9216;
constexpr int NADA = 9216;
constexpr float EPSV = 1e-6f;
constexpr int NWAVES = 8, NTHR = 512;

constexpr size_t al256(size_t x) { return (x + 255) & ~(size_t)255; }
constexpr size_t WS_CTL = 0, CTL_BYTES = 1u << 20;
constexpr size_t WS_ADAP = WS_CTL + CTL_BYTES;
constexpr size_t WS_ADA  = WS_ADAP + al256((size_t)16 * 2 * 3 * NADA * 4);
constexpr size_t WS_SSQ  = WS_ADA + al256((size_t)2 * 3 * NADA * 4);
constexpr size_t WS_SSKV = WS_SSQ + al256((size_t)MTOK * 4 * 4);
constexpr size_t WS_ROPE = WS_SSKV + al256((size_t)MTOK * 4 * 4);
constexpr size_t WS_H2   = WS_ROPE + al256(64 * 8 * 2 * 4);
constexpr size_t WS_FILT = WS_H2 + al256((size_t)2 * 2304 * 64 * 4);
constexpr size_t FILT_LAYER = (size_t)512 * 4096 + (size_t)512 * 512;
constexpr size_t WS_CKVRAW = WS_FILT + al256(2 * FILT_LAYER * 4);
constexpr size_t WS_KRRAW = WS_CKVRAW + al256((size_t)NCTX * 128 * 4);
constexpr size_t WS_CKVB = WS_KRRAW + al256((size_t)MTOK * 32 * 4);
constexpr size_t WS_WUP  = WS_CKVB + al256((size_t)2 * 1024 * 256 * 2);
constexpr size_t WS_WDN  = WS_WUP + al256((size_t)4 * NUP * DM * 2);
constexpr size_t WS_W1T  = WS_WDN + al256((size_t)4 * DM * DFF * 2);
constexpr size_t WS_W2T  = WS_W1T + al256((size_t)2 * N1 * DM * 2);
constexpr size_t WS_WQB  = WS_W2T + al256((size_t)2 * N2 * DM * 2);
constexpr size_t WS_WKVB = WS_WQB + al256((size_t)2 * 768 * 256 * 2);
constexpr size_t WS_WKVR = WS_WKVB + al256((size_t)2 * 1024 * 256 * 2);
constexpr size_t WS_WHY  = WS_WKVR + al256((size_t)2 * 1024 * 256 * 2);
constexpr size_t WS_WMLA = WS_WHY + al256((size_t)2 * 1024 * 256 * 2);
constexpr size_t WS_WFN  = WS_WMLA + al256((size_t)2 * 1024 * 512 * 2);
constexpr size_t WS_WOUT = WS_WFN + al256((size_t)2 * 1024 * 256 * 2);
constexpr size_t WS_DFTL = WS_WOUT + al256((size_t)2 * 1024 * 1024 * 2);
constexpr size_t WS_DFTC = WS_DFTL + al256((size_t)2048 * 4096 * 2);
constexpr size_t WS_H    = WS_DFTC + al256((size_t)256 * 512 * 2);
constexpr size_t WS_N    = WS_H + al256((size_t)MTOK * DM * 4);
constexpr size_t WS_KV   = WS_N + al256((size_t)MTOK * DM * 2);
constexpr size_t WS_KR   = WS_KV + al256((size_t)KVROWS * 1024 * 2);
constexpr size_t WS_R1   = WS_KR + al256((size_t)KVROWS * 32 * 2);
constexpr size_t WS_ACT  = WS_R1;
constexpr size_t WS_P1   = WS_R1;
constexpr size_t WS_HYT  = WS_P1 + al256((size_t)MTOK * N1 * 2);
constexpr size_t WS_XCTL = WS_HYT + al256((size_t)768 * MTOK * 2);
constexpr size_t WS_XCTC = WS_XCTL + al256((size_t)512 * 4096 * 2);
constexpr size_t WS_Q    = WS_XCTC + al256((size_t)4096 * 512 * 2);
constexpr size_t WS_O    = WS_Q + al256((size_t)MTOK * 768 * 2);
constexpr size_t WS_Z    = WS_O + al256((size_t)MTOK * 512 * 2);
constexpr size_t WS_FN   = WS_Z + al256((size_t)MTOK * 256 * 2);
constexpr size_t WS_Y    = WS_FN + al256((size_t)MTOK * 256 * 2);
constexpr size_t WS_END  = WS_Y + al256((size_t)MTOK * DM * 4);
static_assert(WS_ACT + (size_t)MTOK * DFF * 2 <= WS_END, "ws map");

constexpr int CW_BAR = 4096, CW_Q = 8192;

constexpr int RING_BYTES = 131072;
constexpr int MISC_OFF = 163840 - 512;
constexpr int LDS_BYTES = 163840;

__device__ __forceinline__ unsigned f2bf(float f) { unsigned u = __builtin_bit_cast(unsigned, f); return (u + 0x7fffu + ((u >> 16) & 1u)) >> 16; }
__device__ __forceinline__ unsigned pk2(float lo, float hi) { return f2bf(lo) | (f2bf(hi) << 16); }
__device__ __forceinline__ float bf2f(unsigned short b) { return __builtin_bit_cast(float, (unsigned)b << 16); }
__device__ __forceinline__ float bflo(unsigned w) { return __builtin_bit_cast(float, w << 16); }
__device__ __forceinline__ float bfhi(unsigned w) { return __builtin_bit_cast(float, w & 0xffff0000u); }
__device__ __forceinline__ unsigned cvtpk(float lo, float hi) { unsigned r; asm volatile("v_cvt_pk_bf16_f32 %0, %1, %2" : "=v"(r) : "v"(lo), "v"(hi)); return r; }
__device__ __forceinline__ u32x4 pack8(f32x4 a, f32x4 b) { u32x4 w; w.x = cvtpk(a[0], a[1]); w.y = cvtpk(a[2], a[3]); w.z = cvtpk(b[0], b[1]); w.w = cvtpk(b[2], b[3]); return w; }
__device__ __forceinline__ float wave_sum(float v) {
#pragma unroll
    for (int o = 1; o < 64; o <<= 1) v += __shfl_xor(v, o);
    return v;
}
__device__ __forceinline__ float sigmoidf_(float x) { return 1.0f / (1.0f + __expf(-x)); }
__device__ __forceinline__ float siluf_(float x) { return x / (1.0f + __expf(-x)); }
__device__ __forceinline__ int grp_of_pm(int pm) { return pm < 16 ? 0 : (pm < 24 ? 1 : 2); }
__device__ __forceinline__ int kvrow_of(int r) { return r < NCTX ? r : NCTX + ((r - NCTX) >> 11) * 2560 + ((r - NCTX) & 2047); }

#define XB_TMO      128
#define XB_XCNT(j)  (256  + 64 * (j))
#define XB_XSUB(j)  (1280 + 64 * (j))
#define XB_XGEN(j)  (2304 + 64 * (j))
#define XB_TOP      3328
#define XB_TOPGEN   3392
#define XCD_BAR_WORDS 3456
#define XB_SPIN_CAP (1u << 20)
__device__ __forceinline__ unsigned xb_ld(unsigned* p)              { return __hip_atomic_load(p, __ATOMIC_RELAXED, __HIP_MEMORY_SCOPE_AGENT); }
__device__ __forceinline__ unsigned xb_add(unsigned* p, unsigned v) { return __hip_atomic_fetch_add(p, v, __ATOMIC_RELAXED, __HIP_MEMORY_SCOPE_AGENT); }
__device__ __forceinline__ unsigned xb_xcc_id() { return (unsigned)__builtin_amdgcn_s_getreg((3 << 11) | 20) & 0xFu; }
#define XB_SPIN(cond, bar) do { unsigned _sp = 0; while (cond) { __builtin_amdgcn_s_sleep(1); \
    if ((++_sp & 255u) == 0u) { if (xb_ld(&(bar)[XB_TMO])) break; if (_sp > XB_SPIN_CAP) { atomicAdd(&(bar)[XB_TMO], 1u); break; } } } } while (0)
struct XcdBarrier { unsigned* bar; unsigned x; volatile LAS unsigned* st; };
__device__ __forceinline__ XcdBarrier xcd_barrier_post(unsigned* bar, volatile LAS unsigned* st) {
    XcdBarrier b; b.bar = bar; b.x = xb_xcc_id(); b.st = st;
    if (threadIdx.x == 0) (void)xb_add(&bar[XB_XCNT(b.x)], 1u);
    return b;
}
__device__ __forceinline__ void xcd_barrier_complete(unsigned* bar, unsigned x, unsigned& nloc, unsigned& nx) {
    const unsigned G = gridDim.x * gridDim.y * gridDim.z;
    unsigned sum, cnt, mine, sp = 0u;
    for (;;) {
        sum = 0u; cnt = 0u; mine = 0u;
#pragma unroll 1
        for (unsigned j = 0; j < 16; ++j) { const unsigned c = xb_ld(&bar[XB_XCNT(j)]); sum += c; cnt += (c > 0u) ? 1u : 0u; mine = (j == x) ? c : mine; }
        if (sum == G) break;
        __builtin_amdgcn_s_sleep(1);
        if ((++sp & 255u) == 0u) { if (xb_ld(&bar[XB_TMO])) break; if (sp > XB_SPIN_CAP) { atomicAdd(&bar[XB_TMO], 1u); break; } }
    }
    nloc = mine > 0u ? mine : 1u; nx = cnt > 0u ? cnt : 1u;
}
__device__ __forceinline__ void xcd_barrier(const XcdBarrier& b) {
    asm volatile("s_waitcnt vmcnt(0)" ::: "memory");
    __syncthreads();
    if (threadIdx.x == 0) {
        size_t z_ = 0; asm volatile("" : "+s"(z_));
        unsigned* bar = b.bar + z_;
        __builtin_amdgcn_s_waitcnt(0);
        unsigned nloc = b.st[0], nx = b.st[1];
        if (nloc == 0u) { xcd_barrier_complete(bar, b.x, nloc, nx); b.st[0] = nloc; b.st[1] = nx; }
        const unsigned old = xb_add(&bar[XB_XSUB(b.x)], 1u);
        const unsigned gen = old / nloc;
        if (old + 1u == (gen + 1u) * nloc) {
            __builtin_amdgcn_fence(__ATOMIC_RELEASE, "agent");
            asm volatile("s_waitcnt vmcnt(0)" ::: "memory");
            const unsigned og = xb_add(&bar[XB_TOP], 1u);
            const unsigned tg = og / nx;
            if (og + 1u == (tg + 1u) * nx) xb_add(&bar[XB_TOPGEN], 1u);
            else XB_SPIN(xb_ld(&bar[XB_TOPGEN]) == tg, bar);
            __builtin_amdgcn_fence(__ATOMIC_ACQUIRE, "agent");
            xb_add(&bar[XB_XGEN(b.x)], 1u);
            asm volatile("s_waitcnt vmcnt(0)" ::: "memory");
        } else {
            XB_SPIN(xb_ld(&bar[XB_XGEN(b.x)]) == gen, bar);
            __builtin_amdgcn_fence(__ATOMIC_ACQUIRE, "agent");
            asm volatile("s_waitcnt vmcnt(0)" ::: "memory");
        }
    }
    __syncthreads();
}

using pg8::Unit;
typedef const f32x4 (&AccT)[2][2][4][2];

struct EpiSwiglu {
    static constexpr bool PERM = false, AFTER_DRAIN = false, HALFN = false;
    bf16_t* ACT;
    __device__ __forceinline__ void operator()(AccT acc, const Unit& u, int wr, int wc, int fr, int fq) const {
        int z_ = 0; asm volatile("" : "+s"(z_));
        const int row0 = u.pm * 256 + wr * 64 + fr + z_, f0 = u.pn * 128 + wc * 16 + 4 * fq;
#pragma unroll
        for (int ai = 0; ai < 2; ++ai)
#pragma unroll
            for (int m = 0; m < 4; ++m) { bf16_t* rp = ACT + (size_t)(row0 + ai * 128 + m * 16) * DFF + f0;
#pragma unroll
                for (int bj = 0; bj < 2; ++bj) { const f32x4 g = acc[ai][bj][m][0], x = acc[ai][bj][m][1];
                    u32x2 w; w.x = cvtpk(siluf_(g[0]) * x[0], siluf_(g[1]) * x[1]); w.y = cvtpk(siluf_(g[2]) * x[2], siluf_(g[3]) * x[3]);
                    *(u32x2*)(rp + 64 * bj) = w; } }
    }
};
template <bool HN> struct EpiResid {
    static constexpr bool PERM = true, AFTER_DRAIN = false, HALFN = HN;
    float* H; const float* gate; float gs;
    __device__ __forceinline__ void operator()(AccT acc, const Unit& u, int wr, int wc, int fr, int fq) const {
        int z_ = 0; asm volatile("" : "+s"(z_));
        const int row0 = u.pm * 256 + wr * 64 + fr + z_, col0 = u.pn * (HN ? 128 : 256) + wc * 32 + 8 * fq;
        const float* gp = gate + grp_of_pm(u.pm) * NADA + col0;
        f32x4 gv[2][2];
#pragma unroll
        for (int bj = 0; bj < (HN ? 1 : 2); ++bj) { gv[bj][0] = *(const f32x4*)(gp + bj * 128) * gs; gv[bj][1] = *(const f32x4*)(gp + bj * 128 + 4) * gs; }
#pragma unroll
        for (int ai = 0; ai < 2; ++ai)
#pragma unroll
            for (int m = 0; m < 4; ++m) { float* rp = H + (size_t)(row0 + ai * 128 + m * 16) * DM + col0;
#pragma unroll
                for (int bj = 0; bj < (HN ? 1 : 2); ++bj) {
                    f32x4 h0 = *(const f32x4*)(rp + bj * 128), h1 = *(const f32x4*)(rp + bj * 128 + 4);
                    h0 += gv[bj][0] * acc[ai][bj][m][0]; h1 += gv[bj][1] * acc[ai][bj][m][1];
                    *(f32x4*)(rp + bj * 128) = h0; *(f32x4*)(rp + bj * 128 + 4) = h1; }
                if (m & 1) asm volatile("" ::: "memory"); }
    }
};
struct EpiProj1 {
    static constexpr bool PERM = true, AFTER_DRAIN = false, HALFN = false;
    bf16_t* P1; float* SSQ; float* SSKV; float* CKVRAW; float* KRRAW;
    __device__ __forceinline__ void operator()(AccT acc, const Unit& u, int wr, int wc, int fr, int fq) const {
        int z_ = 0; asm volatile("" : "+s"(z_));
        fq += z_; wc += z_;
        const int row0 = u.pm * 256 + wr * 64 + fr + z_, col0 = u.pn * 256 + wc * 32 + 8 * fq;
        if (u.pn >= 2) {
#pragma unroll
            for (int ai = 0; ai < 2; ++ai)
#pragma unroll
                for (int m = 0; m < 4; ++m) { bf16_t* rp = P1 + (size_t)(row0 + ai * 128 + m * 16) * N1 + col0;
#pragma unroll
                    for (int bj = 0; bj < 2; ++bj) { f32x4 a = acc[ai][bj][m][0], b = acc[ai][bj][m][1];
#pragma unroll
                        for (int j = 0; j < 4; ++j) { a[j] = sigmoidf_(a[j]); b[j] = sigmoidf_(b[j]); }
                        *(u32x4*)(rp + bj * 128) = pack8(a, b); } }
        } else {
            const bool isq = (u.pn == 0);
#pragma unroll
            for (int ai = 0; ai < 2; ++ai)
#pragma unroll
                for (int m = 0; m < 4; ++m) { const int row = row0 + ai * 128 + m * 16; bf16_t* rp = P1 + (size_t)row * N1 + col0;
                    const f32x4 a0 = acc[ai][0][m][0], b0 = acc[ai][0][m][1], a1 = acc[ai][1][m][0], b1 = acc[ai][1][m][1];
                    *(u32x4*)(rp) = pack8(a0, b0); *(u32x4*)(rp + 128) = pack8(a1, b1);
                    float s = (a0[0] * a0[0] + a0[1] * a0[1]) + (a0[2] * a0[2] + a0[3] * a0[3]) + (b0[0] * b0[0] + b0[1] * b0[1]) + (b0[2] * b0[2] + b0[3] * b0[3]);
                    if (isq) s += (a1[0] * a1[0] + a1[1] * a1[1]) + (a1[2] * a1[2] + a1[3] * a1[3]) + (b1[0] * b1[0] + b1[1] * b1[1]) + (b1[2] * b1[2] + b1[3] * b1[3]);
                    s += __shfl_xor(s, 16); s += __shfl_xor(s, 32);
                    if (fq == 0) (isq ? SSQ : SSKV)[row * 4 + wc] = s;
                    if (!isq) {
                        if (row < NCTX) { float* cp = CKVRAW + (size_t)row * 128 + wc * 32 + 8 * fq; *(f32x4*)cp = a0; *(f32x4*)(cp + 4) = b0; }
                        if (wc == 0) { float* kp = KRRAW + (size_t)row * 32 + 8 * fq; *(f32x4*)kp = a1; *(f32x4*)(kp + 4) = b1; }
                    }
                    asm volatile("" ::: "memory"); }
        }
    }
};
struct EpiQ {
    static constexpr bool PERM = true, AFTER_DRAIN = false, HALFN = false;
    bf16_t* Q; const float* SSQ; const float* rope;
    __device__ __forceinline__ void operator()(AccT acc, const Unit& u, int wr, int wc, int fr, int fq) const {
        int z_ = 0; asm volatile("" : "+s"(z_));
        const int row0 = u.pm * 256 + wr * 64 + fr + z_, col0 = u.pn * 256 + wc * 32 + 8 * fq;
#pragma unroll
        for (int ai = 0; ai < 2; ++ai)
#pragma unroll
            for (int m = 0; m < 4; ++m) { const int row = row0 + ai * 128 + m * 16;
                const f32x4 ss = *(const f32x4*)(SSQ + row * 4); const float rstd = __builtin_amdgcn_rsqf(((ss[0] + ss[1]) + (ss[2] + ss[3])) * (1.0f / 256.0f) + EPSV);
#pragma unroll
                for (int bj = 0; bj < 2; ++bj) { const int c = col0 + bj * 128, within = c % 96;
                    f32x4 a = acc[ai][bj][m][0] * rstd, b = acc[ai][bj][m][1] * rstd;
                    if (within >= 64 && row >= NCTX) { const int pp = within - 64, part = pp >> 4, ib = (pp & 15) >> 1; const int t = (row - NCTX) & 2047, pos = part == 0 ? (t >> 6) : (t & 63);
                        const float* rt = rope + (pos * 8 + ib) * 2; const f32x4 r0 = *(const f32x4*)rt, r1 = *(const f32x4*)(rt + 4);
                        f32x4 a2, b2; a2[0] = a[0] * r0[0] - a[1] * r0[1]; a2[1] = a[1] * r0[0] + a[0] * r0[1]; a2[2] = a[2] * r0[2] - a[3] * r0[3]; a2[3] = a[3] * r0[2] + a[2] * r0[3];
                        b2[0] = b[0] * r1[0] - b[1] * r1[1]; b2[1] = b[1] * r1[0] + b[0] * r1[1]; b2[2] = b[2] * r1[2] - b[3] * r1[3]; b2[3] = b[3] * r1[2] + b[2] * r1[3]; a = a2; b = b2; }
                    *(u32x4*)(Q + (size_t)row * 768 + c) = pack8(a, b); }
                asm volatile("" ::: "memory"); }
    }
};
template <bool CACHED> struct EpiKV {
    static constexpr bool PERM = true, AFTER_DRAIN = false, HALFN = false;
    bf16_t* KV; const float* SS;
    __device__ __forceinline__ void operator()(AccT acc, const Unit& u, int wr, int wc, int fr, int fq) const {
        int z_ = 0; asm volatile("" : "+s"(z_));
        const int row0 = u.pm * 256 + wr * 64 + fr + z_, col0 = u.pn * 256 + wc * 32 + 8 * fq;
#pragma unroll
        for (int ai = 0; ai < 2; ++ai)
#pragma unroll
            for (int m = 0; m < 4; ++m) { const int row = row0 + ai * 128 + m * 16; float rstd = 1.0f; int drow;
                if (CACHED) drow = NCTX + (row >> 9) * 2560 + 2048 + (row & 511);
                else { drow = kvrow_of(row); const f32x4 ss = *(const f32x4*)(SS + row * 4); rstd = __builtin_amdgcn_rsqf(((ss[0] + ss[1]) + (ss[2] + ss[3])) * (1.0f / 128.0f) + EPSV); }
#pragma unroll
                for (int bj = 0; bj < 2; ++bj) *(u32x4*)(KV + (size_t)drow * 1024 + col0 + bj * 128) = pack8(acc[ai][bj][m][0] * rstd, acc[ai][bj][m][1] * rstd);
                asm volatile("" ::: "memory"); }
    }
};
struct EpiT {
    static constexpr bool PERM = true, AFTER_DRAIN = false, HALFN = false;
    bf16_t* HYT; bf16_t* XCTL; bf16_t* XCTC;
    __device__ __forceinline__ void operator()(AccT acc, const Unit& u, int wr, int wc, int fr, int fq) const {
        int z_ = 0; asm volatile("" : "+s"(z_));
        const int row0 = u.pm * 256 + wr * 64 + fr + z_, tok0 = u.pn * 256 + wc * 32 + 8 * fq;
#pragma unroll
        for (int ai = 0; ai < 2; ++ai)
#pragma unroll
            for (int m = 0; m < 4; ++m) { const int n = row0 + ai * 128 + m * 16;
#pragma unroll
                for (int bj = 0; bj < 2; ++bj) { const int tok = tok0 + bj * 128; bf16_t* dp;
                    if (u.pm < 3) dp = HYT + (size_t)n * MTOK + tok;
                    else { const int isS = u.pm - 3, col = n - 768 - 256 * isS;
                        if (tok < NCTX) dp = XCTC + ((size_t)((tok >> 8) * 256 + col)) * 512 + isS * 256 + (tok & 255);
                        else dp = XCTL + ((size_t)(((tok - NCTX) >> 11) * 256 + col)) * 4096 + isS * 2048 + ((tok - NCTX) & 2047); }
                    *(u32x4*)dp = pack8(acc[ai][bj][m][0], acc[ai][bj][m][1]); } }
    }
};
struct EpiFn {
    static constexpr bool PERM = true, AFTER_DRAIN = false, HALFN = false;
    bf16_t* FN; int lat; float scale;
    __device__ __forceinline__ void operator()(AccT acc, const Unit& u, int wr, int wc, int fr, int fq) const {
        int z_ = 0; asm volatile("" : "+s"(z_));
        const int rb = lat ? (NCTX + u.pn * 2048 + u.pm * 256) : (u.pn * 256);
        const int row0 = rb + wr * 64 + fr + z_, col0 = wc * 32 + 8 * fq;
#pragma unroll
        for (int ai = 0; ai < 2; ++ai)
#pragma unroll
            for (int m = 0; m < 4; ++m) { bf16_t* rp = FN + (size_t)(row0 + ai * 128 + m * 16) * 256 + col0;
#pragma unroll
                for (int bj = 0; bj < 2; ++bj) *(u32x4*)(rp + bj * 128) = pack8(acc[ai][bj][m][0] * scale, acc[ai][bj][m][1] * scale); }
    }
};
template <int MODE, bool HN> struct EpiGate {
    static constexpr bool PERM = true, AFTER_DRAIN = false, HALFN = HN;
    float* Y; bf16_t* YB; const bf16_t* G; float gsc;
    __device__ __forceinline__ void operator()(AccT acc, const Unit& u, int wr, int wc, int fr, int fq) const {
        int z_ = 0; asm volatile("" : "+s"(z_));
        const int row0 = u.pm * 256 + wr * 64 + fr + z_, col0 = u.pn * (HN ? 128 : 256) + wc * 32 + 8 * fq;
#pragma unroll
        for (int ai = 0; ai < 2; ++ai)
#pragma unroll
            for (int m = 0; m < 4; ++m) { const int row = row0 + ai * 128 + m * 16;
#pragma unroll
                for (int bj = 0; bj < (HN ? 1 : 2); ++bj) { const int c = col0 + bj * 128;
                    const u32x4 gw = *(const u32x4*)(G + (size_t)row * N1 + c);
                    f32x4 g0, g1; g0[0] = bflo(gw.x); g0[1] = bfhi(gw.x); g0[2] = bflo(gw.y); g0[3] = bfhi(gw.y); g1[0] = bflo(gw.z); g1[1] = bfhi(gw.z); g1[2] = bflo(gw.w); g1[3] = bfhi(gw.w);
                    f32x4 a = g0 * acc[ai][bj][m][0] * gsc, b = g1 * acc[ai][bj][m][1] * gsc;
                    float* yp = Y + (size_t)row * DM + c;
                    if (MODE >= 1) { a += *(const f32x4*)yp; b += *(const f32x4*)(yp + 4); }
                    if (MODE <= 1) { *(f32x4*)yp = a; *(f32x4*)(yp + 4) = b; }
                    else *(u32x4*)(YB + (size_t)row * DM + c) = pack8(a, b); }
                asm volatile("" ::: "memory"); }
    }
};

namespace att {
constexpr int KVBLK = 64;
constexpr float SCALE = 0.10206207261596575f;
constexpr float THR = 8.f;
constexpr int SHM_V = KVBLK * 128 * 2, SHM_K = KVBLK * 128 * 2, SHM_ATTN = 2 * SHM_V + 2 * SHM_K + NWAVES * 64 * 4;
#define KSWZ(row, colB) ((row) * 256 + ((colB) ^ (((row) & 7) << 4)))
#define SBAR() __builtin_amdgcn_sched_barrier(0)
__device__ __forceinline__ int crow(int r, int hi) { return (r & 3) + 8 * (r >> 2) + 4 * hi; }
__device__ __forceinline__ void partialSM(f32x16& p0, f32x16& p1, float& m_reg, float& mn, float& alpha) {
  constexpr float C = SCALE * 1.4426950408889634f;
  float pmax = p0[0];
#pragma unroll
  for (int r = 1; r < 16; ++r) pmax = fmaxf(pmax, p0[r]);
#pragma unroll
  for (int r = 0; r < 16; ++r) pmax = fmaxf(pmax, p1[r]);
  { auto rr = __builtin_amdgcn_permlane32_swap(__float_as_uint(pmax), __float_as_uint(pmax), false, false);
    pmax = fmaxf(__uint_as_float(rr[0]), __uint_as_float(rr[1])); }
  if (__builtin_expect(__all(pmax - m_reg <= THR / SCALE), 1)) { mn = m_reg; alpha = 1.f; }
  else { mn = fmaxf(m_reg, pmax); alpha = __builtin_amdgcn_exp2f((m_reg - mn) * C); m_reg = mn; }
  float mnC = -mn * C;
#pragma unroll
  for (int r = 0; r < 16; ++r) p0[r] = fmaf(p0[r], C, mnC);
#pragma unroll
  for (int r = 0; r < 16; ++r) p1[r] = fmaf(p1[r], C, mnC);
#pragma unroll
  for (int r = 0; r < 16; ++r) p0[r] = __builtin_amdgcn_exp2f(p0[r]);
}
__device__ __forceinline__ void finishSM(f32x16& p0, f32x16& p1, float alpha, float& l_reg, bf16x8& pa0, bf16x8& pa1, bf16x8& pa2, bf16x8& pa3) {
#pragma unroll
  for (int r = 0; r < 16; ++r) p1[r] = __builtin_amdgcn_exp2f(p1[r]);
  float ps = 0;
#pragma unroll
  for (int r = 0; r < 16; ++r) ps += p0[r];
#pragma unroll
  for (int r = 0; r < 16; ++r) ps += p1[r];
  { auto rr = __builtin_amdgcn_permlane32_swap(__float_as_uint(ps), __float_as_uint(ps), false, false);
    ps = __uint_as_float(rr[0]) + __uint_as_float(rr[1]); }
  l_reg = l_reg * alpha + ps;
#define PK4(P, BASE, OUT) do { unsigned a0 = cvtpk(P[BASE + 0], P[BASE + 1]), a1 = cvtpk(P[BASE + 2], P[BASE + 3]);   \
    unsigned b0 = cvtpk(P[BASE + 4], P[BASE + 5]), b1 = cvtpk(P[BASE + 6], P[BASE + 7]);                              \
    auto r0 = __builtin_amdgcn_permlane32_swap(a0, b0, false, false); auto r1 = __builtin_amdgcn_permlane32_swap(a1, b1, false, false); \
    u32x4 w = {r0[0], r1[0], r0[1], r1[1]}; OUT = *reinterpret_cast<bf16x8*>(&w); } while (0)
  PK4(p0, 0, pa0); PK4(p0, 8, pa1); PK4(p1, 0, pa2); PK4(p1, 8, pa3);
#undef PK4
}
__device__ __forceinline__ void qkt(f32x16& p0, f32x16& p1, const char* Ks, const bf16x8* qr, int r32, int hi) {
  p0 = f32x16{}; p1 = f32x16{};
#pragma unroll
  for (int d0 = 0; d0 < 6; ++d0) { int cb = (d0 * 16 + hi * 8) * 2;
    bf16x8 b0 = *reinterpret_cast<const bf16x8*>(Ks + KSWZ(r32, cb));
    bf16x8 b1 = *reinterpret_cast<const bf16x8*>(Ks + KSWZ(32 + r32, cb));
    p0 = __builtin_amdgcn_mfma_f32_32x32x16_bf16(b0, qr[d0], p0, 0, 0, 0);
    p1 = __builtin_amdgcn_mfma_f32_32x32x16_bf16(b1, qr[d0], p1, 0, 0, 0); }
}
__device__ __forceinline__ int v_st(int k, int c) { const int kk = (k & ~0xC) | ((k & 4) << 1) | ((k & 8) >> 1); return ((kk >> 3) * 4 + (c >> 5)) * 512 + ((kk & 7) * 32 + (c & 31)) * 2; }
__device__ __forceinline__ int v_rd_base(int lane) { return ((lane & 3) << 3) | (((lane >> 2) & 3) << 6) | (((lane >> 4) & 1) << 5) | (((lane >> 5) & 1) << 8); }
constexpr int v_rd_off(int d0, int ks, int half) { return d0 * 512 + ks * 4096 + half * 2048; }
template <int OFF> __device__ __forceinline__ s16x4 tr_read(int vb) {
  s16x4 r; asm volatile("ds_read_b64_tr_b16 %0, %1 offset:%2" : "=&v"(r) : "v"(vb), "i"(OFF) : "memory"); return r;
}
template <int D0> __device__ __forceinline__ void pv_one(f32x16& od, int vb, bf16x8 pa0, bf16x8 pa1, bf16x8 pa2, bf16x8 pa3) {
  const s16x4 l0 = tr_read<v_rd_off(D0, 0, 0)>(vb), h0 = tr_read<v_rd_off(D0, 0, 1)>(vb), l1 = tr_read<v_rd_off(D0, 1, 0)>(vb), h1 = tr_read<v_rd_off(D0, 1, 1)>(vb);
  const s16x4 l2 = tr_read<v_rd_off(D0, 2, 0)>(vb), h2 = tr_read<v_rd_off(D0, 2, 1)>(vb), l3 = tr_read<v_rd_off(D0, 3, 0)>(vb), h3 = tr_read<v_rd_off(D0, 3, 1)>(vb);
  asm volatile("s_waitcnt lgkmcnt(0)" ::: "memory"); SBAR();
#define PK(L, H) (bf16x8){L[0], L[1], L[2], L[3], H[0], H[1], H[2], H[3]}
  od = __builtin_amdgcn_mfma_f32_32x32x16_bf16(pa0, PK(l0, h0), od, 0, 0, 0);
  od = __builtin_amdgcn_mfma_f32_32x32x16_bf16(pa1, PK(l1, h1), od, 0, 0, 0);
  od = __builtin_amdgcn_mfma_f32_32x32x16_bf16(pa2, PK(l2, h2), od, 0, 0, 0);
  od = __builtin_amdgcn_mfma_f32_32x32x16_bf16(pa3, PK(l3, h3), od, 0, 0, 0);
#undef PK
}
__device__ __forceinline__ void pv_d0(f32x16* o, int vb, bf16x8 pa0, bf16x8 pa1, bf16x8 pa2, bf16x8 pa3) {
  pv_one<0>(o[0], vb, pa0, pa1, pa2, pa3); pv_one<1>(o[1], vb, pa0, pa1, pa2, pa3);
}
__device__ __forceinline__ void attn_unit(const bf16_t* __restrict__ Qb, const bf16_t* __restrict__ KVh, const bf16_t* __restrict__ KRr, bf16_t* __restrict__ Ob, int seq, char* lds) {
  int tid_ = threadIdx.x; asm volatile("" : "+v"(tid_));
  const int tid = tid_, wid = tid >> 6, lane = tid & 63, r32 = lane & 31, hi = lane >> 5;
  char* V_lds = lds; char* K_lds = lds + 2 * SHM_V;
  float* ws = (float*)(lds + 2 * SHM_V + 2 * SHM_K) + wid * 64; float* li_l = ws; float* al_l = ws + 32;
  float m_reg = -1e30f, l_reg = 0; f32x16 o[2] = {}; bf16x8 qr[6];
  const bf16_t* Qw = Qb + (long)(wid * 32 + r32) * 768 + hi * 8;
#pragma unroll
  for (int d0 = 0; d0 < 6; ++d0) qr[d0] = *reinterpret_cast<const bf16x8*>(Qw + d0 * 16);
  const int sr = tid >> 4, sc = (tid & 15) * 8, vst0 = v_st(sr, sc & 63), vst1 = v_st(32 + sr, sc & 63);
  const bool kn = sc < 64, krp = (sc >= 64 && sc < 96);
  const int vb0 = (int)(uintptr_t)V_lds + v_rd_base(lane);
  struct { bf16x8 vs0, vs1, ks0, ks1; } sr_[2];
#define SLOAD(i, k0) do { if (kn) { sr_[i].vs0 = *reinterpret_cast<const bf16x8*>(&KVh[(long)((k0) + sr) * 1024 + 64 + sc]); sr_[i].vs1 = *reinterpret_cast<const bf16x8*>(&KVh[(long)((k0) + 32 + sr) * 1024 + 64 + sc]); \
      sr_[i].ks0 = *reinterpret_cast<const bf16x8*>(&KVh[(long)((k0) + sr) * 1024 + sc]); sr_[i].ks1 = *reinterpret_cast<const bf16x8*>(&KVh[(long)((k0) + 32 + sr) * 1024 + sc]); } \
    else if (krp) { sr_[i].ks0 = *reinterpret_cast<const bf16x8*>(&KRr[(long)((k0) + sr) * 32 + sc - 64]); sr_[i].ks1 = *reinterpret_cast<const bf16x8*>(&KRr[(long)((k0) + 32 + sr) * 32 + sc - 64]); } } while (0)
#define SWRITE(b, i) do { if (kn) { *(bf16x8*)(V_lds + (b) * SHM_V + vst0) = sr_[i].vs0; *(bf16x8*)(V_lds + (b) * SHM_V + vst1) = sr_[i].vs1; } \
    if (kn || krp) { int kc = sc * 2; *(bf16x8*)(K_lds + (b) * SHM_K + KSWZ(sr, kc)) = sr_[i].ks0; *(bf16x8*)(K_lds + (b) * SHM_K + KSWZ(32 + sr, kc)) = sr_[i].ks1; } } while (0)
#define RESC(a) do { if (__any((a) < 1.f)) { if (hi == 0) al_l[r32] = (a); asm volatile("s_waitcnt lgkmcnt(0)" ::: "memory"); \
    _Pragma("unroll") for (int d = 0; d < 2; ++d) _Pragma("unroll") for (int r = 0; r < 16; ++r) o[d][r] *= al_l[crow(r, hi)]; } } while (0)
  f32x16 pA0, pA1, pB0, pB1; float mnA, mnB, alA, alB; bf16x8 pa0, pa1, pa2, pa3; const int NT = seq / KVBLK;
  SLOAD(0, 0); SWRITE(0, 0); __syncthreads();
  qkt(pA0, pA1, K_lds, qr, r32, hi); partialSM(pA0, pA1, m_reg, mnA, alA);
  SLOAD(1, KVBLK); if (2 < NT) SLOAD(0, 2 * KVBLK);
  SWRITE(1, 1); __syncthreads();
  for (int j = 1; j + 1 < NT; j += 2) {
    SBAR(); qkt(pB0, pB1, K_lds + SHM_K, qr, r32, hi);
    finishSM(pA0, pA1, alA, l_reg, pa0, pa1, pa2, pa3); SBAR();
    SLOAD(1, (j + 2) * KVBLK); SBAR();
    pv_d0(o, vb0, pa0, pa1, pa2, pa3); partialSM(pB0, pB1, m_reg, mnB, alB);
    __syncthreads(); SWRITE(0, 0);
    RESC(alB); __syncthreads();
    SBAR(); qkt(pA0, pA1, K_lds, qr, r32, hi);
    finishSM(pB0, pB1, alB, l_reg, pa0, pa1, pa2, pa3); SBAR();
    if (j + 3 < NT) SLOAD(0, (j + 3) * KVBLK); SBAR();
    pv_d0(o, vb0 + SHM_V, pa0, pa1, pa2, pa3); partialSM(pA0, pA1, m_reg, mnA, alA);
    __syncthreads(); SWRITE(1, 1);
    RESC(alA); __syncthreads();
  }
  SBAR(); qkt(pB0, pB1, K_lds + SHM_K, qr, r32, hi);
  finishSM(pA0, pA1, alA, l_reg, pa0, pa1, pa2, pa3); SBAR();
  pv_d0(o, vb0, pa0, pa1, pa2, pa3); partialSM(pB0, pB1, m_reg, mnB, alB);
  __syncthreads(); RESC(alB);
  finishSM(pB0, pB1, alB, l_reg, pa0, pa1, pa2, pa3); SBAR();
  pv_d0(o, vb0 + SHM_V, pa0, pa1, pa2, pa3);
  if (hi == 0) li_l[r32] = l_reg; asm volatile("s_waitcnt lgkmcnt(0)" ::: "memory");
  float rli[16];
#pragma unroll
  for (int r = 0; r < 16; ++r) rli[r] = __builtin_amdgcn_rcpf(li_l[crow(r, hi)]);
  bf16_t* Ow = Ob + (long)(wid * 32) * 512;
#pragma unroll
  for (int r = 0; r < 16; ++r) { int orow = crow(r, hi);
#pragma unroll
    for (int d0 = 0; d0 < 2; ++d0) Ow[(long)orow * 512 + d0 * 32 + r32] = (bf16_t)f2bf(o[d0][r] * rli[r]); }
  __syncthreads();
#undef SLOAD
#undef SWRITE
#undef RESC
}
#undef KSWZ
#undef SBAR
}

struct Args { const float* in[29]; float* out; unsigned char* ws; int ph_lo, ph_hi, use_bar, pad; };
enum { I_XP = 0, I_XS, I_CCKV, I_CKR, I_C, I_CCTX, I_WADA, I_BADA, I_NORMG, I_WUP, I_WDN, I_WIN, I_HCW, I_HCB, I_FW1, I_FB1, I_FW2, I_FB2, I_FW3, I_SKIP,
       I_WHY, I_QNG, I_WQB, I_KVNG, I_WKVB, I_WMLA, I_WFN, I_WOUT, I_FING };

struct Frame {
    LAS unsigned char* lds; char* ldsg;
    int G, bid;
    unsigned char* ws;
};
#define WSP(T, off) ((T*)(F.ws + (off)))
#define TLW() int tid_ = threadIdx.x; asm volatile("" : "+v"(tid_)); const int tid = tid_, lane = tid & 63, wave = __builtin_amdgcn_readfirstlane(tid >> 6); (void)lane; (void)wave
__device__ __forceinline__ const float* argin(int i) { size_t off = (size_t)i * 8; asm volatile("" : "+s"(off)); const __attribute__((address_space(4))) char* k = (const __attribute__((address_space(4))) char*)__builtin_amdgcn_kernarg_segment_ptr(); return (const float*)(*(const GAS float* const __attribute__((address_space(4)))*)(k + off)); }
#define AIN(i) argin(i)

enum { CK_ID = 0, CK_UP, CK_IN, CK_QB };
__device__ __forceinline__ bf16_t* conv_dst(int kind, bf16_t* d0, bf16_t* d1, int ldd, int n) {
    if (kind == CK_ID) return d0 + (size_t)n * ldd;
    if (kind == CK_UP) { const int isU = n >= DFF, f = n - DFF * isU; const int R = (f >> 7) * 256 + ((f >> 6) & 1) * 128 + ((f >> 4) & 3) * 32 + 16 * isU + (f & 15); return d0 + (size_t)R * ldd; }
    if (kind == CK_IN) {
        if (n < 768) return d1 + (size_t)n * ldd;
        if (n < 1024) return d0 + (size_t)(n - 768) * ldd;
        if (n < 1152) return d0 + (size_t)(256 + n - 1024) * ldd;
        if (n < 1184) { const int p = n - 1152, part = p >> 4, w = p & 15, half = w >> 3, i = w & 7; return d0 + (size_t)(384 + part * 16 + 2 * i + half) * ldd; }
        if (n < 1440) return nullptr;
        return d0 + (size_t)(512 + n - 1440) * ldd;
    }
    { const int h = n / 96, w96 = n - h * 96; int d = w96;
      if (w96 >= 64) { const int p = w96 - 64, part = p >> 4, w = p & 15, half = w >> 3, i = w & 7; d = 64 + part * 16 + 2 * i + half; }
      return d0 + (size_t)(h * 96 + d) * ldd; }
}
__device__ __forceinline__ void conv_item(const float* W, int ldw, int ncols, int k0, int n0, int kind, bf16_t* d0, bf16_t* d1, int ldd, const float* kscale, bf16_t* dextra, LAS float* scr, int lane) {
    const int lr = lane >> 4, lc = (lane & 15) * 4;
    const bool cok = (n0 + lc) < ncols;
    f32x4 v[16];
#pragma unroll
    for (int i = 0; i < 16; ++i) v[i] = cok ? *(const f32x4*)(W + (size_t)(k0 + i * 4 + lr) * ldw + n0 + lc) : (f32x4){0.f, 0.f, 0.f, 0.f};
#pragma unroll
    for (int i = 0; i < 16; ++i) *(LAS f32x4*)(scr + (i * 4 + lr) * 68 + lc) = v[i];
    asm volatile("s_waitcnt lgkmcnt(0)" ::: "memory");
    const int n = n0 + lane;
    bf16_t* dp = (n < ncols) ? conv_dst(kind, d0, d1, ldd, n) : nullptr;
#pragma unroll
    for (int c = 0; c < 8; ++c) {
        float x[8];
#pragma unroll
        for (int e2 = 0; e2 < 8; ++e2) x[e2] = scr[(8 * c + e2) * 68 + lane];
        if (dp) {
            if (dextra) { u32x4 r; r.x = cvtpk(x[0], x[1]); r.y = cvtpk(x[2], x[3]); r.z = cvtpk(x[4], x[5]); r.w = cvtpk(x[6], x[7]); *(u32x4*)(dextra + (size_t)n * ldd + k0 + 8 * c) = r; }
            if (kscale) {
#pragma unroll
                for (int e2 = 0; e2 < 8; ++e2) x[e2] *= kscale[k0 + 8 * c + e2]; }
            u32x4 o; o.x = cvtpk(x[0], x[1]); o.y = cvtpk(x[2], x[3]); o.z = cvtpk(x[4], x[5]); o.w = cvtpk(x[6], x[7]);
            *(u32x4*)(dp + k0 + 8 * c) = o; }
    }
    asm volatile("s_waitcnt lgkmcnt(0)" ::: "memory");
}

__device__ __forceinline__ void p0_phase(Frame& F, const Args& A) {
    TLW();
    LAS float* scr = (LAS float*)(F.lds + wave * 17408);
    const int gw = F.bid * NWAVES + wave, NGW = F.G * NWAVES;
    const int gt = F.bid * NTHR + tid, NGT = F.G * NTHR;
    {
        constexpr int I_UP = 16 * 88, I_DN = 44 * 16, I_IN = 16 * 71, I_QB = 4 * 12, I_KVB = 2 * 16, I_HY = 4 * 16, I_MLA = 8 * 16, I_FN = 4 * 16, I_OUT = 16 * 16;
        constexpr int PER_L = 2 * I_UP + 2 * I_DN + I_IN + I_QB + I_KVB + I_HY + I_MLA + I_FN + I_OUT;
        for (int it = gw; it < 2 * PER_L; it += NGW) {
            const int l = it / PER_L; int r = it - l * PER_L;
            if (r < 2 * I_UP) { const int f = r / I_UP; r -= f * I_UP; const int nb = 88, kb = r / nb, n_ = r % nb;
                conv_item(AIN(I_WUP) + (size_t)(l * 2 + f) * DM * NUP, NUP, NUP, kb * 64, n_ * 64, CK_UP, WSP(bf16_t, WS_WUP) + (size_t)(l * 2 + f) * NUP * DM, nullptr, DM, nullptr, nullptr, scr, lane); continue; }
            r -= 2 * I_UP;
            if (r < 2 * I_DN) { const int f = r / I_DN; r -= f * I_DN; const int nb = 16, kb = r / nb, n_ = r % nb;
                conv_item(AIN(I_WDN) + (size_t)(l * 2 + f) * DFF * DM, DM, DM, kb * 64, n_ * 64, CK_ID, WSP(bf16_t, WS_WDN) + (size_t)(l * 2 + f) * DM * DFF, nullptr, DFF, nullptr, nullptr, scr, lane); continue; }
            r -= 2 * I_DN;
            if (r < I_IN) { const int nb = 71, kb = r / nb, n_ = r % nb;
                conv_item(AIN(I_WIN) + (size_t)l * DM * INC, INC, INC, kb * 64, n_ * 64, CK_IN, WSP(bf16_t, WS_W1T) + (size_t)l * N1 * DM, WSP(bf16_t, WS_W2T) + (size_t)l * N2 * DM, DM, nullptr, nullptr, scr, lane); continue; }
            r -= I_IN;
            if (r < I_QB) { const int nb = 12, kb = r / nb, n_ = r % nb;
                conv_item(AIN(I_WQB) + (size_t)l * 256 * 768, 768, 768, kb * 64, n_ * 64, CK_QB, WSP(bf16_t, WS_WQB) + (size_t)l * 768 * 256, nullptr, 256, AIN(I_QNG) + l * 256, nullptr, scr, lane); continue; }
            r -= I_QB;
            if (r < I_KVB) { const int nb = 16, kb = r / nb, n_ = r % nb;
                conv_item(AIN(I_WKVB) + (size_t)l * 128 * 1024, 1024, 1024, kb * 64, n_ * 64, CK_ID, WSP(bf16_t, WS_WKVB) + (size_t)l * 1024 * 256, nullptr, 256, AIN(I_KVNG) + l * 128, WSP(bf16_t, WS_WKVR) + (size_t)l * 1024 * 256, scr, lane); continue; }
            r -= I_KVB;
            if (r < I_HY) { const int nb = 16, kb = r / nb, n_ = r % nb;
                conv_item(AIN(I_WHY) + (size_t)l * 256 * 1024, 1024, 1024, kb * 64, n_ * 64, CK_ID, WSP(bf16_t, WS_WHY) + (size_t)l * 1024 * 256, nullptr, 256, nullptr, nullptr, scr, lane); continue; }
            r -= I_HY;
            if (r < I_MLA) { const int nb = 16, kb = r / nb, n_ = r % nb;
                conv_item(AIN(I_WMLA) + (size_t)l * 512 * 1024, 1024, 1024, kb * 64, n_ * 64, CK_ID, WSP(bf16_t, WS_WMLA) + (size_t)l * 1024 * 512, nullptr, 512, nullptr, nullptr, scr, lane); continue; }
            r -= I_MLA;
            if (r < I_FN) { const int nb = 16, kb = r / nb, n_ = r % nb;
                conv_item(AIN(I_WFN) + (size_t)l * 256 * 1024, 1024, 1024, kb * 64, n_ * 64, CK_ID, WSP(bf16_t, WS_WFN) + (size_t)l * 1024 * 256, nullptr, 256, nullptr, nullptr, scr, lane); continue; }
            r -= I_FN;
            { const int nb = 16, kb = r / nb, n_ = r % nb;
                conv_item(AIN(I_WOUT) + (size_t)l * 1024 * 1024, 1024, 1024, kb * 64, n_ * 64, CK_ID, WSP(bf16_t, WS_WOUT) + (size_t)l * 1024 * 1024, nullptr, 1024, nullptr, nullptr, scr, lane); }
        }
    }
    __syncthreads();
    LAS float* scv = (LAS float*)(F.lds);
    LAS float* ctab = (LAS float*)(F.lds + 16384);
    for (int i = tid; i < 3 * DM; i += NTHR) { const int g = i >> 10, k = i & 1023; const float c = (g == 0) ? AIN(I_CCTX)[k] : AIN(I_C)[(g - 1) * DM + k]; scv[i] = siluf_(c); }
    for (int i = tid; i < 2048; i += NTHR) ctab[i] = cospif((float)i * (1.0f / 1024.0f));
    __syncthreads();
    for (int it = gw; it < 2 * 4 * 16 * 4; it += NGW) {
        const int mq = it & 3, kc = (it >> 2) & 15, g = (it >> 6) & 3, l = it >> 8; const int k = kc * 64 + lane;
        const float* src = AIN(I_WIN) + (size_t)l * DM * INC + (size_t)k * INC + 1184 + g * 64;
        float x[64];
#pragma unroll
        for (int j = 0; j < 16; ++j) { const f32x4 v = *(const f32x4*)(src + 4 * j); x[4 * j] = v[0]; x[4 * j + 1] = v[1]; x[4 * j + 2] = v[2]; x[4 * j + 3] = v[3]; }
        bf16_t* dst = WSP(bf16_t, WS_W2T) + (size_t)l * N2 * DM;
        for (int mm = 0; mm < 16; ++mm) { const int m = mq * 16 + mm; float sc_ = 0.f, ss_ = 0.f;
#pragma unroll
            for (int j = 0; j < 64; ++j) { const int ph = (j * m) & 63; sc_ += x[j] * ctab[ph * 32]; ss_ += x[j] * ctab[((ph + 48) & 63) * 32]; }
            dst[(size_t)(768 + g * 64 + m) * DM + k] = (bf16_t)f2bf(sc_); dst[(size_t)(1024 + g * 64 + m) * DM + k] = (bf16_t)f2bf(ss_); }
    }
    for (int it = gw; it < 2 * 16 * 36; it += NGW) {
        const int cc = it % 36, kc = (it / 36) & 15, l = it / (36 * 16);
        const float* wp = AIN(I_WADA) + (size_t)l * DM * NADA + (size_t)(kc * 64) * NADA + cc * 256 + lane * 4;
        f32x4 a0 = {0, 0, 0, 0}, a1 = a0, a2 = a0;
#pragma unroll 8
        for (int k = 0; k < 64; ++k) { const f32x4 w = *(const f32x4*)(wp + (size_t)k * NADA); const int kk = kc * 64 + k; a0 += w * scv[kk]; a1 += w * scv[1024 + kk]; a2 += w * scv[2048 + kk]; }
        float* op = WSP(float, WS_ADAP) + ((size_t)(kc * 2 + l) * 3) * NADA + cc * 256 + lane * 4;
        *(f32x4*)op = a0; *(f32x4*)(op + NADA) = a1; *(f32x4*)(op + 2 * NADA) = a2;
    }
    for (int it = gw; it < 2 * 288; it += NGW) {
        const int l = it / 288, r0 = (it % 288) * 8;
        const float* W1 = AIN(I_FW1) + l * 17 * 64; const float* W2 = AIN(I_FW2) + l * 64 * 64;
        float w1c[17], w2c[64];
#pragma unroll
        for (int i = 0; i < 17; ++i) w1c[i] = W1[i * 64 + lane];
#pragma unroll
        for (int k = 0; k < 64; ++k) w2c[k] = W2[k * 64 + lane];
        const float b1 = AIN(I_FB1)[l * 64 + lane], b2 = AIN(I_FB2)[l * 64 + lane];
        for (int rr = 0; rr < 8; ++rr) { const int row = r0 + rr; const int L = row < 256 ? 256 : 2048, t = row < 256 ? row : row - 256;
            float feat = 0.f;
            { const float tn = (float)t / (float)(L - 1), w = 6.283185307179586f * (float)t / (float)L;
              const int bi = (lane >= 9) ? lane - 9 : lane - 1; const float band = 1e-4f + (float)bi * ((7.0f - 1e-4f) / 7.0f); const float ang = w * band;
              feat = (lane == 0) ? tn : ((lane <= 8) ? cosf(ang) : -sinf(ang)); }
            float h1 = b1;
#pragma unroll
            for (int i = 0; i < 17; ++i) h1 += __builtin_bit_cast(float, __builtin_amdgcn_readlane(__builtin_bit_cast(int, feat), i)) * w1c[i];
            h1 = sinf(h1);
            float h2 = b2;
#pragma unroll
            for (int k = 0; k < 64; ++k) h2 += __builtin_bit_cast(float, __builtin_amdgcn_readlane(__builtin_bit_cast(int, h1), k)) * w2c[k];
            h2 = sinf(h2);
            WSP(float, WS_H2)[((size_t)l * 2304 + row) * 64 + lane] = h2; }
    }
    if (F.bid == 0) { const int pos = tid >> 3, i = tid & 7; const float inv = exp2f(-(float)i * (13.287712379549449f / 8.0f)); float s, c; sincosf((float)pos * inv, &s, &c);
        WSP(float, WS_ROPE)[(pos * 8 + i) * 2] = c; WSP(float, WS_ROPE)[(pos * 8 + i) * 2 + 1] = s; }
    for (int it = gt; it < 2048 * 512 + 256 * 64; it += NGT) {
        const bool isl = it < 2048 * 512; const int L = isl ? 2048 : 256, j = isl ? it : it - 2048 * 512, per = 2 * L / 8, k = j / per, t8 = (j % per) * 8, sh = isl ? 0 : 3;
        float v[8];
#pragma unroll
        for (int e = 0; e < 8; ++e) { const int tt = t8 + e, isS = tt >= L, t = tt - isS * L; const int ph = (k * t) & (L - 1);
            v[e] = isS ? -ctab[(((ph - L / 4) & (L - 1)) << sh)] : ctab[ph << sh]; }
        u32x4 o; o.x = pk2(v[0], v[1]); o.y = pk2(v[2], v[3]); o.z = pk2(v[4], v[5]); o.w = pk2(v[6], v[7]);
        *(u32x4*)((isl ? WSP(bf16_t, WS_DFTL) : WSP(bf16_t, WS_DFTC)) + (size_t)k * 2 * L + t8) = o;
    }
    for (int it = gt; it < 2 * 1024 * 32; it += NGT) { const int c8 = (it & 31) * 8, row = (it >> 5) & 1023, l = it >> 15; const int b = row >> 9, j = row & 511;
        u32x4 o = {0, 0, 0, 0};
        if (c8 < 128) { const float* sp = AIN(I_CCKV) + ((size_t)((b * 2 + l) * 512 + j)) * 128 + c8; const f32x4 x = *(const f32x4*)sp, y = *(const f32x4*)(sp + 4);
            o.x = pk2(x[0], x[1]); o.y = pk2(x[2], x[3]); o.z = pk2(y[0], y[1]); o.w = pk2(y[2], y[3]); }
        *(u32x4*)(WSP(bf16_t, WS_CKVB) + ((size_t)l * 1024 + row) * 256 + c8) = o; }
    for (int it = gt; it < 2 * 96 * 128; it += NGT) { const int c8 = (it & 127) * 8, r = (it >> 7) % 96, l = it / (96 * 128);
        *(u32x4*)(WSP(bf16_t, WS_W1T) + ((size_t)l * N1 + 416 + r) * DM + c8) = (u32x4){0, 0, 0, 0}; }
    for (int it = gt; it < 2 * 2 * 1024 * 16; it += NGT) { const int c8 = 128 + (it & 15) * 8, r = (it >> 4) & 1023, l = (it >> 14) & 1, wsel = it >> 15;
        *(u32x4*)((wsel ? WSP(bf16_t, WS_WKVR) : WSP(bf16_t, WS_WKVB)) + ((size_t)l * 1024 + r) * 256 + c8) = (u32x4){0, 0, 0, 0}; }
    __syncthreads();
}

__device__ __forceinline__ void norm_phase(Frame& F, const Args& A, int l, int which, bool first, bool from_partials) {
    TLW();
    LAS float* gm = (LAS float*)(F.lds);
    LAS float* sv = (LAS float*)(F.lds + 12288);
    for (int i = tid; i < 3 * DM; i += NTHR) { const int g = i >> 10, c = i & 1023; float s, sc;
        if (from_partials) { s = AIN(I_BADA)[l * NADA + (3 * which) * DM + c]; sc = AIN(I_BADA)[l * NADA + (3 * which + 1) * DM + c];
            for (int kc = 0; kc < 16; ++kc) { const float* pp = WSP(float, WS_ADAP) + ((size_t)(kc * 2 + l) * 3 + g) * NADA; s += pp[(3 * which) * DM + c]; sc += pp[(3 * which + 1) * DM + c]; } }
        else { const float* ad = WSP(float, WS_ADA) + ((size_t)l * 3 + g) * NADA; s = ad[(3 * which) * DM + c]; sc = ad[(3 * which + 1) * DM + c]; }
        gm[i] = AIN(I_NORMG)[(l * 3 + which) * DM + c] * (1.0f + sc); sv[i] = s; }
    __syncthreads();
    const int gw = F.bid * NWAVES + wave, NGW = F.G * NWAVES;
    for (int r = gw; r < MTOK; r += NGW) {
        const float* src = first ? (r < NCTX ? AIN(I_XP) + (size_t)r * DM : AIN(I_XS) + (size_t)(r - NCTX) * DM) : WSP(float, WS_H) + (size_t)r * DM;
        const int g = r < NCTX ? 0 : 1 + ((r - NCTX) >> 11);
        f32x4 v[4]; float s = 0.f;
#pragma unroll
        for (int j = 0; j < 4; ++j) { v[j] = *(const f32x4*)(src + 4 * lane + 256 * j); s += (v[j][0] * v[j][0] + v[j][1] * v[j][1]) + (v[j][2] * v[j][2] + v[j][3] * v[j][3]); }
        const float rstd = 1.0f / sqrtf(wave_sum(s) * (1.0f / DM) + EPSV);
        bf16_t* np = WSP(bf16_t, WS_N) + (size_t)r * DM;
#pragma unroll
        for (int j = 0; j < 4; ++j) { const int c = 4 * lane + 256 * j; const f32x4 gg = *(const LAS f32x4*)(gm + g * DM + c), ss = *(const LAS f32x4*)(sv + g * DM + c);
            const f32x4 y = v[j] * rstd * gg + ss; u32x2 w; w.x = cvtpk(y[0], y[1]); w.y = cvtpk(y[2], y[3]); *(u32x2*)(np + c) = w;
            if (first) *(f32x4*)(WSP(float, WS_H) + (size_t)r * DM + c) = v[j]; }
    }
    __syncthreads();
}
__device__ __forceinline__ void final_norm_phase(Frame& F, const Args& A) {
    TLW();
    const int gw = F.bid * NWAVES + wave, NGW = F.G * NWAVES;
    for (int r = gw; r < MTOK; r += NGW) {
        const float* src = WSP(float, WS_H) + (size_t)r * DM;
        f32x4 v[4]; float s = 0.f;
#pragma unroll
        for (int j = 0; j < 4; ++j) { v[j] = *(const f32x4*)(src + 4 * lane + 256 * j); s += (v[j][0] * v[j][0] + v[j][1] * v[j][1]) + (v[j][2] * v[j][2] + v[j][3] * v[j][3]); }
        const float rstd = 1.0f / sqrtf(wave_sum(s) * (1.0f / DM) + EPSV);
#pragma unroll
        for (int j = 0; j < 4; ++j) { const int c = 4 * lane + 256 * j; const f32x4 gg = *(const f32x4*)(AIN(I_FING) + c); *(f32x4*)(A.out + (size_t)r * DM + c) = v[j] * rstd * gg; }
    }
}

__device__ __forceinline__ void p0b_phase(Frame& F, const Args& A) {
    TLW();
    const int gt = F.bid * NTHR + tid, NGT = F.G * NTHR, gw = F.bid * NWAVES + wave, NGW = F.G * NWAVES;
    for (int it = gt; it < 2 * 3 * NADA; it += NGT) { const int c = it % NADA, g = (it / NADA) % 3, l = it / (3 * NADA); float s = AIN(I_BADA)[l * NADA + c];
        for (int kc = 0; kc < 16; ++kc) s += WSP(float, WS_ADAP)[((size_t)(kc * 2 + l) * 3 + g) * NADA + c];
        WSP(float, WS_ADA)[((size_t)l * 3 + g) * NADA + c] = s; }
    LAS float* tl = (LAS float*)(F.lds + wave * 16384);
    for (int it = gw; it < 2 * 36 * 16; it += NGW) {
        const int cc = it & 15, rc = (it >> 4) % 36, l = it / (36 * 16); const int L = rc < 4 ? 256 : 2048, t0 = rc < 4 ? rc * 64 : rc * 64 - 256;
        const float* W3 = AIN(I_FW3) + (size_t)l * 64 * 1024 + cc * 64 + lane;
        float w[64];
#pragma unroll
        for (int k = 0; k < 64; ++k) w[k] = W3[k * 1024];
        const float* hp = WSP(float, WS_H2) + ((size_t)l * 2304 + rc * 64) * 64;
#pragma unroll 2
        for (int tt = 0; tt < 64; ++tt) { float s = 0.f;
#pragma unroll
            for (int k = 0; k < 64; ++k) s += hp[tt * 64 + k] * w[k];
            tl[tt * 64 + (lane ^ tt)] = s; }
        asm volatile("s_waitcnt lgkmcnt(0)" ::: "memory");
        const int t = t0 + lane; const float tn = (float)t / (float)(L - 1);
        float* fb = WSP(float, WS_FILT) + (size_t)l * FILT_LAYER + (rc < 4 ? (size_t)512 * 4096 : 0);
        for (int ci = 0; ci < 64; ++ci) { const int col = cc * 64 + ci, ch = col & 255, oc = col & 511, dir = col >> 9;
            const float delta = -3.0701134573253944f + (float)ch * ((-15.350567286626972f + 3.0701134573253944f) / 255.0f);
            const float s = tl[lane * 64 + (ci ^ lane)] * expf(-tn * fabsf(delta));
            float* fr = fb + (size_t)oc * (2 * L);
            if (dir == 0) fr[L + t] = s; else if (t > 0) fr[L - t] = s; else fr[0] = 0.f; }
        asm volatile("s_waitcnt lgkmcnt(0)" ::: "memory");
    }
}

#ifndef HYP
#define HYP 0
#endif
constexpr int HY_HCS = 8176;
constexpr int HY_IMG = 17472;
constexpr int HY_HC = 0, HY_HV = 8 * HY_HCS, HY_HZ = HY_HV + HY_IMG, HY_X1 = HY_HZ + HY_IMG, HY_X2 = HY_X1 + 8192, HY_ST = HY_X2 + 8192, HY_TB = HY_ST + 32768, HY_END = HY_TB + 8192;
static_assert(HY_END <= MISC_OFF, "hyena LDS map");
struct HyPre { u32x4 raw[3]; float xm[3], xp[3]; f32x4 ta, tb; };
__device__ __forceinline__ void hyena_unit(Frame& F, const Args& A, int l, int unit, int nrun = 4) {
    TLW();
    const bool lat = unit < 64; const int nch = 4, c0 = (lat ? unit : unit - 64) * 4;
    const int L = lat ? 2048 : 256, tokbase = lat ? NCTX : 0, NQ = lat ? 512 : 64;
    LAS unsigned char* lds = F.lds;
    volatile LAS float* red = (volatile LAS float*)(lds + MISC_OFF + 64);
    const bf16_t* hyt = WSP(bf16_t, WS_HYT);
    const float* filt = WSP(float, WS_FILT) + (size_t)l * FILT_LAYER + (lat ? 0 : (size_t)512 * 4096);
    const int ntap = 2 * L;
    for (int i = tid; i < (2 * HY_IMG) / 16; i += NTHR) *(LAS u32x4*)(lds + HY_HV + i * 16) = (u32x4){0, 0, 0, 0};
    LAS float* cwl = (LAS float*)(lds + MISC_OFF + 128);
    if (tid < 48) { const int e = tid & 3, ws_ = (tid >> 2) % 3, cc_ = (tid / 12) < nch ? tid / 12 : 0, chn = (ws_ == 0 ? 512 : (ws_ == 1 ? 0 : 256)) + c0 + cc_;
        cwl[tid] = e < 3 ? AIN(I_HCW)[(size_t)l * 3 * 768 + e * 768 + chn] : AIN(I_HCB)[l * 768 + chn]; }
    else if (tid < 56) { const int o_ = tid & 1, cc_ = ((tid - 48) >> 1) < nch ? (tid - 48) >> 1 : 0; cwl[tid] = AIN(I_SKIP)[(l * 2 + o_) * 256 + c0 + cc_]; }
    const int rho = wave, rp = lane & 15, g4 = lane >> 4;
    LAS unsigned char* HCw = lds + HY_HC + wave * HY_HCS - 16;
    const int idx8 = tid * 8, pos8 = idx8 & (L - 1), b8 = idx8 / L;
    const int eoffm = pos8 > 0 ? -1 : 0, eoffp = (pos8 + 8 < L) ? 8 : 0;
    const float emm = pos8 > 0 ? 1.f : 0.f, epm = (pos8 + 8 < L) ? 1.f : 0.f;
    const bool tapok = idx8 < ntap; const int tapoff = tapok ? idx8 : 0; const float tapm = tapok ? 1.f : 0.f;
    u32x4 raw0, raw1, raw2; unsigned short xm0, xm1, xm2, xp0, xp1, xp2; f32x4 ta, tb;
#define HY_LOADHY(cc) do { const bf16_t* h0_ = hyt + (size_t)(512 + (cc)) * MTOK + tokbase + idx8; const bf16_t* h1_ = hyt + (size_t)(cc) * MTOK + tokbase + idx8; const bf16_t* h2_ = hyt + (size_t)(256 + (cc)) * MTOK + tokbase + idx8; \
        raw0 = *(const u32x4*)h0_; raw1 = *(const u32x4*)h1_; raw2 = *(const u32x4*)h2_; \
        xm0 = h0_[eoffm]; xm1 = h1_[eoffm]; xm2 = h2_[eoffm]; xp0 = h0_[eoffp]; xp1 = h1_[eoffp]; xp2 = h2_[eoffp]; } while (0)
#define HY_LOADTAPS(oo, cc) do { const float* fp_ = filt + (size_t)((oo) * 256 + (cc)) * ntap + tapoff; ta = *(const f32x4*)fp_; tb = *(const f32x4*)(fp_ + 4); } while (0)
#define HY_PUTTAPS(oo, TA, TB) do { TA = TA * tapm; TB = TB * tapm; const float as_ = (fabsf(TA[0]) + fabsf(TA[1])) + (fabsf(TA[2]) + fabsf(TA[3])) + (fabsf(TB[0]) + fabsf(TB[1])) + (fabsf(TB[2]) + fabsf(TB[3])); \
        const float ws_ = wave_sum(as_); if (lane == 0) red[(oo) * 8 + wave] = ws_; \
        if (tapok) *(LAS u32x4*)(lds + HY_TB + idx8 * 2) = pack8(TA, TB); } while (0)
#define HY_CONV(raw, xm_, xp_, wsel, dstoff, isimg) do { const f32x4 cw4_ = *(const LAS f32x4*)(cwl + (ci * 3 + (wsel)) * 4); const float w0_ = cw4_[0], w1_ = cw4_[1], w2_ = cw4_[2], bb_ = cw4_[3]; \
        float x_[10]; x_[0] = bf2f(xm_) * emm; x_[1] = bflo(raw.x); x_[2] = bfhi(raw.x); x_[3] = bflo(raw.y); x_[4] = bfhi(raw.y); x_[5] = bflo(raw.z); x_[6] = bfhi(raw.z); x_[7] = bflo(raw.w); x_[8] = bfhi(raw.w); x_[9] = bf2f(xp_) * epm; \
        float u_[8]; _Pragma("unroll") for (int e = 0; e < 8; ++e) u_[e] = x_[e] * w0_ + x_[e + 1] * w1_ + x_[e + 2] * w2_ + bb_; \
        u32x4 o_; o_.x = cvtpk(u_[0], u_[1]); o_.y = cvtpk(u_[2], u_[3]); o_.z = cvtpk(u_[4], u_[5]); o_.w = cvtpk(u_[6], u_[7]); \
        if (isimg) { const int J_ = pos8 >> 7, bo_ = lat ? b8 * 8832 + (7 + J_) * 288 : (b8 * 2 + J_) * 272; *(LAS u32x4*)(lds + (dstoff) + bo_ + (pos8 & 127) * 2) = o_; } \
        else *(LAS u32x4*)(lds + (dstoff) + idx8 * 2) = o_; } while (0)
    f32x4 tc, td;
#define HY_BAR() asm volatile("s_waitcnt lgkmcnt(0)\n\ts_barrier" ::: "memory")
    HY_LOADHY(c0); HY_LOADTAPS(0, c0);
    { const float* fp_ = filt + (size_t)(256 + c0) * ntap + tapoff; tc = *(const f32x4*)fp_; td = *(const f32x4*)(fp_ + 4); }
    __syncthreads();
#pragma unroll 1
    for (int ci = 0; ci < nrun; ++ci) {
        const int c = c0 + ci, cn = (ci + 1 < nch) ? c + 1 : c;
#pragma unroll 1
        for (int rc_ = 0; rc_ < ((HYP & 8) ? 2 : 1); ++rc_) {
        HY_CONV(raw0, xm0, xp0, 0, HY_HV, true); HY_CONV(raw1, xm1, xp1, 1, HY_X1, false); HY_CONV(raw2, xm2, xp2, 2, HY_X2, false);
        HY_PUTTAPS(0, ta, tb); }
        HY_LOADHY(cn); HY_LOADTAPS(0, cn);
        HY_BAR();
#pragma unroll 1
        for (int ord = 0; ord < 2; ++ord) {
            for (int rb_ = 0; rb_ < ((HYP & 2) ? 2 : 1); ++rb_)
            for (int qi = lane; qi < NQ; qi += 64) { if (qi == 0) continue; const int h0 = 8 * (qi - NQ / 2) + rho + L - 7;
                const LAS unsigned* tw = (const LAS unsigned*)(lds + HY_TB) + (h0 >> 1);
                unsigned w0 = tw[0], w1 = tw[1], w2 = tw[2], w3 = tw[3], w4 = tw[4];
                if (h0 & 1) { w0 = __builtin_amdgcn_alignbit(w1, w0, 16); w1 = __builtin_amdgcn_alignbit(w2, w1, 16); w2 = __builtin_amdgcn_alignbit(w3, w2, 16); w3 = __builtin_amdgcn_alignbit(w4, w3, 16); }
                u32x4 o; o.x = __builtin_amdgcn_alignbit(w3, w3, 16); o.y = __builtin_amdgcn_alignbit(w2, w2, 16); o.z = __builtin_amdgcn_alignbit(w1, w1, 16); o.w = __builtin_amdgcn_alignbit(w0, w0, 16);
                *(LAS u32x4*)(HCw + qi * 16) = o; }
            float nsum = 0.f;
#pragma unroll
            for (int w = 0; w < 8; ++w) nsum += red[ord * 8 + w];
            const float inv = 1.0f / (nsum + EPSV);
            asm volatile("s_waitcnt lgkmcnt(0)" ::: "memory");
            const LAS unsigned char* Ub = lds + (ord == 0 ? HY_HV : HY_HZ) + 16 * g4;
            const int blkS = lat ? 288 : 272, lo0 = lat ? (rp & 1) * 8832 + (7 + (rp >> 1)) * 288 : rp * 2 * 272, lo1_ = lo0 + (lat ? 8 * 288 : 272);
            const int dmin = lat ? -15 : -1, dmax = lat ? 15 : 1, hi0 = lat ? 7 : 0, lo1 = lat ? -7 : 0;
            f32x4 acc0, acc1, acc0b, acc1b;
#pragma unroll 1
            for (int rm_ = 0; rm_ < ((HYP & 1) ? 2 : 1); ++rm_) {
            acc0 = (f32x4){0.f, 0.f, 0.f, 0.f}; acc1 = acc0; acc0b = acc0; acc1b = acc0;
            const LAS unsigned char* ap = HCw + (NQ / 2 + rp - g4 + 16 * dmin) * 16;
            const LAS unsigned char* bp0 = Ub + lo0 - dmin * blkS; const LAS unsigned char* bp1 = Ub + lo1_ - dmin * blkS;
#define HY_LD(p, o) (*(const LAS bf16x8*)((p) + (o)))
#define HY_MM(a, b, c) c = __builtin_amdgcn_mfma_f32_16x16x32_bf16(a, b, c, 0, 0, 0)
#define HY_BODY(U0, U1) do { const bf16x8 a0_ = HY_LD(ap, 0), a1_ = HY_LD(ap, -64), a2_ = HY_LD(ap, -128), a3_ = HY_LD(ap, -192); \
        bf16x8 p0_, p1_, p2_, p3_, q0_, q1_, q2_, q3_; \
        if (U0) { p0_ = HY_LD(bp0, 0); p1_ = HY_LD(bp0, 64); p2_ = HY_LD(bp0, 128); p3_ = HY_LD(bp0, 192); } \
        if (U1) { q0_ = HY_LD(bp1, 0); q1_ = HY_LD(bp1, 64); q2_ = HY_LD(bp1, 128); q3_ = HY_LD(bp1, 192); } \
        if (U0) { HY_MM(a0_, p0_, acc0); HY_MM(a1_, p1_, acc0b); } if (U1) { HY_MM(a0_, q0_, acc1); HY_MM(a1_, q1_, acc1b); } \
        if (U0) { HY_MM(a2_, p2_, acc0); HY_MM(a3_, p3_, acc0b); } if (U1) { HY_MM(a2_, q2_, acc1); HY_MM(a3_, q3_, acc1b); } \
        ap += 256; bp0 -= blkS; bp1 -= blkS; } while (0)
            if (lat) {
                const LAS unsigned char* apb = ap - 192;
                const LAS unsigned char* bpb = Ub + lo0 - 7 * 288;
#pragma unroll
                for (int sp = 0; sp < 2; ++sp) {
                    bf16x8 rb[8][2];
#pragma unroll
                    for (int c8 = 0; c8 < 4; ++c8)
#pragma unroll
                        for (int k = 0; k < 8; ++k) { const int d = -15 + 8 * c8 + k;
                            if (d <= 15) {
                                const bf16x8 a0_ = HY_LD(apb, 256 * (d + 15) + 64 * (3 - 2 * sp)), a1_ = HY_LD(apb, 256 * (d + 15) + 64 * (2 - 2 * sp));
                                if (d >= -7) { HY_MM(a0_, rb[k][0], acc1); HY_MM(a1_, rb[k][1], acc1b); }
                                if (d <= 7) { rb[k][0] = HY_LD(bpb, 288 * (7 - d) + 128 * sp); rb[k][1] = HY_LD(bpb, 288 * (7 - d) + 128 * sp + 64);
                                    HY_MM(a0_, rb[k][0], acc0); HY_MM(a1_, rb[k][1], acc0b); }
                            } }
                }
            } else { int d = dmin;
#pragma unroll 1
              for (; d < lo1; ++d) HY_BODY(true, false);
#pragma unroll 1
              for (; d <= hi0; ++d) HY_BODY(true, true);
#pragma unroll 1
              for (; d <= dmax; ++d) HY_BODY(false, true); }
#undef HY_LD
#undef HY_MM
#undef HY_BODY
            if (HYP & 1) asm volatile("" : "+v"(acc0), "+v"(acc1), "+v"(acc0b), "+v"(acc1b));
            }
            acc0 += acc0b; acc1 += acc1b;
            const float sk = cwl[48 + ci * 2 + ord];
            const LAS unsigned char* Uimg = lds + (ord == 0 ? HY_HV : HY_HZ); const LAS unsigned char* Xc = lds + (ord == 0 ? HY_X1 : HY_X2);
            int la_[8], ix_[8]; unsigned short uv_[8], xv_[8];
#pragma unroll 1
            for (int re_ = 0; re_ < ((HYP & 4) ? 2 : 1); ++re_) {
#pragma unroll
            for (int t = 0; t < 2; ++t)
#pragma unroll
                for (int reg = 0; reg < 4; ++reg) { const int a = 32 * g4 + 8 * reg + rho; const int I = lat ? 8 * t + (rp >> 1) : t, b = lat ? (rp & 1) : rp;
                    ix_[t * 4 + reg] = lat ? b * 2048 + 128 * I + a : b * 256 + 128 * I + a; la_[t * 4 + reg] = (lat ? b * 8832 + (7 + I) * 288 : (b * 2 + I) * 272) + a * 2; }
#pragma unroll
            for (int k = 0; k < 8; ++k) { uv_[k] = *(const LAS bf16_t*)(Uimg + la_[k]); xv_[k] = *(const LAS bf16_t*)(Xc + ix_[k] * 2); }
#pragma unroll
            for (int k = 0; k < 8; ++k) { const float y = (k < 4 ? acc0[k & 3] : acc1[k & 3]) * inv; const float z = bf2f(xv_[k]) * (y + sk * bf2f(uv_[k]));
                if (ord == 0) *(LAS bf16_t*)(lds + HY_HZ + la_[k]) = (bf16_t)f2bf(z); else *(LAS bf16_t*)(lds + HY_ST + (ix_[k] * nch + ci) * 2) = (bf16_t)f2bf(z); }
            }
            HY_BAR();
            if (ord == 0) { HY_PUTTAPS(1, tc, td);
                { const float* fp_ = filt + (size_t)(256 + cn) * ntap + tapoff; tc = *(const f32x4*)fp_; td = *(const f32x4*)(fp_ + 4); }
                HY_BAR(); }
        }
    }
    for (int i = tid; i < 4096; i += NTHR) *(u32x2*)(WSP(bf16_t, WS_Z) + (size_t)(tokbase + i) * 256 + c0) = *(const LAS u32x2*)(lds + HY_ST + i * 8);
    __syncthreads();
#undef HY_LOADHY
#undef HY_LOADTAPS
#undef HY_PUTTAPS
#undef HY_CONV
}

constexpr int ST_PER_LAYER = 21, N_STEPS = 3 + 2 * ST_PER_LAYER;
#ifndef MK_ONE_LAUNCH
#define MK_ONE_LAUNCH 1
#endif
#ifndef PHSEL
#define PHSEL -1
#endif
#define PSEL(k) (PHSEL < 0 || PHSEL == (k))
#ifndef PROBE_REP
#define PROBE_REP 0
#endif
__host__ __device__ constexpr bool bar_after(int st) {
    if (st < 3) return st != 1;
    const int s = (st - 3) % ST_PER_LAYER;
    return !(s == 3 || s == 5 || s == 6 || s == 7 || s == 9 || s == 10 || s == 11 || s == 13 || s == 14);
}

template <class Epi> __device__ __forceinline__ void run_gemm(Frame& F, const bf16_t* Ap, int lda, const bf16_t* Bp, int ldb, int M, int N, int K, int cshift, const Epi& E) {
    pg8::Gemm g{Ap, Bp, M, N, K, lda, ldb}; pg8::StaticOrder S; S.init(M, N, F.G, (F.bid + F.G - cshift) % F.G, Epi::HALFN ? 128 : 256);
    pg8::gemm_phase<Epi, pg8::StaticOrder, true, true>(F.lds, g, S, E);
}

__global__ void __launch_bounds__(NTHR, 2) mk_fwd(Args args) {
    extern __shared__ __attribute__((aligned(16))) unsigned char lds[];
    Frame F;
    F.lds = (LAS unsigned char*)lds; F.ldsg = (char*)lds;
    F.G = gridDim.x; F.bid = blockIdx.x;
    volatile LAS unsigned* MISC = (volatile LAS unsigned*)(F.lds + MISC_OFF);
    if (threadIdx.x < 64) ((LAS unsigned*)(F.lds + MISC_OFF))[threadIdx.x] = 0u;
    __syncthreads();
    const int lo = args.ph_lo, hi = args.ph_hi;
    XcdBarrier bar; bar.bar = (unsigned*)(args.ws + WS_CTL) + CW_BAR; bar.x = 0; bar.st = nullptr;
    if (args.use_bar) bar = xcd_barrier_post((unsigned*)(args.ws + WS_CTL) + CW_BAR, MISC + 8);
    const Args& A = args;

#pragma unroll 1
    for (int st = lo; st < hi; ++st) {
        { size_t z_ = 0; asm volatile("" : "+s"(z_)); F.ws = args.ws + z_; }
        int nrep = 1;
        if (PROBE_REP) { const int s_ = st < 3 ? -1 : (st - 3) % ST_PER_LAYER;
            if ((PROBE_REP & 1) && (s_ == 0 || s_ == 18)) nrep = 2;
            if ((PROBE_REP & 2) && (s_ == 1 || s_ == 19)) nrep = 2;
            if ((PROBE_REP & 4) && (s_ == 3 || s_ == 4)) nrep = 2;
            if ((PROBE_REP & 8) && s_ == 11) nrep = 2;
            if ((PROBE_REP & 16) && s_ == 12) nrep = 2;
            if ((PROBE_REP & 32) && (s_ == 9 || s_ == 10)) nrep = 2;
            if ((PROBE_REP & 64) && st == 0) nrep = 2;
            if ((PROBE_REP & 128) && (st == 2 || s_ == 2 || s_ == 17 || s_ == 20)) nrep = 2;
            if ((PROBE_REP & 512) && (s_ >= 5 && s_ <= 8)) nrep = 2;
            if ((PROBE_REP & 1024) && s_ == 16) nrep = 2;
            if ((PROBE_REP & 2048) && st == 1) nrep = 2;
            if ((PROBE_REP & 4096) && (s_ == 13 || s_ == 14 || s_ == 15)) nrep = 2; }
#pragma unroll 1
        for (int rep = 0; rep < nrep; ++rep) {
        const float gsm = (rep + 1 < nrep) ? 0.0f : 1.0f;
        if (st == 0) { if (PSEL(100)) p0_phase(F, A); }
        else if (st == 1) { if (PSEL(101)) p0b_phase(F, A); }
        else if (st == 2) { if (PSEL(102)) norm_phase(F, A, 0, 0, true, true); }
        else {
            const int l = (st - 3) / ST_PER_LAYER, s = (st - 3) % ST_PER_LAYER;
            const float* ada = WSP(float, WS_ADA) + (size_t)l * 3 * NADA;
            if ((s == 0 || s == 18) && PSEL(0)) {
                const int f = s == 0 ? 0 : 1;
                EpiSwiglu E{WSP(bf16_t, WS_ACT)};
                run_gemm(F, WSP(bf16_t, WS_N), DM, WSP(bf16_t, WS_WUP) + (size_t)(l * 2 + f) * NUP * DM, DM, MTOK, NUP, DM, 0, E);
            } else if ((s == 1 || s == 19) && PSEL(1)) {
                const int f = s == 1 ? 0 : 1;
                EpiResid<true> E{WSP(float, WS_H), ada + (f == 0 ? 2 : 8) * DM, 0.5f * gsm};
                run_gemm(F, WSP(bf16_t, WS_ACT), DFF, WSP(bf16_t, WS_WDN) + (size_t)(l * 2 + f) * DM * DFF, DFF, MTOK, DM, DFF, 0, E);
            } else if (s == 2 && PSEL(2)) norm_phase(F, A, l, 1, false, false);
            else if (s == 3 && PSEL(3)) {
                EpiProj1 E1{WSP(bf16_t, WS_P1), WSP(float, WS_SSQ), WSP(float, WS_SSKV), WSP(float, WS_CKVRAW), WSP(float, WS_KRRAW)};
                run_gemm(F, WSP(bf16_t, WS_N), DM, WSP(bf16_t, WS_W1T) + (size_t)l * N1 * DM, DM, MTOK, N1, DM, 0, E1);
            } else if (s == 4 && PSEL(4)) {
                EpiT E2{WSP(bf16_t, WS_HYT), WSP(bf16_t, WS_XCTL), WSP(bf16_t, WS_XCTC)};
                run_gemm(F, WSP(bf16_t, WS_W2T) + (size_t)l * N2 * DM, DM, WSP(bf16_t, WS_N), DM, N2, MTOK, DM, 192, E2);
            } else if (s == 5 && PSEL(5)) {
                EpiQ EQ{WSP(bf16_t, WS_Q), WSP(float, WS_SSQ), WSP(float, WS_ROPE)};
                run_gemm(F, WSP(bf16_t, WS_P1), N1, WSP(bf16_t, WS_WQB) + (size_t)l * 768 * 256, 256, MTOK, 768, 256, 0, EQ);
            } else if (s == 6 && PSEL(6)) {
                EpiKV<false> EK{WSP(bf16_t, WS_KV), WSP(float, WS_SSKV)};
                run_gemm(F, WSP(bf16_t, WS_P1) + 256, N1, WSP(bf16_t, WS_WKVB) + (size_t)l * 1024 * 256, 256, MTOK, 1024, 256, 96, EK);
            } else if (s == 7 && PSEL(7)) {
                EpiKV<true> EC{WSP(bf16_t, WS_KV), nullptr};
                run_gemm(F, WSP(bf16_t, WS_CKVB) + (size_t)l * 1024 * 256, 256, WSP(bf16_t, WS_WKVR) + (size_t)l * 1024 * 256, 256, 1024, 1024, 256, 224, EC);
            } else if (s == 8 && PSEL(8)) {
                TLW(); const int gt = F.bid * NTHR + tid, NGT = F.G * NTHR;
                for (int it = gt; it < NCTX * 32; it += NGT) { const int r = it >> 5, c4 = (it & 31) * 4;
                    const f32x4 ss = *(const f32x4*)(WSP(float, WS_SSKV) + r * 4); const float rstd = 1.0f / sqrtf(((ss[0] + ss[1]) + (ss[2] + ss[3])) * (1.0f / 128.0f) + EPSV);
                    const f32x4 x = *(const f32x4*)(WSP(float, WS_CKVRAW) + (size_t)r * 128 + c4), g = *(const f32x4*)(AIN(I_KVNG) + l * 128 + c4);
                    *(f32x4*)(A.out + (size_t)MTOK * DM + ((size_t)((r >> 8) * 2 + l) * 256 + (r & 255)) * 128 + c4) = x * rstd * g; }
                for (int it = gt; it < MTOK * 4; it += NGT) { const int row = it >> 2, q = it & 3, part = q >> 1, ib = 4 * (q & 1);
                    const float* kp = WSP(float, WS_KRRAW) + (size_t)row * 32 + 8 * q; const f32x4 va = *(const f32x4*)kp, vb = *(const f32x4*)(kp + 4);
                    float v[8] = {va[0], va[1], va[2], va[3], vb[0], vb[1], vb[2], vb[3]};
                    if (row < NCTX) { float* op = A.out + (size_t)MTOK * DM + (size_t)16 * 2 * 256 * 128 + (size_t)((row >> 8) * 2 * 256 + l * 256 + (row & 255)) * 32 + part * 16 + ib;
#pragma unroll
                        for (int e = 0; e < 8; ++e) op[(e & 1) * 8 + (e >> 1)] = v[e];
                    } else { const int t = (row - NCTX) & 2047, pos = part == 0 ? (t >> 6) : (t & 63); const float* rt = WSP(float, WS_ROPE) + (pos * 8 + ib) * 2;
#pragma unroll
                        for (int e = 0; e < 8; e += 2) { const float cs = rt[e], sn = rt[e + 1], x1 = v[e], x2 = v[e + 1]; v[e] = x1 * cs - x2 * sn; v[e + 1] = x2 * cs + x1 * sn; } }
                    u32x4 w; w.x = cvtpk(v[0], v[1]); w.y = cvtpk(v[2], v[3]); w.z = cvtpk(v[4], v[5]); w.w = cvtpk(v[6], v[7]);
                    *(u32x4*)(WSP(bf16_t, WS_KR) + (size_t)kvrow_of(row) * 32 + 8 * q) = w; }
                for (int it = gt; it < 2 * 512 * 32; it += NGT) { const int pp = it & 31, j = (it >> 5) & 511, b = it >> 14; const int part = pp >> 4, w = pp & 15, i = w >> 1, half = w & 1, p = part * 16 + half * 8 + i;
                    WSP(bf16_t, WS_KR)[(size_t)(NCTX + b * 2560 + 2048 + j) * 32 + pp] = (bf16_t)f2bf(AIN(I_CKR)[((size_t)(b * 2 + l) * 512 + j) * 32 + p]); }
            } else if (s == 9 && PSEL(9)) {
                EpiFn EL{WSP(bf16_t, WS_FN), 1, 0.00276213586400995f};
                run_gemm(F, WSP(bf16_t, WS_DFTL), 4096, WSP(bf16_t, WS_XCTL), 4096, 2048, 512, 4096, 0, EL);
            } else if (s == 10 && PSEL(10)) {
                EpiFn EC{WSP(bf16_t, WS_FN), 0, 0.0078125f};
                run_gemm(F, WSP(bf16_t, WS_DFTC), 512, WSP(bf16_t, WS_XCTC), 512, 256, 4096, 512, 16, EC);
            } else if (s == 11 && PSEL(11)) {
                unsigned* qctr = WSP(unsigned, WS_CTL) + CW_Q + l * 64;
                volatile LAS unsigned* qs = (volatile LAS unsigned*)(F.lds + MISC_OFF + 16);
#pragma unroll 1
                for (;;) {
                    if (threadIdx.x == 0) qs[0] = __hip_atomic_fetch_add(qctr, 1u, __ATOMIC_RELAXED, __HIP_MEMORY_SCOPE_AGENT);
                    __syncthreads();
                    const int qu = (int)qs[0];
                    __syncthreads();
                    if (qu >= 384) break;
                    if (qu < 64 || (qu >= 192 && qu < 256)) { int nr_ = 4;
#pragma unroll 1
                        for (int rr_ = 0; rr_ < ((HYP & 16) ? 2 : 1); ++rr_) { hyena_unit(F, A, l, qu < 64 ? qu : qu - 128, nr_); nr_ = 0; } }
                    else { const int u = qu < 192 ? qu - 64 : qu - 128;
                        const bf16_t *Qb, *KVh, *KRr; bf16_t* Ob; int seq;
                        if (u < 128) { const int b = u >> 6, h = (u >> 3) & 7, qb = u & 7; const int r0 = NCTX + b * 2048 + qb * 256, k0 = NCTX + b * 2560;
                            Qb = WSP(bf16_t, WS_Q) + (size_t)r0 * 768 + h * 96; KVh = WSP(bf16_t, WS_KV) + (size_t)k0 * 1024 + h * 128; KRr = WSP(bf16_t, WS_KR) + (size_t)k0 * 32; Ob = WSP(bf16_t, WS_O) + (size_t)r0 * 512 + h * 64; seq = 2560; }
                        else { const int v = u - 128, b = v >> 3, h = v & 7; const int r0 = b * 256;
                            Qb = WSP(bf16_t, WS_Q) + (size_t)r0 * 768 + h * 96; KVh = WSP(bf16_t, WS_KV) + (size_t)r0 * 1024 + h * 128; KRr = WSP(bf16_t, WS_KR) + (size_t)r0 * 32; Ob = WSP(bf16_t, WS_O) + (size_t)r0 * 512 + h * 64; seq = 256; }
                        att::attn_unit(Qb, KVh, KRr, Ob, seq, F.ldsg); }
                }
            } else if (s == 13 && PSEL(13)) {
                EpiGate<0, true> E0{WSP(float, WS_Y), WSP(bf16_t, WS_N), WSP(bf16_t, WS_P1) + 512, 1.0f};
                run_gemm(F, WSP(bf16_t, WS_Z), 256, WSP(bf16_t, WS_WHY) + (size_t)l * 1024 * 256, 256, MTOK, DM, 256, 0, E0);
            } else if (s == 14 && PSEL(14)) {
                EpiGate<1, true> E1{WSP(float, WS_Y), WSP(bf16_t, WS_N), WSP(bf16_t, WS_P1) + 512 + 1024, gsm};
                run_gemm(F, WSP(bf16_t, WS_O), 512, WSP(bf16_t, WS_WMLA) + (size_t)l * 1024 * 512, 512, MTOK, DM, 512, 0, E1);
            } else if (s == 15 && PSEL(15)) {
                EpiGate<2, true> E2{WSP(float, WS_Y), WSP(bf16_t, WS_N), WSP(bf16_t, WS_P1) + 512 + 2048, 1.0f};
                run_gemm(F, WSP(bf16_t, WS_FN), 256, WSP(bf16_t, WS_WFN) + (size_t)l * 1024 * 256, 256, MTOK, DM, 256, 0, E2);
            } else if (s == 16 && PSEL(16)) {
                EpiResid<true> E{WSP(float, WS_H), ada + 5 * DM, 1.0f * gsm};
                run_gemm(F, WSP(bf16_t, WS_N), DM, WSP(bf16_t, WS_WOUT) + (size_t)l * DM * DM, DM, MTOK, DM, DM, 0, E);
            } else if (s == 17 && PSEL(17)) norm_phase(F, A, l, 2, false, false);
            else if (s == 20 && PSEL(20)) { if (l == 0) norm_phase(F, A, 1, 0, false, false); else final_norm_phase(F, A); }
        }
        if (rep + 1 < nrep) { asm volatile("s_waitcnt vmcnt(0)" ::: "memory"); __syncthreads(); }
        }
        if (st + 1 < hi) { if (bar_after(st)) { xcd_barrier(bar); if (PROBE_REP & 256) xcd_barrier(bar); } else { asm volatile("s_waitcnt vmcnt(0)" ::: "memory"); __syncthreads(); } }
    }
}

extern "C" void kernel_launch(void* const* d_in, const int* in_sizes, int n_in, void* d_out, int out_size, void* d_ws, size_t ws_size, hipStream_t stream) {
    static int grid = 0;
    if (grid == 0) {
        if (n_in != 29 || ws_size < WS_END) { fprintf(stderr, "kernel_launch: n_in %d ws %zu (need %zu)\n", n_in, ws_size, (size_t)WS_END); grid = -1; return; }
        int dev = 0, cus = 0;
        if (hipGetDevice(&dev) != hipSuccess || hipDeviceGetAttribute(&cus, hipDeviceAttributeMultiprocessorCount, dev) != hipSuccess) { grid = -1; return; }
        if (hipFuncSetAttribute((const void*)mk_fwd, hipFuncAttributeMaxDynamicSharedMemorySize, LDS_BYTES) != hipSuccess) { fprintf(stderr, "kernel_launch: hipFuncSetAttribute failed\n"); grid = -1; return; }
        grid = cus;
    }
    if (grid < 0) return;
    (void)hipMemsetAsync((char*)d_ws + WS_CTL, 0, CTL_BYTES, stream);
    Args a{};
    for (int i = 0; i < 29; ++i) a.in[i] = (const float*)d_in[i];
    a.out = (float*)d_out; a.ws = (unsigned char*)d_ws;
#if MK_ONE_LAUNCH
    a.ph_lo = 0; a.ph_hi = N_STEPS; a.use_bar = 1;
    hipLaunchKernelGGL(mk_fwd, dim3(grid), dim3(NTHR), LDS_BYTES, stream, a);
#else
    a.use_bar = 0;
    for (int s0 = 0; s0 < N_STEPS;) { int s1 = s0; while (!bar_after(s1)) ++s1; a.ph_lo = s0; a.ph_hi = s1 + 1; hipLaunchKernelGGL(mk_fwd, dim3(grid), dim3(NTHR), LDS_BYTES, stream, a); s0 = s1 + 1; }
#endif
}
```
